# Optimizing an MI355X kernel written in HIP

```python
import jax, jax.numpy as jnp
from jax import lax
import numpy as np

D_MODEL = 2048
BATCH = 1
SEQ = 8192
DEPTH = 4

CHUNK = 64
LEFT_CHUNKS = 8
BAND = (LEFT_CHUNKS + 1) * CHUNK
MAX_REL = 128
N_MEM = 256

MIX_WIDTH = D_MODEL
A_WIDTH = MIX_WIDTH // 2
A_HEADS = 8
A_HEAD_DIM = A_WIDTH // A_HEADS
B_WIDTH = MIX_WIDTH // 4
B_HEADS = 4
B_DV = B_WIDTH // B_HEADS
B_DK = B_DV // 2
B_KEY_WIDTH = B_HEADS * B_DK
GATE_RANK = 16
GATE_TAU = 16.0
M_WIDTH = MIX_WIDTH // 4
M_HEADS = 4
M_HEAD_DIM = M_WIDTH // M_HEADS

IN_SPLITS = (A_WIDTH, A_WIDTH, A_WIDTH, A_WIDTH,
             B_KEY_WIDTH, B_KEY_WIDTH, B_WIDTH, B_WIDTH, GATE_RANK,
             M_WIDTH, M_WIDTH)
IN_WIDTH = sum(IN_SPLITS)
VALUE_SPLITS = (2, 6)

DEEPNORM_ALPHA = (2.0 * DEPTH) ** 0.25
DEEPNORM_BETA = (8.0 * DEPTH) ** -0.25
LN_EPS = 1e-5
RMS_EPS = 1e-6
NEG_INF = -1e30

kernel_name = "hybrid_chunk_attn_gla_mem_deepnorm"


def layer_norm(x, g, b):
    xf = x.astype(jnp.float32)
    mu = jnp.mean(xf, axis=-1, keepdims=True)
    var = jnp.mean(jnp.square(xf - mu), axis=-1, keepdims=True)
    y = (xf - mu) * lax.rsqrt(var + LN_EPS) * g.astype(jnp.float32) + b.astype(jnp.float32)
    return y.astype(x.dtype)


def chunk_band_attention(q, k, v, rel_table):
    B, S, H, Dh = q.shape
    nc = S // CHUNK
    qc = q.reshape(B, nc, CHUNK, H, Dh)
    pad = ((0, 0), (LEFT_CHUNKS * CHUNK, 0), (0, 0), (0, 0))
    kp = jnp.pad(k, pad).reshape(B, nc + LEFT_CHUNKS, CHUNK, H, Dh)
    vp = jnp.pad(v, pad).reshape(B, nc + LEFT_CHUNKS, CHUNK, H, Dh)
    k_band = jnp.concatenate([kp[:, i:i + nc] for i in range(LEFT_CHUNKS + 1)], axis=2)
    v_band = jnp.concatenate([vp[:, i:i + nc] for i in range(LEFT_CHUNKS + 1)], axis=2)
    scores = jnp.einsum('bnqhd,bnkhd->bnhqk', qc, k_band).astype(jnp.float32) * (Dh ** -0.5)
    dist = jnp.arange(CHUNK)[:, None] + LEFT_CHUNKS * CHUNK - jnp.arange(BAND)[None, :]
    rel_idx = jnp.clip(dist, -MAX_REL, MAX_REL) + MAX_REL
    bias = rel_table[:, rel_idx].astype(jnp.float32)
    key_chunk = jnp.arange(nc)[:, None] - LEFT_CHUNKS + (jnp.arange(BAND) // CHUNK)[None, :]
    valid = key_chunk >= 0
    scores = jnp.where(valid[None, :, None, None, :], scores + bias[None, None], NEG_INF)
    p = jax.nn.softmax(scores, axis=-1).astype(v.dtype)
    out = jnp.einsum('bnhqk,bnkhd->bnqhd', p, v_band)
    return out.reshape(B, S, H, Dh)


def gla_chunk_recurrence(q, k, v, log_g):
    B, S, H, DK = q.shape
    DV = v.shape[-1]
    nc = S // CHUNK
    f32 = jnp.float32

    def to_chunks(t):
        return jnp.moveaxis(t.astype(f32).reshape(B, nc, CHUNK, H, t.shape[-1]), 1, 0)

    qs = to_chunks(q * (DK ** -0.5))
    ks, vs, gs = to_chunks(k), to_chunks(v), to_chunks(log_g)

    def step(state, inp):
        qc, kc, vc, gc = inp
        b = jnp.cumsum(gc, axis=1)
        decay = jnp.exp(-jnp.abs(b[:, :, None] - b[:, None, :]))
        attn = jnp.einsum('bihd,bjhd,bijhd->bhij', qc, kc, decay)
        o_intra = jnp.einsum('bhij,bjhv->bihv', attn, vc)
        o_inter = jnp.einsum('bihd,bhdv->bihv', qc * jnp.exp(b), state)
        b_last = b[:, -1]
        k_dec = kc * jnp.exp(b_last[:, None] - b)
        new_state = jnp.exp(b_last)[..., None] * state + jnp.einsum('bjhd,bjhv->bhdv', k_dec, vc)
        return new_state, o_intra + o_inter

    state0 = jnp.zeros((B, H, DK, DV), f32)
    _, out = lax.scan(step, state0, (qs, ks, vs, gs))
    return jnp.moveaxis(out, 0, 1).reshape(B, S, H, DV)


def memory_attention(q, mk, mv):
    s = jnp.einsum('bshd,bmhd->bhsm', q, mk).astype(jnp.float32) * (q.shape[-1] ** -0.5)
    p = jax.nn.softmax(s, axis=-1).astype(mv.dtype)
    return jnp.einsum('bhsm,bmhd->bshd', p, mv)


def hybrid_layer(x, mem, w_in, rel_table, gate_w, gate_b, gla_norm_g, w_mem_kv, w_out, ln_g, ln_b):
    B, S, _ = x.shape
    h = x @ w_in
    cuts = [int(c) for c in np.cumsum(IN_SPLITS)[:-1]]
    a_q, a_k, a_v, a_z, b_q, b_k, b_v, b_z, b_lr, m_q, m_z = jnp.split(h, cuts, axis=-1)

    heads_a = lambda t: t.reshape(B, S, A_HEADS, A_HEAD_DIM)
    y_a = chunk_band_attention(heads_a(a_q), heads_a(a_k), heads_a(a_v), rel_table).reshape(B, S, A_WIDTH)

    gate_logit = (b_lr @ gate_w + gate_b).astype(jnp.float32)
    log_g = jax.nn.log_sigmoid(gate_logit) / GATE_TAU
    heads_k = lambda t: t.reshape(B, S, B_HEADS, B_DK)
    o_b = gla_chunk_recurrence(heads_k(b_q), heads_k(b_k), b_v.reshape(B, S, B_HEADS, B_DV), heads_k(log_g))
    o_b = o_b * lax.rsqrt(jnp.mean(jnp.square(o_b), axis=-1, keepdims=True) + RMS_EPS) * gla_norm_g.astype(jnp.float32)
    y_b = o_b.reshape(B, S, B_WIDTH).astype(x.dtype)

    mkv = mem @ w_mem_kv
    mk, mv = jnp.split(mkv, 2, axis=-1)
    heads_m = lambda t: t.reshape(t.shape[0], t.shape[1], M_HEADS, M_HEAD_DIM)
    y_m = memory_attention(heads_m(m_q), heads_m(mk), heads_m(mv)).reshape(B, S, M_WIDTH)

    y = jnp.concatenate([y_a * jax.nn.silu(a_z), y_b * jax.nn.silu(b_z), y_m * jax.nn.silu(m_z)], axis=-1)
    out = y @ w_out
    return layer_norm(DEEPNORM_ALPHA * x + out, ln_g, ln_b)


def setup_inputs(seed: int = 0) -> dict:
    key = jax.random.key(seed)
    ks = jax.random.split(key, 12)
    f32 = jnp.float32
    x = jax.random.normal(ks[0], (BATCH, SEQ, D_MODEL), f32)
    mem = jax.random.normal(ks[1], (N_MEM, D_MODEL), f32)[None].repeat(BATCH, axis=0) \
        + 0.1 * jax.random.normal(ks[2], (BATCH, N_MEM, D_MODEL), f32)
    col_scale = jnp.concatenate([
        jnp.full((n,), DEEPNORM_BETA if i in VALUE_SPLITS else 1.0, f32) for i, n in enumerate(IN_SPLITS)])
    w_in = jax.random.normal(ks[3], (DEPTH, D_MODEL, IN_WIDTH), f32) * (D_MODEL ** -0.5) * col_scale
    a_rel_bias = 0.1 * jax.random.normal(ks[4], (DEPTH, A_HEADS, 2 * MAX_REL + 1), f32)
    b_gate_w = jax.random.normal(ks[5], (DEPTH, GATE_RANK, B_KEY_WIDTH), f32) * (GATE_RANK ** -0.5)
    b_gate_b = 0.1 * jax.random.normal(ks[6], (DEPTH, B_KEY_WIDTH), f32)
    b_norm_g = 1.0 + 0.02 * jax.random.normal(ks[7], (DEPTH, B_DV), f32)
    kv_scale = jnp.concatenate([jnp.ones((M_WIDTH,), f32), jnp.full((M_WIDTH,), DEEPNORM_BETA, f32)])
    w_mem_kv = jax.random.normal(ks[8], (DEPTH, D_MODEL, 2 * M_WIDTH), f32) * (D_MODEL ** -0.5) * kv_scale
    w_out = jax.random.normal(ks[9], (DEPTH, MIX_WIDTH, D_MODEL), f32) * (MIX_WIDTH ** -0.5) * DEEPNORM_BETA
    ln_g = 1.0 + 0.02 * jax.random.normal(ks[10], (DEPTH, D_MODEL), f32)
    ln_b = 0.02 * jax.random.normal(ks[11], (DEPTH, D_MODEL), f32)
    return {"x": x, "mem": mem, "w_in": w_in, "a_rel_bias": a_rel_bias, "b_gate_w": b_gate_w,
            "b_gate_b": b_gate_b, "b_norm_g": b_norm_g, "w_mem_kv": w_mem_kv, "w_out": w_out,
            "ln_g": ln_g, "ln_b": ln_b}


def reference(x, mem, w_in, a_rel_bias, b_gate_w, b_gate_b, b_norm_g, w_mem_kv, w_out, ln_g, ln_b):
    h = x
    for l in range(DEPTH):
        h = hybrid_layer(h, mem, w_in[l], a_rel_bias[l], b_gate_w[l], b_gate_b[l], b_norm_g[l],
                         w_mem_kv[l], w_out[l], ln_g[l], ln_b[l])
    return h
```

```cpp
#include <hip/hip_runtime.h>
#include <hip/hip_cooperative_groups.h>
#include <cstdio>
#include <cstdint>
namespace cg = cooperative_groups;
namespace pg8 {
#define PG8_LAS __attribute__((address_space(3)))
typedef unsigned short bf16_t;
typedef short bf16x8 __attribute__((ext_vector_type(8)));
typedef float f32x4 __attribute__((ext_vector_type(4)));
typedef unsigned u32x4 __attribute__((ext_vector_type(4)));
constexpr int BM = 256, BK = 64, HALF = 128, HTB = HALF * BK * 2  , STAGE_BYTES = 8 * HTB, NXCD = 8, WGM = 8;

__host__ __device__ __forceinline__ int lds_byte(int r, int c) { const int st = (r >> 4) * 2 + (c >> 5), rr = r & 15, cc = c & 31, ob = rr * 64 + cc * 2; return st * 1024 + (ob ^ (((ob >> 9) & 1) << 5)); }
__host__ __device__ __forceinline__ void stage_rc(int b, int& R, int& C) { const int st = b / 1024, sb = b % 1024, swz = sb ^ (((sb >> 9) & 1) << 5); R = (st >> 1) * 16 + swz / 64; C = (st & 1) * 32 + (swz % 64) / 2; }
__host__ __device__ __forceinline__ int perm32(int rho) { const int n = rho >> 4, i = rho & 15; return 8 * (i >> 2) + 4 * n + (i & 3); }

struct Unit { int pm, pn; };
struct Gemm { const bf16_t* A; const bf16_t* Bt; int M, N, K; };

struct StaticOrder {
    int nM, nN, nwg, G, c;
    __host__ __device__ void init(int M, int N, int G_, int c_) { nM = M / BM; nN = N / BM; nwg = nM * nN; G = G_; c = c_; }
    __host__ __device__ bool next(int i, Unit& u) const {
        const long L = (long)i * G + c; if (L >= nwg) return false;
        int wgid = (int)L; { const int q = nwg / NXCD, r = nwg % NXCD, xcd = wgid % NXCD, off = wgid / NXCD; wgid = (xcd < r ? xcd * (q + 1) : r * (q + 1) + (xcd - r) * q) + off; }
        const int nig = WGM * nN, gid = wgid / nig, fm = gid * WGM, gsz = (nM - fm) < WGM ? (nM - fm) : WGM;
        u.pm = fm + ((wgid % nig) % gsz); u.pn = (wgid % nig) / gsz; return true;
    }
    __device__ __forceinline__ void a_ready(const Unit&) const {}
    __device__ __forceinline__ void done(const Unit&) const {}
};

__device__ __forceinline__ unsigned cvt_pk_bf16(float lo, float hi) { unsigned r; asm volatile("v_cvt_pk_bf16_f32 %0, %1, %2" : "=v"(r) : "v"(lo), "v"(hi)); return r; }
typedef float f32x2 __attribute__((ext_vector_type(2)));
__device__ __forceinline__ f32x2 gelu_pk(f32x2 v) {
    const f32x2 av = __builtin_elementwise_abs(v), d = av * 0.2316418882f + 1.0f;
    f32x2 t; t.x = __builtin_amdgcn_rcpf(d.x); t.y = __builtin_amdgcn_rcpf(d.y);
    f32x2 q = t * 0.5307027145f + (-0.7265760135f); q = q * t + 0.7107068705f; q = q * t + (-0.142248368f); q = q * t + 0.127414796f; q = q * t;
    const f32x2 s = (v * v) * (-0.72134752044f);
    f32x2 e; e.x = __builtin_amdgcn_exp2f(s.x); e.y = __builtin_amdgcn_exp2f(s.y);
    const f32x2 m = v * (q * e), r = v - m;
    f32x2 o; o.x = v.x < 0.f ? m.x : r.x; o.y = v.y < 0.f ? m.y : r.y; return o;
}

template <int ACT  > struct EpiBf16 {
    static constexpr bool PERM = true, AFTER_DRAIN = false; static_assert(ACT == 0 || ACT == 1, "EpiBf16: ACT is 0 (none) or 1 (gelu_pk)");
    bf16_t* O; int ldc; const float* bias; int split_cols; size_t split_stride; float scale0;
    __device__ __forceinline__ void operator()(const f32x4 (&acc)[2][2][4][2], const Unit& u, int wr, int wc, int fr, int fq) const {
        const int row0 = u.pm * BM + wr * 64 + fr; int colt = u.pn * BM; bf16_t* base = O;
        float sc = 1.f; if (split_cols) { const int t = colt / split_cols; base += (size_t)t * split_stride; colt -= t * split_cols; if (t == 0) sc = scale0; }
        const int col0 = colt + wc * 32 + 8 * fq, bcol0 = u.pn * BM + wc * 32 + 8 * fq;
        f32x4 bv[2][2];
#pragma unroll
        for (int bj = 0; bj < 2; ++bj)
#pragma unroll
            for (int n = 0; n < 2; ++n) bv[bj][n] = bias ? *(const f32x4*)(bias + bcol0 + bj * HALF + 4 * n) : (f32x4){0.f, 0.f, 0.f, 0.f};
#pragma unroll
        for (int ai = 0; ai < 2; ++ai)
#pragma unroll
            for (int m = 0; m < 4; ++m) { bf16_t* rowp = base + (size_t)(row0 + ai * HALF + m * 16) * ldc + col0;
#pragma unroll
                for (int bj = 0; bj < 2; ++bj) { f32x4 v0 = acc[ai][bj][m][0] + bv[bj][0], v1 = acc[ai][bj][m][1] + bv[bj][1];
                    if (ACT == 1) { f32x2 a = gelu_pk((f32x2){v0[0], v0[1]}), b = gelu_pk((f32x2){v0[2], v0[3]}), c = gelu_pk((f32x2){v1[0], v1[1]}), d = gelu_pk((f32x2){v1[2], v1[3]});
                        v0 = (f32x4){a.x, a.y, b.x, b.y}; v1 = (f32x4){c.x, c.y, d.x, d.y}; }
                    v0 = v0 * sc; v1 = v1 * sc; u32x4 w; w.x = cvt_pk_bf16(v0[0], v0[1]); w.y = cvt_pk_bf16(v0[2], v0[3]); w.z = cvt_pk_bf16(v1[0], v1[1]); w.w = cvt_pk_bf16(v1[2], v1[3]);
                    *(u32x4*)(rowp + bj * HALF) = w; } }
    }
};
template <class Epi, class Sched, bool ALIGN_EPI = false, bool SP2 = false>
__device__ __forceinline__ void gemm_phase(PG8_LAS unsigned char* lds, const Gemm g, const Sched& S, const Epi& E) {
    int tid_ = threadIdx.x; asm volatile("" : "+v"(tid_)); const int tid = tid_, wid = __builtin_amdgcn_readfirstlane(tid >> 6), lane = tid & 63, wr = wid >> 2, wc = wid & 3, fr = lane & 15, fq = lane >> 4;
    const int K = g.K, nt = K / BK;
    unsigned voffA[2], voffB[2];
#pragma unroll
    for (int i = 0; i < 2; ++i) { int R, C; stage_rc(tid * 16 + i * 8192, R, C); const int Rb = Epi::PERM ? ((R & ~31) + perm32(R & 31)) : R;
        voffA[i] = (unsigned)(R * K + C) * 2u; voffB[i] = (unsigned)(Rb * K + C) * 2u; }
    const size_t kstep = (size_t)(BK * 2);
    const size_t hstep = (size_t)HALF * K * 2;
    const size_t tstep = 2 * hstep;
    const unsigned ldsw = (unsigned)wid * 1024u;
    const int aoff = lds_byte(wr * 64 + fr, fq * 8), boff = lds_byte(wc * 32 + fr, fq * 8);
#define PG8_SA(b, h) (((b) * 2 + (h)) * HTB)
#define PG8_SB(b, h) ((4 + (b) * 2 + (h)) * HTB)
#define PG8_STAGE(bufoff, gbase, voff) do { _Pragma("unroll") for (int _i = 0; _i < 2; ++_i) \
        __builtin_amdgcn_global_load_lds((const unsigned*)((const char*)(gbase) + (voff)[_i]), (PG8_LAS unsigned*)(lds + (bufoff) + ldsw + _i * 8192), 16, 0, 0); } while (0)
#define PG8_LDA(dst, b, h) do { _Pragma("unroll") for (int m = 0; m < 4; ++m) _Pragma("unroll") for (int k = 0; k < 2; ++k) dst[m][k] = *(const PG8_LAS bf16x8*)(lds + PG8_SA(b, h) + aoff + m * 2048 + k * 1024); } while (0)
#define PG8_LDB(dst, b, h) do { _Pragma("unroll") for (int n = 0; n < 2; ++n) _Pragma("unroll") for (int k = 0; k < 2; ++k) dst[n][k] = *(const PG8_LAS bf16x8*)(lds + PG8_SB(b, h) + boff + n * 2048 + k * 1024); } while (0)
#define PG8_MMA(ai, bj, At, Bt) do { __builtin_amdgcn_s_setprio(1); _Pragma("unroll") for (int m = 0; m < 4; ++m) _Pragma("unroll") for (int n = 0; n < 2; ++n) _Pragma("unroll") for (int k = 0; k < 2; ++k) \
        acc[ai][bj][m][n] = __builtin_amdgcn_mfma_f32_16x16x32_bf16(Bt[n][k], At[m][k], acc[ai][bj][m][n], 0, 0, 0); __builtin_amdgcn_s_setprio(0); } while (0)
#define PG8_WAIT_V(n) asm volatile("s_waitcnt vmcnt(" #n ")" ::: "memory")
#define PG8_WAIT_L(n) asm volatile("s_waitcnt lgkmcnt(" #n ")" ::: "memory")
#define PG8_BAR __builtin_amdgcn_s_barrier()
#define PG8_SCHED __builtin_amdgcn_sched_barrier(0)
    Unit cur, nxt; int ui = 0;
    if (!S.next(0, cur)) return;
    f32x4 acc[2][2][4][2];
#pragma unroll
    for (int a = 0; a < 2; ++a)
#pragma unroll
        for (int b = 0; b < 2; ++b)
#pragma unroll
            for (int m = 0; m < 4; ++m)
#pragma unroll
                for (int n = 0; n < 2; ++n) acc[a][b][m][n] = (f32x4){0.f, 0.f, 0.f, 0.f};
    bf16x8 At[4][2], B0[2][2], B1[2][2];
    const char* cA = (const char*)g.A + (size_t)cur.pm * tstep; const char* cB = (const char*)g.Bt + (size_t)cur.pn * tstep;
    S.a_ready(cur);
    if constexpr (SP2) {
        PG8_STAGE(PG8_SB(0, 0), cB, voffB); PG8_STAGE(PG8_SB(0, 1), cB + hstep, voffB); PG8_STAGE(PG8_SA(0, 0), cA, voffA); PG8_STAGE(PG8_SA(0, 1), cA + hstep, voffA);
        if (wr == 1) PG8_BAR;
        PG8_WAIT_V(2); PG8_BAR;
        PG8_STAGE(PG8_SB(1, 0), cB + kstep, voffB); PG8_STAGE(PG8_SA(1, 0), cA + kstep, voffA); PG8_STAGE(PG8_SB(1, 1), cB + hstep + kstep, voffB);
        PG8_WAIT_V(6); PG8_BAR;
    } else {
        PG8_STAGE(PG8_SB(0, 0), cB, voffB); PG8_STAGE(PG8_SA(0, 0), cA, voffA); PG8_STAGE(PG8_SB(0, 1), cB + hstep, voffB); PG8_STAGE(PG8_SA(0, 1), cA + hstep, voffA);
        if (wr == 1) PG8_BAR;
        PG8_WAIT_V(4); PG8_BAR;
        PG8_STAGE(PG8_SB(1, 0), cB + kstep, voffB); PG8_STAGE(PG8_SA(1, 0), cA + kstep, voffA); PG8_STAGE(PG8_SB(1, 1), cB + hstep + kstep, voffB);
        PG8_WAIT_V(6); PG8_BAR;
    }
    for (;;) {
        const bool has_next = S.next(ui + 1, nxt);
        const char* nA = has_next ? (const char*)g.A + (size_t)nxt.pm * tstep : cA; const char* nB = has_next ? (const char*)g.Bt + (size_t)nxt.pn * tstep : cB;
        for (int t = 0; t < nt; t += 2) {
            const bool last = (t == nt - 2);
            const char* a1 = cA + (size_t)(t + 1) * kstep;
            const char* a2 = last ? nA : cA + (size_t)(t + 2) * kstep; const char* b2 = last ? nB : cB + (size_t)(t + 2) * kstep;
            const char* a3 = a2 + kstep; const char* b3 = b2 + kstep;
            if (last && has_next) S.a_ready(nxt);
            if constexpr (SP2) {
            PG8_LDB(B0, 0, 0); PG8_LDB(B1, 0, 1); PG8_SCHED; PG8_LDA(At, 0, 0); PG8_STAGE(PG8_SA(1, 1), a1 + hstep, voffA);
            PG8_WAIT_V(8); PG8_WAIT_L(0); PG8_BAR; PG8_MMA(0, 0, At, B0); PG8_MMA(0, 1, At, B1); PG8_BAR; PG8_SCHED;
            PG8_LDA(At, 0, 1); PG8_STAGE(PG8_SB(0, 0), b2, voffB); PG8_STAGE(PG8_SB(0, 1), b2 + hstep, voffB); PG8_STAGE(PG8_SA(0, 0), a2, voffA);
            PG8_WAIT_V(8); PG8_WAIT_L(0); PG8_BAR; PG8_MMA(1, 0, At, B0); PG8_MMA(1, 1, At, B1); PG8_BAR; PG8_SCHED;
            PG8_LDB(B0, 1, 0); PG8_LDB(B1, 1, 1); PG8_SCHED; PG8_LDA(At, 1, 0); PG8_STAGE(PG8_SA(0, 1), a2 + hstep, voffA);
            PG8_WAIT_V(8); PG8_WAIT_L(0); PG8_BAR; PG8_MMA(0, 0, At, B0); PG8_MMA(0, 1, At, B1); PG8_BAR; PG8_SCHED;
            PG8_LDA(At, 1, 1); PG8_STAGE(PG8_SB(1, 0), b3, voffB); PG8_STAGE(PG8_SB(1, 1), b3 + hstep, voffB); PG8_STAGE(PG8_SA(1, 0), a3, voffA);
            PG8_WAIT_V(8); PG8_WAIT_L(0); PG8_BAR; PG8_MMA(1, 0, At, B0); PG8_MMA(1, 1, At, B1); PG8_BAR; PG8_SCHED;
            } else {
            PG8_LDB(B0, 0, 0); PG8_SCHED; PG8_LDA(At, 0, 0); PG8_STAGE(PG8_SA(1, 1), a1 + hstep, voffA);
            PG8_WAIT_L(8); PG8_BAR; PG8_WAIT_L(0); PG8_MMA(0, 0, At, B0); PG8_BAR; PG8_SCHED;
            PG8_LDB(B1, 0, 1); PG8_STAGE(PG8_SB(0, 0), b2, voffB);
            PG8_BAR; PG8_WAIT_L(0); PG8_MMA(0, 1, At, B1); PG8_BAR;
            PG8_LDA(At, 0, 1); PG8_STAGE(PG8_SA(0, 0), a2, voffA);
            PG8_BAR; PG8_WAIT_L(0); PG8_MMA(1, 0, At, B0); PG8_BAR; PG8_SCHED;
            PG8_STAGE(PG8_SB(0, 1), b2 + hstep, voffB);
            PG8_WAIT_V(6); PG8_BAR; PG8_MMA(1, 1, At, B1); PG8_BAR;
            PG8_LDB(B0, 1, 0); PG8_SCHED; PG8_LDA(At, 1, 0); PG8_STAGE(PG8_SA(0, 1), a2 + hstep, voffA);
            PG8_WAIT_L(8); PG8_BAR; PG8_WAIT_L(0); PG8_MMA(0, 0, At, B0); PG8_BAR; PG8_SCHED;
            PG8_LDB(B1, 1, 1); PG8_STAGE(PG8_SB(1, 0), b3, voffB);
            PG8_BAR; PG8_WAIT_L(0); PG8_MMA(0, 1, At, B1); PG8_BAR;
            PG8_LDA(At, 1, 1); PG8_STAGE(PG8_SA(1, 0), a3, voffA);
            PG8_BAR; PG8_WAIT_L(0); PG8_MMA(1, 0, At, B0); PG8_BAR; PG8_SCHED;
            PG8_STAGE(PG8_SB(1, 1), b3 + hstep, voffB);
            PG8_WAIT_V(6); PG8_BAR; PG8_MMA(1, 1, At, B1); PG8_BAR;
            }
        }
        if constexpr (ALIGN_EPI) { if (wr == 0) PG8_BAR; }
        if constexpr (!Epi::AFTER_DRAIN) { E(acc, cur, wr, wc, fr, fq); S.done(cur); }
        if (!has_next) break;
#pragma unroll
        for (int a = 0; a < 2; ++a)
#pragma unroll
            for (int b = 0; b < 2; ++b)
#pragma unroll
                for (int m = 0; m < 4; ++m)
#pragma unroll
                    for (int n = 0; n < 2; ++n) acc[a][b][m][n] = (f32x4){0.f, 0.f, 0.f, 0.f};
        cur = nxt; cA = nA; cB = nB; ++ui;
        if constexpr (ALIGN_EPI) { if (wr == 1) PG8_BAR; }
    }
    PG8_WAIT_V(0);
    if constexpr (!ALIGN_EPI) { if (wr == 0) PG8_BAR; }
    PG8_BAR;
    if constexpr (Epi::AFTER_DRAIN) { E.fused(acc, cur, wr, wc, fr, fq, lds, wid, lane); S.done(cur); }
#undef PG8_SA
#undef PG8_SB
#undef PG8_STAGE
#undef PG8_LDA
#undef PG8_LDB
#undef PG8_MMA
#undef PG8_WAIT_V
#undef PG8_WAIT_L
#undef PG8_BAR
#undef PG8_SCHED
}
}

namespace pg8 {
struct EpiResid {
    static constexpr bool PERM = false, AFTER_DRAIN = false;
    const float* base; float* out; int ldc; float alpha;
    __device__ __forceinline__ void operator()(const f32x4 (&acc)[2][2][4][2], const Unit& u, int wr, int wc, int fr, int fq) const {
        const int col0 = u.pn * BM + wc * 32 + 4 * fq;
#pragma unroll
        for (int ai = 0; ai < 2; ++ai)
#pragma unroll
            for (int m = 0; m < 4; ++m) { const int r = ai * HALF + wr * 64 + m * 16 + fr; const size_t off = (size_t)(u.pm * BM + r) * ldc + col0;
#pragma unroll
                for (int bj = 0; bj < 2; ++bj)
#pragma unroll
                    for (int n = 0; n < 2; ++n) { const f32x4 bs = *(const f32x4*)(base + off + bj * HALF + n * 16);
                        const f32x4 o = bs * alpha + acc[ai][bj][m][n]; *(f32x4*)(out + off + bj * HALF + n * 16) = o; }
                if (m & 1) asm volatile("" ::: "memory"); }
    }
};

struct EpiResLn {
    static constexpr bool PERM = false, AFTER_DRAIN = true;
    const float* base; float* out; bf16_t* xn; bf16_t* xl; const float* lg; const float* lb; unsigned long long* xbuf; unsigned* cnt; float alpha, eps;
    __device__ __forceinline__ void fused(f32x4 (&acc)[2][2][4][2], const Unit& u, int wr, int wc, int fr, int fq, PG8_LAS unsigned char* lds, int wid, int lane) const {
        typedef float f32x2v __attribute__((ext_vector_type(2))); typedef unsigned u32x2v __attribute__((ext_vector_type(2)));
        PG8_LAS f32x2v* P = (PG8_LAS f32x2v*)lds;
        PG8_LAS f32x2v* S = (PG8_LAS f32x2v*)(lds + 8192);
        const int col0 = u.pn * BM + wc * 32 + 4 * fq;
#pragma unroll
        for (int ai = 0; ai < 2; ++ai)
#pragma unroll
            for (int m = 0; m < 4; ++m) { const size_t off = (size_t)(u.pm * BM + ai * HALF + wr * 64 + m * 16 + fr) * 2048 + col0;
#pragma unroll
                for (int bj = 0; bj < 2; ++bj)
#pragma unroll
                    for (int n = 0; n < 2; ++n) { f32x4 bs;
                        if (base) bs = *(const f32x4*)(base + off + bj * HALF + n * 16);
                        else { const u32x2v h = *(const u32x2v*)(xn + off + bj * HALF + n * 16), q = *(const u32x2v*)(xl + off + bj * HALF + n * 16);
                            bs[0] = __uint_as_float(h.x << 16) + __uint_as_float(q.x << 16); bs[1] = __uint_as_float(h.x & 0xffff0000u) + __uint_as_float(q.x & 0xffff0000u);
                            bs[2] = __uint_as_float(h.y << 16) + __uint_as_float(q.y << 16); bs[3] = __uint_as_float(h.y & 0xffff0000u) + __uint_as_float(q.y & 0xffff0000u); }
                        acc[ai][bj][m][n] = bs * alpha + acc[ai][bj][m][n]; }
                asm volatile("" : "+v"(acc[ai][0][m][0]), "+v"(acc[ai][0][m][1]), "+v"(acc[ai][1][m][0]), "+v"(acc[ai][1][m][1]));
                if (m == 3) asm volatile("" ::: "memory"); }
#pragma unroll
        for (int ai = 0; ai < 2; ++ai)
#pragma unroll
            for (int m = 0; m < 4; ++m) {
                float s = 0.f;
#pragma unroll
                for (int bj = 0; bj < 2; ++bj)
#pragma unroll
                    for (int n = 0; n < 2; ++n) { const f32x4 x = acc[ai][bj][m][n]; s += (x[0] + x[1]) + (x[2] + x[3]); }
                s += __shfl_xor(s, 16); s += __shfl_xor(s, 32);
                const float mw = s * (1.0f / 64.0f); float q = 0.f;
#pragma unroll
                for (int bj = 0; bj < 2; ++bj)
#pragma unroll
                    for (int n = 0; n < 2; ++n) { const f32x4 d = acc[ai][bj][m][n] - mw; q += (d[0] * d[0] + d[1] * d[1]) + (d[2] * d[2] + d[3] * d[3]); }
                q += __shfl_xor(q, 16); q += __shfl_xor(q, 32);
                if (fq == 0) P[(ai * HALF + wr * 64 + m * 16 + fr) * 4 + wc] = (f32x2v){mw, q};
            }
        asm volatile("s_waitcnt lgkmcnt(0)" ::: "memory"); __builtin_amdgcn_s_barrier(); asm volatile("" ::: "memory");
        const int row = wid * 32 + (lane & 31);
        if (lane < 32) {
            const f32x2v a = P[row * 4 + 0], b = P[row * 4 + 1], c = P[row * 4 + 2], d = P[row * 4 + 3];
            const float mt = (a.x + b.x + c.x + d.x) * 0.25f;
            const float da = a.x - mt, db = b.x - mt, dc = c.x - mt, dd = d.x - mt;
            const float m2 = (a.y + b.y) + (c.y + d.y) + 64.0f * ((da * da + db * db) + (dc * dc + dd * dd));
            unsigned long long* slot = xbuf + ((size_t)(u.pm * BM + row) * 8 + u.pn);
            __hip_atomic_store(slot, ((unsigned long long)__float_as_uint(m2) << 32) | __float_as_uint(mt), __ATOMIC_RELAXED, __HIP_MEMORY_SCOPE_AGENT);
        }
        asm volatile("s_waitcnt vmcnt(0)" ::: "memory");
        if (lane == 0) __hip_atomic_fetch_add(cnt + 64 * u.pm, 1u, __ATOMIC_RELAXED, __HIP_MEMORY_SCOPE_AGENT);
        if (wid == 0) {
            unsigned sp = 0;
            while ((unsigned)__builtin_amdgcn_readfirstlane(__hip_atomic_load(cnt + 64 * u.pm, __ATOMIC_RELAXED, __HIP_MEMORY_SCOPE_AGENT)) < 64u) { __builtin_amdgcn_s_sleep(2); if (++sp > (1u << 22)) break; }
            __builtin_amdgcn_fence(__ATOMIC_ACQUIRE, "agent");
        }
        asm volatile("s_waitcnt vmcnt(0) lgkmcnt(0)" ::: "memory"); __builtin_amdgcn_s_barrier(); asm volatile("" ::: "memory");
        if (lane < 32) {
            const unsigned long long* slot = xbuf + (size_t)(u.pm * BM + row) * 8; float mt[8], m2[8]; float ms = 0.f;
#pragma unroll
            for (int t = 0; t < 8; ++t) { const unsigned long long w = __hip_atomic_load(slot + t, __ATOMIC_RELAXED, __HIP_MEMORY_SCOPE_AGENT); mt[t] = __uint_as_float((unsigned)w); m2[t] = __uint_as_float((unsigned)(w >> 32)); ms += mt[t]; }
            const float mean = ms * 0.125f; float q = 0.f;
#pragma unroll
            for (int t = 0; t < 8; ++t) { const float dm = mt[t] - mean; q += m2[t] + 256.0f * dm * dm; }
            S[row] = (f32x2v){mean, 1.0f / sqrtf(q * (1.0f / 2048.0f) + eps)};
        }
        asm volatile("s_waitcnt lgkmcnt(0)" ::: "memory"); __builtin_amdgcn_s_barrier(); asm volatile("" ::: "memory");
#pragma unroll
        for (int bj = 0; bj < 2; ++bj)
#pragma unroll
            for (int n = 0; n < 2; ++n) { const f32x4 gg = *(const f32x4*)(lg + col0 + bj * HALF + n * 16), bb = *(const f32x4*)(lb + col0 + bj * HALF + n * 16);
#pragma unroll
                for (int ai = 0; ai < 2; ++ai)
#pragma unroll
                    for (int m = 0; m < 4; ++m) { const int r = ai * HALF + wr * 64 + m * 16 + fr; const f32x2v sr = S[r]; const size_t off = (size_t)(u.pm * BM + r) * 2048 + col0 + bj * HALF + n * 16;
                        const f32x4 y = (acc[ai][bj][m][n] - sr.x) * sr.y * gg + bb;
                        if (out) *(f32x4*)(out + off) = y;
                        else { u32x2v w; w.x = cvt_pk_bf16(y[0], y[1]); w.y = cvt_pk_bf16(y[2], y[3]); *(u32x2v*)(xn + off) = w;
                            u32x2v q; q.x = cvt_pk_bf16(y[0] - __uint_as_float(w.x << 16), y[1] - __uint_as_float(w.x & 0xffff0000u)); q.y = cvt_pk_bf16(y[2] - __uint_as_float(w.y << 16), y[3] - __uint_as_float(w.y & 0xffff0000u));
                            *(u32x2v*)(xl + off) = q; } } }
    }
};
}

#define LAS __attribute__((address_space(3)))
#define GAS __attribute__((address_space(1)))
typedef unsigned short bf16_t;
typedef short bf16x8 __attribute__((ext_vector_type(8)));
typedef short bf16x4 __attribute__((ext_vector_type(4)));
typedef float f32x4 __attribute__((ext_vector_type(4)));
typedef unsigned u32x4 __attribute__((ext_vector_type(4)));
typedef unsigned u32x2 __attribute__((ext_vector_type(2)));

constexpr int SEQ = 8192, DM = 2048, DEPTH = 4, INW = 6672, NMEM = 256;
constexpr int NMAIN = 5376, NVT = 1536, NWT = NMAIN + NVT;
constexpr int C_AQ = 0, C_AK = 1024, C_AZ = 2048, C_BQ = 3072, C_BK = 3328, C_BZ = 3584, C_MQ = 4096, C_MZ = 4608, C_LR = 5120;
constexpr int NCH = SEQ / 64;
constexpr float LN_EPS = 1e-5f, RMS_EPS = 1e-6f;
constexpr float LOG2E = 1.4426950408889634f;
constexpr float ATT_SC = 0.08838834764831845f * LOG2E;
constexpr int LDS_BYTES = 147456;

constexpr size_t MiB = 1u << 20;
constexpr size_t WS_WIN = 0, WIN_L = (size_t)NWT * DM * 2;
constexpr size_t WS_WOUT = 112 * MiB, WOUT_L = (size_t)DM * DM * 2;
constexpr size_t WS_WMK = 144 * MiB, WS_WMV = 152 * MiB;
constexpr size_t WS_MEMB = 160 * MiB, WS_MK = 161 * MiB, WS_MVT = 162 * MiB;
constexpr size_t WS_XB = 164 * MiB, WS_XF = 196 * MiB, WS_HM = 260 * MiB, WS_Y = 368 * MiB;
constexpr int LDV = SEQ + 64;
constexpr size_t WS_U = 400 * MiB, WS_SP = 416 * MiB, WS_DCY = 424 * MiB, WS_CTL = 426 * MiB, CTL_BYTES = 65536, WS_XCH = 427 * MiB, WS_VT = 428 * MiB, WS_BG = 454 * MiB, WS_XL = 462 * MiB, WS_END = 494 * MiB;
constexpr int CW_CNT = 4096;
static_assert(WS_WIN + 4 * WIN_L <= WS_WOUT, "ws map");
static_assert(WS_HM + (size_t)SEQ * NMAIN * 2 <= WS_Y, "ws map");

struct Params {
    const float *x, *mem, *w_in, *rel, *gate_w, *gate_b, *norm_g, *w_mkv, *w_out, *ln_g, *ln_b;
    float* out; unsigned char* ws; int ph_lo, ph_hi;
};

typedef float f32x2_t __attribute__((ext_vector_type(2))); typedef __bf16 bf16x2_t __attribute__((ext_vector_type(2)));
__device__ __forceinline__ unsigned pk2(float lo, float hi) { const f32x2_t v = {lo, hi}; const bf16x2_t b = __builtin_convertvector(v, bf16x2_t); return __builtin_bit_cast(unsigned, b); }
__device__ __forceinline__ float bflo(unsigned w) { return __uint_as_float(w << 16); }
__device__ __forceinline__ float bfhi(unsigned w) { return __uint_as_float(w & 0xffff0000u); }
__device__ __forceinline__ float silu_f(float z) { return z / (1.0f + __expf(-z)); }
#define MFMA16(a, b, c) __builtin_amdgcn_mfma_f32_16x16x32_bf16((a), (b), (c), 0, 0, 0)

struct ConvItem { const GAS float* src; GAS bf16_t* dst; int ldw; bool ok; };
__device__ __forceinline__ void conv_load(const ConvItem& d, f32x4 (&v)[8]) {
#pragma unroll
    for (int i = 0; i < 8; ++i) v[i] = d.ok ? *(const GAS f32x4*)(d.src + (size_t)(8 * i) * d.ldw) : (f32x4){0.f, 0.f, 0.f, 0.f};
}
__device__ __forceinline__ void conv_store(const ConvItem& d, const f32x4 (&v)[8], LAS float* scr, int lane) {
    const int n4 = 4 * (lane & 7), kr = lane >> 3;
#pragma unroll
    for (int i = 0; i < 8; ++i) { LAS float* q = scr + (8 * i + kr) * 33 + n4; q[0] = v[i].x; q[1] = v[i].y; q[2] = v[i].z; q[3] = v[i].w; }
    asm volatile("s_waitcnt lgkmcnt(0)" ::: "memory");
    const int c = lane & 7;
#pragma unroll
    for (int j = 0; j < 4; ++j) { const int n = (lane >> 3) + 8 * j; const LAS float* s = scr + (8 * c) * 33 + n;
        u32x4 o; o.x = pk2(s[0 * 33], s[1 * 33]); o.y = pk2(s[2 * 33], s[3 * 33]); o.z = pk2(s[4 * 33], s[5 * 33]); o.w = pk2(s[6 * 33], s[7 * 33]);
        *(GAS u32x4*)(d.dst + (size_t)n * DM + 8 * c) = o; }
    asm volatile("s_waitcnt lgkmcnt(0)" ::: "memory");
}
__device__ __forceinline__ void in_seg(int drow, int& src_col, int& nvalid) {
    nvalid = 32;
    if (drow < 2048) src_col = drow;
    else if (drow < 3072) src_col = 3072 + (drow - 2048);
    else if (drow < 3328) src_col = 4096 + (drow - 3072);
    else if (drow < 3584) src_col = 4352 + (drow - 3328);
    else if (drow < 4096) src_col = 5120 + (drow - 3584);
    else if (drow < 4608) src_col = 5648 + (drow - 4096);
    else if (drow < 5120) src_col = 6160 + (drow - 4608);
    else if (drow < 5376) { src_col = 5632; nvalid = (drow == 5120) ? 16 : 0; }
    else if (drow < 6400) src_col = 2048 + (drow - 5376);
    else src_col = 4608 + (drow - 6400);
}
__device__ __forceinline__ ConvItem conv_decode(const Params& p, int l, int it, int lane) {
    constexpr int I_IN = 32 * (NWT / 32), I_OUT = 32 * (DM / 32);
    const int n4 = 4 * (lane & 7), kr = lane >> 3;
    ConvItem d; int r = it;
    if (r < I_IN) { const int g_ = r >> 5, nb = 8 * (g_ % 27) + (r & 7), k0 = 64 * (4 * (g_ / 27) + ((r >> 3) & 3)); int sc, nv; in_seg(32 * nb, sc, nv);
        d.ldw = INW; d.ok = n4 < nv; d.src = (const GAS float*)p.w_in + (size_t)l * DM * INW + (size_t)(k0 + kr) * INW + sc + n4;
        d.dst = (GAS bf16_t*)(p.ws + WS_WIN + l * WIN_L) + (size_t)(32 * nb) * DM + k0; return d; }
    r -= I_IN;
    if (r < I_OUT) { const int g_ = r >> 5, nb = 8 * (g_ % 8) + (r & 7), k0 = 64 * (4 * (g_ / 8) + ((r >> 3) & 3));
        d.ldw = DM; d.ok = true; d.src = (const GAS float*)p.w_out + (size_t)l * DM * DM + (size_t)(k0 + kr) * DM + 32 * nb + n4;
        d.dst = (GAS bf16_t*)(p.ws + WS_WOUT + l * WOUT_L) + (size_t)(32 * nb) * DM + k0; return d; }
    r -= I_OUT;
    { const int g_ = r >> 5, nb = 8 * (g_ % 4) + (r & 7), k0 = 64 * (4 * (g_ / 4) + ((r >> 3) & 3));
        d.ldw = 1024; d.ok = true; d.src = (const GAS float*)p.w_mkv + (size_t)l * DM * 1024 + (size_t)(k0 + kr) * 1024 + 32 * nb + n4;
        d.dst = (GAS bf16_t*)(p.ws + (nb < 16 ? WS_WMK : WS_WMV)) + (size_t)(l * 512 + 32 * (nb & 15)) * DM + k0; return d; }
}
__device__ __forceinline__ void convert_layer(const Params& p, int l, LAS unsigned char* lds, int wk, int nwk) {
    int tid_ = threadIdx.x; asm volatile("" : "+v"(tid_)); const int tid = tid_, lane = tid & 63, wave = tid >> 6;
    LAS float* scr = (LAS float*)(lds + wave * 8704);
    constexpr int I_L = 32 * (NWT / 32) + 32 * (DM / 32) + 32 * 32;
    if (wk >= I_L) return;
    ConvItem cur = conv_decode(p, l, wk, lane); f32x4 v[8]; conv_load(cur, v);
    for (int it = wk; it < I_L; it += nwk) {
        const int nx = it + nwk; ConvItem nxt = cur; f32x4 v2[8];
        if (nx < I_L) { nxt = conv_decode(p, l, nx, lane); conv_load(nxt, v2); }
        conv_store(cur, v, scr, lane);
        if (nx < I_L) { cur = nxt;
#pragma unroll
            for (int i = 0; i < 8; ++i) v[i] = v2[i]; }
    }
}
__device__ __forceinline__ void phase0(const Params& p, LAS unsigned char* lds) {
    int tid_ = threadIdx.x; asm volatile("" : "+v"(tid_)); const int tid = tid_, wave = tid >> 6;
    convert_layer(p, 0, lds, blockIdx.x * 8 + wave, gridDim.x * 8);
    const size_t gt = (size_t)blockIdx.x * 512 + tid, NT = (size_t)gridDim.x * 512;
    GAS bf16_t* xb = (GAS bf16_t*)(p.ws + WS_XB); const GAS f32x4* xs = (const GAS f32x4*)p.x;
    for (size_t i = gt; i < (size_t)SEQ * DM / 8; i += NT) { const f32x4 a = xs[2 * i], b = xs[2 * i + 1];
        u32x4 o; o.x = pk2(a.x, a.y); o.y = pk2(a.z, a.w); o.z = pk2(b.x, b.y); o.w = pk2(b.z, b.w); ((GAS u32x4*)xb)[i] = o; }
    GAS bf16_t* mb = (GAS bf16_t*)(p.ws + WS_MEMB); const GAS f32x4* ms = (const GAS f32x4*)p.mem;
    for (size_t i = gt; i < (size_t)NMEM * DM / 8; i += NT) { const f32x4 a = ms[2 * i], b = ms[2 * i + 1];
        u32x4 o; o.x = pk2(a.x, a.y); o.y = pk2(a.z, a.w); o.z = pk2(b.x, b.y); o.w = pk2(b.z, b.w); ((GAS u32x4*)mb)[i] = o; }
}

constexpr int A_KS = 0, A_KSZ = 64 * 272, A_VS = 2 * A_KSZ, A_VSZ = 128 * 144, A_BT = A_VS + 2 * A_VSZ;
template <bool BAND>
__device__ __forceinline__ void attn_step(LAS unsigned char* lds, int buf, int t, int cw, int w, int r16, int g, const bf16x8 (&qf)[4], f32x4 (&o)[8], float& m, float& l) {
    const LAS float* btab = (const LAS float*)(lds + A_BT);
    const LAS unsigned char* kb_ = lds + A_KS + buf * A_KSZ + r16 * 272 + g * 16;
    f32x4 s[4];
#pragma unroll
    for (int kb = 0; kb < 4; ++kb) { s[kb] = (f32x4){0.f, 0.f, 0.f, 0.f}; bf16x8 kfr[4];
#pragma unroll
        for (int ks = 0; ks < 4; ++ks) kfr[ks] = *(const LAS bf16x8*)(kb_ + kb * 16 * 272 + ks * 64);
#pragma unroll
        for (int ks = 0; ks < 4; ++ks) s[kb] = MFMA16(kfr[ks], qf[ks], s[kb]); }
    if (BAND) {
        const int delta = cw + 8 - t;
        if (delta >= 3) { const float bc = btab[256];
#pragma unroll
            for (int kb = 0; kb < 4; ++kb) s[kb] = s[kb] * ATT_SC + bc;
        } else { const int qi = 16 * (w & 3) + r16;
#pragma unroll
            for (int kb = 0; kb < 4; ++kb)
#pragma unroll
                for (int r = 0; r < 4; ++r) { int dist = 64 * delta + qi - (16 * kb + 4 * g + r); dist = dist > 128 ? 128 : (dist < -128 ? -128 : dist);
                    s[kb][r] = s[kb][r] * ATT_SC + btab[dist + 128]; }
        }
    } else {
#pragma unroll
        for (int kb = 0; kb < 4; ++kb) s[kb] = s[kb] * ATT_SC;
    }
    float mt = fmaxf(fmaxf(s[0][0], s[0][1]), fmaxf(s[0][2], s[0][3]));
#pragma unroll
    for (int kb = 1; kb < 4; ++kb) mt = fmaxf(mt, fmaxf(fmaxf(s[kb][0], s[kb][1]), fmaxf(s[kb][2], s[kb][3])));
    mt = fmaxf(mt, __shfl_xor(mt, 16)); mt = fmaxf(mt, __shfl_xor(mt, 32));
    const float mn = fmaxf(m, mt), alpha = __builtin_amdgcn_exp2f(m - mn); m = mn;
    float rs = 0.f;
#pragma unroll
    for (int kb = 0; kb < 4; ++kb)
#pragma unroll
        for (int r = 0; r < 4; ++r) { const float pv = __builtin_amdgcn_exp2f(s[kb][r] - mn); s[kb][r] = pv; rs += pv; }
    l = l * alpha + rs;
    if (__any(alpha != 1.0f)) {
#pragma unroll
        for (int i = 0; i < 8; ++i) o[i] = o[i] * alpha; }
    bf16x8 pb[2];
#pragma unroll
    for (int s2 = 0; s2 < 2; ++s2) { u32x4 pw; pw.x = pk2(s[2 * s2][0], s[2 * s2][1]); pw.y = pk2(s[2 * s2][2], s[2 * s2][3]);
        pw.z = pk2(s[2 * s2 + 1][0], s[2 * s2 + 1][1]); pw.w = pk2(s[2 * s2 + 1][2], s[2 * s2 + 1][3]); pb[s2] = __builtin_bit_cast(bf16x8, pw); }
    int voff_ = 0; asm volatile("" : "+v"(voff_), "+v"(pb[1]));
    const LAS unsigned char* vb_ = lds + A_VS + buf * A_VSZ + r16 * 144 + g * 8 + voff_;
    u32x2 vfr[2][4];
#pragma unroll
    for (int q = 0; q < 4; ++q) vfr[0][q] = *(const LAS u32x2*)(vb_ + (q >> 1) * 64 + (q & 1) * 32);
#pragma unroll
    for (int dvb = 0; dvb < 8; ++dvb) {
        if (dvb < 7) {
#pragma unroll
            for (int q = 0; q < 4; ++q) vfr[(dvb + 1) & 1][q] = *(const LAS u32x2*)(vb_ + (dvb + 1) * 16 * 144 + (q >> 1) * 64 + (q & 1) * 32); }
#pragma unroll
        for (int s2 = 0; s2 < 2; ++s2) { const u32x2 lo = vfr[dvb & 1][2 * s2], hi = vfr[dvb & 1][2 * s2 + 1];
            const u32x4 av = (u32x4){lo.x, lo.y, hi.x, hi.y}; o[dvb] = MFMA16(__builtin_bit_cast(bf16x8, av), pb[s2], o[dvb]); } }
}
template <bool BAND>
__device__ __forceinline__ void attn_unit(LAS unsigned char* lds, int q_row0, const bf16_t* Qh, int ldq, const bf16_t* Kh, int ldk, const bf16_t* Vth, int ldvt,
                                          const bf16_t* Zh, int ldz, bf16_t* Yh, int ldy, const float* bias_tab, int j2) {
    int tid_ = threadIdx.x; asm volatile("" : "+v"(tid_)); const int tid = tid_, lane = tid & 63, w = __builtin_amdgcn_readfirstlane(tid >> 6), r16 = lane & 15, g = lane >> 4;
    LAS float* btab = (LAS float*)(lds + A_BT);
    if (BAND) { for (int i = tid; i < 257; i += 512) btab[i] = ((const GAS float*)bias_tab)[i] * LOG2E; }
    const GAS bf16_t* qp = (const GAS bf16_t*)Qh + (size_t)(q_row0 + 16 * w + r16) * ldq + 8 * g;
    bf16x8 qf[4];
#pragma unroll
    for (int ks = 0; ks < 4; ++ks) qf[ks] = *(const GAS bf16x8*)(qp + 32 * ks);
    f32x4 o[8];
#pragma unroll
    for (int i = 0; i < 8; ++i) o[i] = (f32x4){0.f, 0.f, 0.f, 0.f};
    float m = -1e30f, l = 0.f;
    const int cw = BAND ? (w >> 2) : 0;
    const int nt = BAND ? 10 : 4;
    int t0 = 0; if (BAND) { t0 = 8 - 2 * j2; if (t0 < 0) t0 = 0; }
    u32x4 kA[2], vA[2], kB[2], vB[2];
#define A_GLOAD(kr, vr, t) do { const int key0_ = BAND ? 64 * (2 * j2 - 8 + (t)) : 64 * (t); \
        _Pragma("unroll") for (int i_ = 0; i_ < 2; ++i_) { const int id_ = tid + 512 * i_; \
            kr[i_] = *(const GAS u32x4*)((const GAS bf16_t*)Kh + (size_t)(key0_ + (id_ >> 4)) * ldk + (id_ & 15) * 8); \
            vr[i_] = *(const GAS u32x4*)((const GAS bf16_t*)Vth + (size_t)(id_ >> 3) * ldvt + key0_ + (id_ & 7) * 8); } } while (0)
#define A_LSTORE(kr, vr, buf) do { _Pragma("unroll") for (int i_ = 0; i_ < 2; ++i_) { const int id_ = tid + 512 * i_; \
            *(LAS u32x4*)(lds + A_KS + (buf) * A_KSZ + (id_ >> 4) * 272 + (id_ & 15) * 16) = kr[i_]; \
            *(LAS u32x4*)(lds + A_VS + (buf) * A_VSZ + (id_ >> 3) * 144 + (id_ & 7) * 16) = vr[i_]; } } while (0)
    A_GLOAD(kA, vA, t0); A_GLOAD(kB, vB, t0 + 1); A_LSTORE(kA, vA, 0); __syncthreads();
    for (int t = t0; t < nt; t += 2) {
        if (t + 2 < nt) A_GLOAD(kA, vA, t + 2);
        if (!BAND || (t >= cw && t <= cw + 8)) attn_step<BAND>(lds, 0, t, cw, w, r16, g, qf, o, m, l);
        A_LSTORE(kB, vB, 1);
        __syncthreads();
        if (t + 3 < nt) A_GLOAD(kB, vB, t + 3);
        if (!BAND || (t + 1 >= cw && t + 1 <= cw + 8)) attn_step<BAND>(lds, 1, t + 1, cw, w, r16, g, qf, o, m, l);
        if (t + 2 < nt) A_LSTORE(kA, vA, 0);
        __syncthreads();
    }
#undef A_GLOAD
#undef A_LSTORE
    l += __shfl_xor(l, 16); l += __shfl_xor(l, 32);
    const float inv = 1.0f / l;
    const size_t row = (size_t)(q_row0 + 16 * w + r16);
#pragma unroll
    for (int dvb = 0; dvb < 8; ++dvb) { const int col = 16 * dvb + 4 * g; const u32x2 z = *(const GAS u32x2*)((const GAS bf16_t*)Zh + row * ldz + col);
        const float y0 = o[dvb][0] * inv * silu_f(bflo(z.x)), y1 = o[dvb][1] * inv * silu_f(bfhi(z.x)), y2 = o[dvb][2] * inv * silu_f(bflo(z.y)), y3 = o[dvb][3] * inv * silu_f(bfhi(z.y));
        u32x2 yo; yo.x = pk2(y0, y1); yo.y = pk2(y2, y3); *(GAS u32x2*)((GAS bf16_t*)Yh + row * ldy + col) = yo; }
}


constexpr int P_HALF = 2 * A_KSZ + 2 * A_VSZ, P_BT = 2 * P_HALF;
static_assert(P_BT + 2 * 1028 <= LDS_BYTES - 64, "pair attention LDS map");
__device__ __forceinline__ void band_pair_step(LAS unsigned char* hl, const LAS float* btab, int buf, int t, int cw, int w4, int r16, int g,
                                               const bf16x8 (&qf)[2][4], f32x4 (&o)[2][8], float (&m)[2], f32x4 (&l)[2]) {
    const LAS unsigned char* kb_ = hl + buf * A_KSZ + r16 * 272 + g * 16;
    f32x4 s[2][4];
#pragma unroll
    for (int kb = 0; kb < 4; ++kb) { bf16x8 kfr[4];
#pragma unroll
        for (int ks = 0; ks < 4; ++ks) kfr[ks] = *(const LAS bf16x8*)(kb_ + kb * 16 * 272 + ks * 64);
#pragma unroll
        for (int rb = 0; rb < 2; ++rb) { s[rb][kb] = (f32x4){0.f, 0.f, 0.f, 0.f};
#pragma unroll
            for (int ks = 0; ks < 4; ++ks) s[rb][kb] = MFMA16(kfr[ks], qf[rb][ks], s[rb][kb]); } }
    const int delta = cw + 8 - t;
    bf16x8 pb[2][2];
    const bf16x8 ones = (bf16x8){16256, 16256, 16256, 16256, 16256, 16256, 16256, 16256};
#pragma unroll
    for (int rb = 0; rb < 2; ++rb) {
        float mn, alpha;
        if (delta >= 3) {
            const float bc = btab[256];
            float mt = fmaxf(fmaxf(s[rb][0][0], s[rb][0][1]), fmaxf(s[rb][0][2], s[rb][0][3]));
#pragma unroll
            for (int kb = 1; kb < 4; ++kb) mt = fmaxf(mt, fmaxf(fmaxf(s[rb][kb][0], s[rb][kb][1]), fmaxf(s[rb][kb][2], s[rb][kb][3])));
            mt = fmaxf(mt, __shfl_xor(mt, 16)); mt = fmaxf(mt, __shfl_xor(mt, 32));
            mn = fmaxf(m[rb], mt * ATT_SC + bc); alpha = __builtin_amdgcn_exp2f(m[rb] - mn); m[rb] = mn;
            const float off = bc - mn;
#pragma unroll
            for (int kb = 0; kb < 4; ++kb)
#pragma unroll
                for (int r = 0; r < 4; ++r) s[rb][kb][r] = __builtin_amdgcn_exp2f(s[rb][kb][r] * ATT_SC + off);
        } else { const int qi = 32 * (w4 & 1) + 16 * rb + r16;
#pragma unroll
            for (int kb = 0; kb < 4; ++kb)
#pragma unroll
                for (int r = 0; r < 4; ++r) { int dist = 64 * delta + qi - (16 * kb + 4 * g + r); dist = dist > 128 ? 128 : (dist < -128 ? -128 : dist);
                    s[rb][kb][r] = s[rb][kb][r] * ATT_SC + btab[dist + 128]; }
            float mt = fmaxf(fmaxf(s[rb][0][0], s[rb][0][1]), fmaxf(s[rb][0][2], s[rb][0][3]));
#pragma unroll
            for (int kb = 1; kb < 4; ++kb) mt = fmaxf(mt, fmaxf(fmaxf(s[rb][kb][0], s[rb][kb][1]), fmaxf(s[rb][kb][2], s[rb][kb][3])));
            mt = fmaxf(mt, __shfl_xor(mt, 16)); mt = fmaxf(mt, __shfl_xor(mt, 32));
            mn = fmaxf(m[rb], mt); alpha = __builtin_amdgcn_exp2f(m[rb] - mn); m[rb] = mn;
#pragma unroll
            for (int kb = 0; kb < 4; ++kb)
#pragma unroll
                for (int r = 0; r < 4; ++r) s[rb][kb][r] = __builtin_amdgcn_exp2f(s[rb][kb][r] - mn);
        }
        if (__any(alpha != 1.0f)) { l[rb] = l[rb] * alpha;
#pragma unroll
            for (int i = 0; i < 8; ++i) o[rb][i] = o[rb][i] * alpha; }
#pragma unroll
        for (int s2 = 0; s2 < 2; ++s2) { u32x4 pw; pw.x = pk2(s[rb][2 * s2][0], s[rb][2 * s2][1]); pw.y = pk2(s[rb][2 * s2][2], s[rb][2 * s2][3]);
            pw.z = pk2(s[rb][2 * s2 + 1][0], s[rb][2 * s2 + 1][1]); pw.w = pk2(s[rb][2 * s2 + 1][2], s[rb][2 * s2 + 1][3]); pb[rb][s2] = __builtin_bit_cast(bf16x8, pw);
            l[rb] = MFMA16(ones, pb[rb][s2], l[rb]); }
    }
    int voff_ = 0; asm volatile("" : "+v"(voff_), "+v"(pb[1][1]));
    const LAS unsigned char* vb_ = hl + 2 * A_KSZ + buf * A_VSZ + r16 * 144 + g * 8 + voff_;
#pragma unroll
    for (int dvb = 0; dvb < 8; ++dvb) { u32x2 vfr[4];
#pragma unroll
        for (int q = 0; q < 4; ++q) vfr[q] = *(const LAS u32x2*)(vb_ + dvb * 16 * 144 + (q >> 1) * 64 + (q & 1) * 32);
#pragma unroll
        for (int s2 = 0; s2 < 2; ++s2) { const u32x4 av = (u32x4){vfr[2 * s2].x, vfr[2 * s2].y, vfr[2 * s2 + 1].x, vfr[2 * s2 + 1].y};
#pragma unroll
            for (int rb = 0; rb < 2; ++rb) o[rb][dvb] = MFMA16(__builtin_bit_cast(bf16x8, av), pb[rb][s2], o[rb][dvb]); } }
}
__device__ __forceinline__ void band_pair_unit(LAS unsigned char* lds, const Params& p, int l, int j2, int hA) {
    int tid_ = threadIdx.x; asm volatile("" : "+v"(tid_)); const int tid = tid_, lane = tid & 63, w = __builtin_amdgcn_readfirstlane(tid >> 6), r16 = lane & 15, g = lane >> 4;
    const int half = w >> 2, w4 = w & 3, th = tid & 255, head = hA + half;
    LAS unsigned char* hl = lds + half * P_HALF;
    LAS float* btab = (LAS float*)(lds + P_BT + half * 1028);
    { const GAS float* bt = (const GAS float*)p.rel + (l * 8 + head) * 257; for (int i = th; i < 257; i += 256) btab[i] = bt[i] * LOG2E; }
    const GAS bf16_t* hm = (const GAS bf16_t*)(p.ws + WS_HM);
    const GAS bf16_t* Kh = hm + C_AK + head * 128; const GAS bf16_t* Vth = (const GAS bf16_t*)(p.ws + WS_VT) + (size_t)(head * 128) * LDV;
    const int row0 = 128 * j2 + 32 * w4 + r16;
    bf16x8 qf[2][4];
#pragma unroll
    for (int rb = 0; rb < 2; ++rb)
#pragma unroll
        for (int ks = 0; ks < 4; ++ks) qf[rb][ks] = *(const GAS bf16x8*)(hm + (size_t)(row0 + 16 * rb) * NMAIN + C_AQ + head * 128 + 32 * ks + 8 * g);
    f32x4 o[2][8];
#pragma unroll
    for (int rb = 0; rb < 2; ++rb)
#pragma unroll
        for (int i = 0; i < 8; ++i) o[rb][i] = (f32x4){0.f, 0.f, 0.f, 0.f};
    float m[2] = {-1e30f, -1e30f}; f32x4 l_[2] = {(f32x4){0.f, 0.f, 0.f, 0.f}, (f32x4){0.f, 0.f, 0.f, 0.f}};
    const int cw = w4 >> 1, nt = 10;
    int t0 = 8 - 2 * j2; if (t0 < 0) t0 = 0;
    u32x4 kr[4], vr[4];
#define P_GLOAD(t) do { const int key0_ = 64 * (2 * j2 - 8 + (t)); \
        _Pragma("unroll") for (int i_ = 0; i_ < 4; ++i_) { const int id_ = th + 256 * i_; \
            kr[i_] = *(const GAS u32x4*)(Kh + (size_t)(key0_ + (id_ >> 4)) * NMAIN + (id_ & 15) * 8); \
            vr[i_] = *(const GAS u32x4*)(Vth + (size_t)(id_ >> 3) * LDV + key0_ + (id_ & 7) * 8); } } while (0)
#define P_LSTORE(buf) do { _Pragma("unroll") for (int i_ = 0; i_ < 4; ++i_) { const int id_ = th + 256 * i_; \
            *(LAS u32x4*)(hl + (buf) * A_KSZ + (id_ >> 4) * 272 + (id_ & 15) * 16) = kr[i_]; \
            *(LAS u32x4*)(hl + 2 * A_KSZ + (buf) * A_VSZ + (id_ >> 3) * 144 + (id_ & 7) * 16) = vr[i_]; } } while (0)
    P_GLOAD(t0); P_LSTORE(0); __syncthreads();
    for (int t = t0; t < nt; ++t) {
        const int buf = (t - t0) & 1;
        if (t + 1 < nt) P_GLOAD(t + 1);
        if (t >= cw && t <= cw + 8) band_pair_step(hl, btab, buf, t, cw, w4, r16, g, qf, o, m, l_);
        if (t + 1 < nt) P_LSTORE(buf ^ 1);
        __syncthreads();
    }
#undef P_GLOAD
#undef P_LSTORE
    GAS bf16_t* Y = (GAS bf16_t*)(p.ws + WS_Y);
#pragma unroll
    for (int rb = 0; rb < 2; ++rb) { const float inv = 1.0f / l_[rb][0]; const size_t row = (size_t)(row0 + 16 * rb);
#pragma unroll
        for (int dvb = 0; dvb < 8; ++dvb) { const int col = 16 * dvb + 4 * g; const u32x2 z = *(const GAS u32x2*)(hm + row * NMAIN + C_AZ + head * 128 + col);
            const float y0 = o[rb][dvb][0] * inv * silu_f(bflo(z.x)), y1 = o[rb][dvb][1] * inv * silu_f(bfhi(z.x)), y2 = o[rb][dvb][2] * inv * silu_f(bflo(z.y)), y3 = o[rb][dvb][3] * inv * silu_f(bfhi(z.y));
            u32x2 yo; yo.x = pk2(y0, y1); yo.y = pk2(y2, y3); *(GAS u32x2*)(Y + row * DM + head * 128 + col) = yo; } }
}

constexpr int G_LR = 0, G_GW = 4096, G_GB = 8192, G_SEG = 8448, G_B = 10496, G_SSQ = 27136, G_QP = 27648, G_QM = 36864, G_KP = 46080, G_KM = 55296,
              G_KD = 64512, G_AT = 73728, G_VT = 82944, G_ST = 101376;
__device__ __forceinline__ void gla_compute_b(LAS unsigned char* lds, const u32x4 v, const float* gw_l, const float* gb_l, int hb) {
    int tid_ = threadIdx.x; asm volatile("" : "+v"(tid_)); const int tid = tid_;
    LAS float* LR = (LAS float*)(lds + G_LR); LAS float* GW = (LAS float*)(lds + G_GW); LAS float* GB = (LAS float*)(lds + G_GB);
    LAS float* SEG = (LAS float*)(lds + G_SEG); LAS float* Bm = (LAS float*)(lds + G_B);
    if (tid < 128) { const int row = tid >> 1, half = tid & 1;
        LAS float* d = LR + row * 16 + 8 * half; d[0] = bflo(v.x); d[1] = bfhi(v.x); d[2] = bflo(v.y); d[3] = bfhi(v.y); d[4] = bflo(v.z); d[5] = bfhi(v.z); d[6] = bflo(v.w); d[7] = bfhi(v.w); }
    for (int i = tid; i < 1024; i += 512) GW[i] = ((const GAS float*)gw_l)[(i >> 6) * 256 + hb * 64 + (i & 63)];
    if (tid < 64) GB[tid] = ((const GAS float*)gb_l)[hb * 64 + tid];
    __syncthreads();
    const int d = tid & 63, tseg = tid >> 6;
    float gwr[16];
#pragma unroll
    for (int r = 0; r < 16; ++r) gwr[r] = GW[r * 64 + d];
    const float gbv = GB[d];
    float loc[8]; float run = 0.f;
#pragma unroll
    for (int tt = 0; tt < 8; ++tt) { const int t = 8 * tseg + tt; float x = gbv;
#pragma unroll
        for (int r = 0; r < 16; ++r) x += LR[t * 16 + r] * gwr[r];
        const float lg = (fminf(x, 0.f) - __logf(1.0f + __expf(-fabsf(x)))) * 0.0625f;
        run += lg; loc[tt] = run; }
    SEG[tseg * 64 + d] = run;
    __syncthreads();
    float off = 0.f;
#pragma unroll
    for (int s = 0; s < 8; ++s) { const float v = SEG[s * 64 + d]; off += (s < tseg) ? v : 0.f; }
#pragma unroll
    for (int tt = 0; tt < 8; ++tt) Bm[(8 * tseg + tt) * 65 + d] = off + loc[tt];
    __syncthreads();
}
__device__ __forceinline__ void gla_load_vt(LAS unsigned char* lds, const bf16_t* VTg, int hb, int c) {
    int tid_ = threadIdx.x; asm volatile("" : "+v"(tid_)); const int tid = tid_;
#pragma unroll
    for (int i = 0; i < 2; ++i) { const int id = tid + 512 * i, row = id >> 3, c8 = id & 7;
        *(LAS u32x4*)(lds + G_VT + row * 144 + c8 * 16) = *(const GAS u32x4*)((const GAS bf16_t*)VTg + (size_t)(1024 + hb * 128 + row) * LDV + 64 * c + 8 * c8); }
}
struct Gla1Regs { u32x4 kv, lr; u32x4 vt[2]; };
__device__ __forceinline__ void gla_part1_load(Gla1Regs& R, const Params& p, int c, int hb, int tid) {
    const GAS bf16_t* hm_rows = (const GAS bf16_t*)(p.ws + WS_HM) + (size_t)(64 * c) * NMAIN;
    R.kv = *(const GAS u32x4*)(hm_rows + (size_t)(tid >> 3) * NMAIN + C_BK + hb * 64 + 8 * (tid & 7));
    R.lr = *(const GAS u32x4*)(hm_rows + (size_t)((tid >> 1) & 63) * NMAIN + C_LR + 8 * (tid & 1));
#pragma unroll
    for (int i = 0; i < 2; ++i) { const int id = tid + 512 * i, row = id >> 3, c8 = id & 7;
        R.vt[i] = *(const GAS u32x4*)((const GAS bf16_t*)(p.ws + WS_VT) + (size_t)(1024 + hb * 128 + row) * LDV + 64 * c + 8 * c8); }
}
__device__ __forceinline__ void gla_part1(LAS unsigned char* lds, const Params& p, int l, int c, int hb, const Gla1Regs& R) {
    int tid_ = threadIdx.x; asm volatile("" : "+v"(tid_)); const int tid = tid_, lane = tid & 63, w = __builtin_amdgcn_readfirstlane(tid >> 6), r16 = lane & 15, g = lane >> 4;
    const u32x4 kv_pre = R.kv; u32x4 vt_pre[2] = {R.vt[0], R.vt[1]};
    gla_compute_b(lds, R.lr, p.gate_w + l * 16 * 256, p.gate_b + l * 256, hb);
    const LAS float* Bm = (const LAS float*)(lds + G_B);
    { GAS float* BG = (GAS float*)(p.ws + WS_BG) + (size_t)(64 * c) * 256 + hb * 64;
        const int t = tid >> 3, dc = tid & 7; f32x4 b0, b1;
        b0.x = Bm[t * 65 + 8 * dc + 0]; b0.y = Bm[t * 65 + 8 * dc + 1]; b0.z = Bm[t * 65 + 8 * dc + 2]; b0.w = Bm[t * 65 + 8 * dc + 3];
        b1.x = Bm[t * 65 + 8 * dc + 4]; b1.y = Bm[t * 65 + 8 * dc + 5]; b1.z = Bm[t * 65 + 8 * dc + 6]; b1.w = Bm[t * 65 + 8 * dc + 7];
        *(GAS f32x4*)(BG + (size_t)t * 256 + 8 * dc) = b0; *(GAS f32x4*)(BG + (size_t)t * 256 + 8 * dc + 4) = b1; }
    { const int t = tid >> 3, dc = tid & 7; const u32x4 kv = kv_pre;
        float kf[8] = {bflo(kv.x), bfhi(kv.x), bflo(kv.y), bfhi(kv.y), bflo(kv.z), bfhi(kv.z), bflo(kv.w), bfhi(kv.w)};
        LAS bf16_t* KD = (LAS bf16_t*)(lds + G_KD);
#pragma unroll
        for (int e = 0; e < 8; ++e) { const int d = 8 * dc + e; const float val = kf[e] * __expf(Bm[63 * 65 + d] - Bm[t * 65 + d]); KD[d * 72 + t] = (bf16_t)(pk2(val, 0.f) & 0xffffu); } }
    {
#pragma unroll
        for (int i = 0; i < 2; ++i) { const int id = tid + 512 * i, row = id >> 3, c8 = id & 7; *(LAS u32x4*)(lds + G_VT + row * 144 + c8 * 16) = vt_pre[i]; } }
    if (tid < 64) ((GAS float*)(p.ws + WS_DCY))[(c * 4 + hb) * 64 + tid] = __expf(Bm[63 * 65 + tid]);
    __syncthreads();
    GAS bf16_t* U = (GAS bf16_t*)(p.ws + WS_U) + (size_t)(c * 4 + hb) * 8192;
    const LAS unsigned char* Ap = lds + G_VT + (16 * w + r16) * 144 + g * 16;
#pragma unroll
    for (int dkb = 0; dkb < 4; ++dkb) { const LAS unsigned char* Bp = lds + G_KD + (16 * dkb + r16) * 144 + g * 16; f32x4 acc = (f32x4){0.f, 0.f, 0.f, 0.f};
#pragma unroll
        for (int ks = 0; ks < 2; ++ks) acc = MFMA16(*(const LAS bf16x8*)(Bp + ks * 64), *(const LAS bf16x8*)(Ap + ks * 64), acc);
        u32x2 ub; ub.x = pk2(acc[0], acc[1]); ub.y = pk2(acc[2], acc[3]); *(GAS u32x2*)(U + (16 * w + r16) * 64 + 16 * dkb + 4 * g) = ub; }
    __syncthreads();
}
__device__ __forceinline__ void gla_scan(const Params& p, LAS unsigned char* lds) {
    int tid_ = threadIdx.x; asm volatile("" : "+v"(tid_)); const int tid = tid_, seg = tid >> 7, el = tid & 127;
    LAS float* CE = (LAS float*)lds;
    for (int eg = blockIdx.x; eg < 256; eg += gridDim.x) {
        const int e = eg * 128 + el, hb = e >> 13, rem = e & 8191, dk = rem & 63;
        const GAS bf16_t* U = (const GAS bf16_t*)(p.ws + WS_U) + (size_t)hb * 8192 + rem + (size_t)(seg * 32) * 32768;
        const GAS float* dcy = (const GAS float*)(p.ws + WS_DCY) + hb * 64 + dk + (seg * 32) * 256;
        GAS bf16_t* Sp = (GAS bf16_t*)(p.ws + WS_SP) + (size_t)hb * 8192 + rem + (size_t)(seg * 32) * 32768;
        float uv[32], dv[32];
#pragma unroll
        for (int j = 0; j < 32; ++j) { uv[j] = __uint_as_float(((unsigned)U[(size_t)j * 32768]) << 16); dv[j] = dcy[j * 256]; }
        float s = 0.f, pd = 1.f;
#pragma unroll
        for (int j = 0; j < 32; ++j) { const float u = uv[j], d = dv[j]; uv[j] = s; dv[j] = pd; s = d * s + u; pd *= d; }
        CE[seg * 128 + el] = s; CE[512 + seg * 128 + el] = pd;
        __syncthreads();
        float st = 0.f;
#pragma unroll
        for (int q = 0; q < 3; ++q) { const float se = CE[q * 128 + el], pe = CE[512 + q * 128 + el]; st = (q < seg) ? pe * st + se : st; }
#pragma unroll
        for (int j = 0; j < 32; ++j) Sp[(size_t)j * 32768] = (bf16_t)(pk2(uv[j] + dv[j] * st, 0.f) & 0xffffu);
        __syncthreads();
    }
}
struct Gla2Regs { u32x4 qv, kv; f32x4 b0, b1; u32x4 vt[2], st[2]; u32x2 zpre[4]; f32x4 gpre[4]; };
__device__ __forceinline__ void gla_part2_load(Gla2Regs& R, const Params& p, int l, int c, int hb, int tid, int w, int r16, int g) {
    const GAS bf16_t* hm_rows = (const GAS bf16_t*)(p.ws + WS_HM) + (size_t)(64 * c) * NMAIN;
    const int t = tid >> 3, dc = tid & 7;
    R.qv = *(const GAS u32x4*)(hm_rows + (size_t)t * NMAIN + C_BQ + hb * 64 + 8 * dc); R.kv = *(const GAS u32x4*)(hm_rows + (size_t)t * NMAIN + C_BK + hb * 64 + 8 * dc);
    const GAS float* BG = (const GAS float*)(p.ws + WS_BG) + (size_t)(64 * c + t) * 256 + hb * 64 + 8 * dc;
    R.b0 = *(const GAS f32x4*)BG; R.b1 = *(const GAS f32x4*)(BG + 4);
    const GAS bf16_t* VTg = (const GAS bf16_t*)(p.ws + WS_VT); const GAS bf16_t* Sp = (const GAS bf16_t*)(p.ws + WS_SP) + (size_t)(c * 4 + hb) * 8192;
#pragma unroll
    for (int i = 0; i < 2; ++i) { const int id = tid + 512 * i, row = id >> 3, c8 = id & 7;
        R.vt[i] = *(const GAS u32x4*)(VTg + (size_t)(1024 + hb * 128 + row) * LDV + 64 * c + 8 * c8); R.st[i] = *(const GAS u32x4*)(Sp + row * 64 + 8 * c8); }
    const int i_ = 16 * (w & 3) + r16;
#pragma unroll
    for (int q4 = 0; q4 < 4; ++q4) { const int dv0 = 16 * (4 * (w >> 2) + q4) + 4 * g;
        R.zpre[q4] = *(const GAS u32x2*)(hm_rows + (size_t)i_ * NMAIN + C_BZ + hb * 128 + dv0); R.gpre[q4] = *(const GAS f32x4*)((const GAS float*)p.norm_g + l * 128 + dv0); }
}
__device__ __forceinline__ void gla_part2(LAS unsigned char* lds, const Params& p, int l, int c, int hb, const Gla2Regs& R, int tid, int w, int r16, int g) {
    const bf16_t* hm_rows = (const bf16_t*)(p.ws + WS_HM) + (size_t)(64 * c) * NMAIN;
    u32x2 zpre[4]; f32x4 gpre[4];
#pragma unroll
    for (int q4 = 0; q4 < 4; ++q4) { zpre[q4] = R.zpre[q4]; gpre[q4] = R.gpre[q4]; }
    {
        const int t = tid >> 3, dc = tid & 7;
        const u32x4 qv = R.qv, kv = R.kv; const f32x4 b0 = R.b0, b1 = R.b1;
        u32x4 vt[2] = {R.vt[0], R.vt[1]}, st[2] = {R.st[0], R.st[1]};
        float qf[8] = {bflo(qv.x), bfhi(qv.x), bflo(qv.y), bfhi(qv.y), bflo(qv.z), bfhi(qv.z), bflo(qv.w), bfhi(qv.w)};
        float kf[8] = {bflo(kv.x), bfhi(kv.x), bflo(kv.y), bfhi(kv.y), bflo(kv.z), bfhi(kv.z), bflo(kv.w), bfhi(kv.w)};
        float bb[8] = {b0.x, b0.y, b0.z, b0.w, b1.x, b1.y, b1.z, b1.w};
        float qpv[8], qmv[8], kpv[8], kmv[8];
#pragma unroll
        for (int e = 0; e < 8; ++e) { const float ep = __expf(bb[e]), em = __expf(-bb[e]), q8 = qf[e] * 0.125f;
            qpv[e] = q8 * ep; qmv[e] = q8 * em; kpv[e] = kf[e] * ep; kmv[e] = kf[e] * em; }
        const int o = t * 144 + dc * 16;
        *(LAS u32x4*)(lds + G_QP + o) = (u32x4){pk2(qpv[0], qpv[1]), pk2(qpv[2], qpv[3]), pk2(qpv[4], qpv[5]), pk2(qpv[6], qpv[7])};
        *(LAS u32x4*)(lds + G_QM + o) = (u32x4){pk2(qmv[0], qmv[1]), pk2(qmv[2], qmv[3]), pk2(qmv[4], qmv[5]), pk2(qmv[6], qmv[7])};
        *(LAS u32x4*)(lds + G_KP + o) = (u32x4){pk2(kpv[0], kpv[1]), pk2(kpv[2], kpv[3]), pk2(kpv[4], kpv[5]), pk2(kpv[6], kpv[7])};
        *(LAS u32x4*)(lds + G_KM + o) = (u32x4){pk2(kmv[0], kmv[1]), pk2(kmv[2], kmv[3]), pk2(kmv[4], kmv[5]), pk2(kmv[6], kmv[7])};
#pragma unroll
        for (int i = 0; i < 2; ++i) { const int id = tid + 512 * i, row = id >> 3, c8 = id & 7;
            *(LAS u32x4*)(lds + G_VT + row * 144 + c8 * 16) = vt[i]; *(LAS u32x4*)(lds + G_ST + row * 144 + c8 * 16) = st[i]; }
    }
    __syncthreads();
    { const int ib = w >> 1; LAS bf16_t* AT = (LAS bf16_t*)(lds + G_AT);
        const LAS unsigned char* qpA = lds + G_QP + (16 * ib + r16) * 144 + g * 16; const LAS unsigned char* qmA = lds + G_QM + (16 * ib + r16) * 144 + g * 16;
#pragma unroll
        for (int jj = 0; jj < 2; ++jj) { const int jb = 2 * (w & 1) + jj;
            const LAS unsigned char* kmB = lds + G_KM + (16 * jb + r16) * 144 + g * 16; const LAS unsigned char* kpB = lds + G_KP + (16 * jb + r16) * 144 + g * 16;
            f32x4 lo = (f32x4){0.f, 0.f, 0.f, 0.f}, hi = lo;
#pragma unroll
            for (int ks = 0; ks < 2; ++ks) { lo = MFMA16(*(const LAS bf16x8*)(qpA + ks * 64), *(const LAS bf16x8*)(kmB + ks * 64), lo);
                hi = MFMA16(*(const LAS bf16x8*)(qmA + ks * 64), *(const LAS bf16x8*)(kpB + ks * 64), hi); }
#pragma unroll
            for (int r = 0; r < 4; ++r) { const int i = 16 * ib + 4 * g + r, j = 16 * jb + r16; const float v = (j <= i) ? lo[r] : hi[r]; AT[i * 72 + j] = (bf16_t)(pk2(v, 0.f) & 0xffffu); } } }
    __syncthreads();
    const int ib = w & 3, dvh = w >> 2;
    f32x4 oacc[4];
    { const LAS unsigned char* atA = lds + G_AT + (16 * ib + r16) * 144 + g * 16; const LAS unsigned char* qpA = lds + G_QP + (16 * ib + r16) * 144 + g * 16;
#pragma unroll
        for (int q4 = 0; q4 < 4; ++q4) { const int dvb = 4 * dvh + q4;
            const LAS unsigned char* vtB = lds + G_VT + (16 * dvb + r16) * 144 + g * 16; const LAS unsigned char* stB = lds + G_ST + (16 * dvb + r16) * 144 + g * 16;
            f32x4 acc = (f32x4){0.f, 0.f, 0.f, 0.f};
#pragma unroll
            for (int ks = 0; ks < 2; ++ks) { acc = MFMA16(*(const LAS bf16x8*)(vtB + ks * 64), *(const LAS bf16x8*)(atA + ks * 64), acc);
                acc = MFMA16(*(const LAS bf16x8*)(stB + ks * 64), *(const LAS bf16x8*)(qpA + ks * 64), acc); }
            oacc[q4] = acc; } }
    LAS float* SSQ = (LAS float*)(lds + G_SSQ);
    { float pr = 0.f;
#pragma unroll
        for (int q4 = 0; q4 < 4; ++q4) pr += (oacc[q4][0] * oacc[q4][0] + oacc[q4][1] * oacc[q4][1]) + (oacc[q4][2] * oacc[q4][2] + oacc[q4][3] * oacc[q4][3]);
        pr += __shfl_xor(pr, 16); pr += __shfl_xor(pr, 32);
        if (g == 0) SSQ[dvh * 64 + 16 * ib + r16] = pr; }
    __syncthreads();
    { const int i = 16 * ib + r16; const float rinv = rsqrtf((SSQ[i] + SSQ[64 + i]) * (1.0f / 128.0f) + RMS_EPS);
        GAS bf16_t* Yr = (GAS bf16_t*)(p.ws + WS_Y) + (size_t)(64 * c + i) * DM + 1024 + hb * 128;
#pragma unroll
        for (int q4 = 0; q4 < 4; ++q4) { const int dv0 = 16 * (4 * dvh + q4) + 4 * g; const u32x2 z = zpre[q4]; const f32x4 gg = gpre[q4];
            const float y0 = oacc[q4][0] * rinv * gg.x * silu_f(bflo(z.x)), y1 = oacc[q4][1] * rinv * gg.y * silu_f(bfhi(z.x)), y2 = oacc[q4][2] * rinv * gg.z * silu_f(bflo(z.y)), y3 = oacc[q4][3] * rinv * gg.w * silu_f(bfhi(z.y));
            u32x2 yo; yo.x = pk2(y0, y1); yo.y = pk2(y2, y3); *(GAS u32x2*)(Yr + dv0) = yo; } }
    __syncthreads();
}

__device__ __forceinline__ void ln_phase(const Params& p, int l, const float* tin, float* fout) {
    int tid_ = threadIdx.x; asm volatile("" : "+v"(tid_)); const int tid = tid_, lane = tid & 63, wave = tid >> 6;
    const int gw = blockIdx.x * 8 + wave, NGW = gridDim.x * 8;
    const float* lg = p.ln_g + l * DM; const float* lb = p.ln_b + l * DM; bf16_t* xb = (bf16_t*)(p.ws + WS_XB);
    for (int row = gw; row < SEQ; row += NGW) {
        const f32x4* xr = (const f32x4*)(tin + (size_t)row * DM) + lane;
        f32x4 v[8]; float s = 0.f;
#pragma unroll
        for (int j = 0; j < 8; ++j) { v[j] = xr[64 * j]; s += (v[j].x + v[j].y) + (v[j].z + v[j].w); }
#pragma unroll
        for (int o = 1; o < 64; o <<= 1) s += __shfl_xor(s, o);
        const float mean = s * (1.0f / DM); float s2 = 0.f;
#pragma unroll
        for (int j = 0; j < 8; ++j) { v[j] = v[j] - mean; s2 += (v[j].x * v[j].x + v[j].y * v[j].y) + (v[j].z * v[j].z + v[j].w * v[j].w); }
#pragma unroll
        for (int o = 1; o < 64; o <<= 1) s2 += __shfl_xor(s2, o);
        const float rstd = rsqrtf(s2 * (1.0f / DM) + LN_EPS);
        f32x4* orow = (f32x4*)(fout + (size_t)row * DM) + lane; u32x2* brow = (u32x2*)(xb + (size_t)row * DM) + lane;
#pragma unroll
        for (int j = 0; j < 8; ++j) { const f32x4 gg = ((const f32x4*)lg)[lane + 64 * j], bb = ((const f32x4*)lb)[lane + 64 * j];
            const f32x4 y = v[j] * rstd * gg + bb; orow[64 * j] = y; u32x2 o2; o2.x = pk2(y.x, y.y); o2.y = pk2(y.z, y.w); brow[64 * j] = o2; }
    }
}

#define XB_TMO      128
#define XB_XCNT(j)  (256  + 64 * (j))
#define XB_XSUB(j)  (1280 + 64 * (j))
#define XB_XGEN(j)  (2304 + 64 * (j))
#define XB_TOP      3328
#define XB_TOPGEN   3392
#define XCD_BAR_WORDS 3456
#define XB_SPIN_CAP (1u << 18)

__device__ __forceinline__ unsigned xb_ld(unsigned* p)              { return __hip_atomic_load(p, __ATOMIC_RELAXED, __HIP_MEMORY_SCOPE_AGENT); }
__device__ __forceinline__ unsigned xb_add(unsigned* p, unsigned v) { return __hip_atomic_fetch_add(p, v, __ATOMIC_RELAXED, __HIP_MEMORY_SCOPE_AGENT); }
__device__ __forceinline__ unsigned xb_xcc_id() { return (unsigned)__builtin_amdgcn_s_getreg((3 << 11) | 20) & 0xFu; }
#define XB_SPIN(cond, bar) do { unsigned _sp = 0; while (cond) { __builtin_amdgcn_s_sleep(1); \
    if ((++_sp & 255u) == 0u) { if (xb_ld(&(bar)[XB_TMO])) break; if (_sp > XB_SPIN_CAP) { atomicAdd(&(bar)[XB_TMO], 1u); break; } } } } while (0)

struct XcdBarrier {
    unsigned* bar; unsigned x;
    volatile LAS unsigned* st;
};

__device__ __forceinline__ XcdBarrier xcd_barrier_post(unsigned* bar, volatile LAS unsigned* st) {
    XcdBarrier b; b.bar = bar; b.x = xb_xcc_id(); b.st = st;
    if (threadIdx.x == 0) (void)xb_add(&bar[XB_XCNT(b.x)], 1u);
    return b;
}
__device__ __forceinline__ void xcd_barrier_complete(unsigned* bar, unsigned x, unsigned& nloc, unsigned& nx) {
    const unsigned G = gridDim.x * gridDim.y * gridDim.z;
    unsigned sum, cnt, mine, sp = 0u;
    for (;;) {
        sum = 0u; cnt = 0u; mine = 0u;
#pragma unroll
        for (unsigned j = 0; j < 16; ++j) { const unsigned c = xb_ld(&bar[XB_XCNT(j)]); sum += c; cnt += (c > 0u) ? 1u : 0u; mine = (j == x) ? c : mine; }
        if (sum == G) break;
        __builtin_amdgcn_s_sleep(1);
        if ((++sp & 255u) == 0u) { if (xb_ld(&bar[XB_TMO])) break; if (sp > XB_SPIN_CAP) { atomicAdd(&bar[XB_TMO], 1u); break; } }
    }
    nloc = mine > 0u ? mine : 1u; nx = cnt > 0u ? cnt : 1u;
}

__device__ __forceinline__ void xcd_barrier(const XcdBarrier& b) {
    asm volatile("s_waitcnt vmcnt(0)" ::: "memory");
    __syncthreads();
    if (threadIdx.x == 0) {
        unsigned* bar = b.bar;
        __builtin_amdgcn_s_waitcnt(0);
        unsigned nloc = b.st[0], nx = b.st[1];
        if (nloc == 0u) { xcd_barrier_complete(bar, b.x, nloc, nx); b.st[0] = nloc; b.st[1] = nx; }
        const unsigned old = xb_add(&bar[XB_XSUB(b.x)], 1u);
        const unsigned gen = old / nloc;
        if (old + 1u == (gen + 1u) * nloc) {
            __builtin_amdgcn_fence(__ATOMIC_RELEASE, "agent");
            asm volatile("s_waitcnt vmcnt(0)" ::: "memory");
            const unsigned og = xb_add(&bar[XB_TOP], 1u);
            const unsigned tg = og / nx;
            if (og + 1u == (tg + 1u) * nx) xb_add(&bar[XB_TOPGEN], 1u);
            else XB_SPIN(xb_ld(&bar[XB_TOPGEN]) == tg, bar);
            __builtin_amdgcn_fence(__ATOMIC_ACQUIRE, "agent");
            xb_add(&bar[XB_XGEN(b.x)], 1u);
            asm volatile("s_waitcnt vmcnt(0)" ::: "memory");
        } else {
            XB_SPIN(xb_ld(&bar[XB_XGEN(b.x)]) == gen, bar);
            __builtin_amdgcn_fence(__ATOMIC_ACQUIRE, "agent");
            asm volatile("s_waitcnt vmcnt(0)" ::: "memory");
        }
    }
    __syncthreads();
}

constexpr int NPH = 1 + 6 * DEPTH;
__global__ void __launch_bounds__(512, 2) mega(Params p_in) {
    extern __shared__ __attribute__((aligned(16))) unsigned char lds_raw[];
    LAS unsigned char* lds = (LAS unsigned char*)lds_raw;
    cg::grid_group grid = cg::this_grid();
    const int bid = blockIdx.x, G = gridDim.x;
    volatile LAS unsigned* misc = (volatile LAS unsigned*)(lds + LDS_BYTES - 64);
    if (threadIdx.x < 16) misc[threadIdx.x] = 0u;
    __syncthreads();
    const XcdBarrier bar = xcd_barrier_post((unsigned*)(p_in.ws + WS_CTL), misc);
    if (p_in.ph_hi - p_in.ph_lo > 1) grid.sync();
    const Params& p0 = p_in;
    for (int ph = p0.ph_lo; ph < p0.ph_hi; ++ph) {
        Params p = p0; asm volatile("" : "+s"(p.ws));
        bf16_t* xb = (bf16_t*)(p.ws + WS_XB); float* xf = (float*)(p.ws + WS_XF);
        bf16_t* hm = (bf16_t*)(p.ws + WS_HM); bf16_t* VT = (bf16_t*)(p.ws + WS_VT); bf16_t* Y = (bf16_t*)(p.ws + WS_Y);
        if (ph == 0) phase0(p, lds);
        else {
            const int l = (ph - 1) / 6, k = (ph - 1) % 6;
            const bf16_t* win = (const bf16_t*)(p.ws + WS_WIN + l * WIN_L);
            if (k == 0) {
                for (int gi = 0; gi < 4; ++gi) {
                    pg8::Gemm g; bf16_t* O; int ldc, c;
                    if (gi == 0) { g.A = xb; g.Bt = win; g.M = SEQ; g.N = NMAIN; O = hm; ldc = NMAIN; c = bid; }
                    else if (gi == 1) { g.A = win + (size_t)NMAIN * DM; g.Bt = xb; g.M = NVT; g.N = SEQ; O = VT; ldc = LDV; c = G - 1 - bid; }
                    else if (gi == 2) { g.A = (const bf16_t*)(p.ws + WS_MEMB); g.Bt = (const bf16_t*)(p.ws + WS_WMK) + (size_t)l * 512 * DM; g.M = NMEM; g.N = 512; O = (bf16_t*)(p.ws + WS_MK) + l * 512; ldc = 2048;
                        c = (bid >= G - 16 && bid < G - 14) ? bid - (G - 16) : (1 << 24); }
                    else { g.A = (const bf16_t*)(p.ws + WS_WMV) + (size_t)l * 512 * DM; g.Bt = (const bf16_t*)(p.ws + WS_MEMB); g.M = 512; g.N = NMEM; O = (bf16_t*)(p.ws + WS_MVT) + (size_t)l * 512 * NMEM; ldc = NMEM;
                        c = (bid >= G - 14 && bid < G - 12) ? bid - (G - 14) : (1 << 24); }
                    g.K = DM;
                    pg8::StaticOrder S; S.init(g.M, g.N, G, c);
                    pg8::EpiBf16<0> E{O, ldc, nullptr, 0, 0, 1.f};
                    pg8::gemm_phase<pg8::EpiBf16<0>, pg8::StaticOrder, true, true>(lds, g, S, E);
                }
                if (l + 1 < DEPTH) {
                    int wkb = bid, nwb = G;
                    if (G == 256) { nwb = 144; wkb = bid < 64 ? bid : (bid >= 160 && bid < 240 ? bid - 96 : -1); }
                    if (wkb >= 0) { int t2_ = threadIdx.x; asm volatile("" : "+v"(t2_)); convert_layer(p, l + 1, lds, wkb * 8 + (t2_ >> 6), nwb * 8); }
                }
            } else if (k == 1) {
                for (int u = bid; u < 256; u += G) band_pair_unit(lds, p, l, u >> 2, 2 * (u & 3));
                for (int u = bid; u < 256; u += G) { const int head = u & 3, qb = u >> 2;
                    attn_unit<false>(lds, 128 * qb, hm + C_MQ + head * 128, NMAIN, (const bf16_t*)(p.ws + WS_MK) + l * 512 + head * 128, 2048,
                                     (const bf16_t*)(p.ws + WS_MVT) + (size_t)(l * 512 + head * 128) * NMEM, NMEM, hm + C_MZ + head * 128, NMAIN, Y + 1536 + head * 128, DM, nullptr, 0); }
                { int t1_ = threadIdx.x; asm volatile("" : "+v"(t1_));
                    if (G == 256) { Gla1Regs RA, RB; gla_part1_load(RA, p, bid >> 2, bid & 3, t1_); gla_part1_load(RB, p, 64 + (bid >> 2), bid & 3, t1_);
                        gla_part1(lds, p, l, bid >> 2, bid & 3, RA); gla_part1(lds, p, l, 64 + (bid >> 2), bid & 3, RB); }
                    else { for (int u = bid; u < 512; u += G) { Gla1Regs RA; gla_part1_load(RA, p, u >> 2, u & 3, t1_); gla_part1(lds, p, l, u >> 2, u & 3, RA); } } }
            } else if (k == 2) gla_scan(p, lds);
            else if (k == 3) {
                int t3_ = threadIdx.x; asm volatile("" : "+v"(t3_)); const int tid3 = t3_, w3 = __builtin_amdgcn_readfirstlane(tid3 >> 6), r3 = tid3 & 15, g3 = (tid3 & 63) >> 4;
                if (G == 256) {
                    Gla2Regs RA, RB; const int u = bid, u2 = bid + 256;
                    gla_part2_load(RA, p, l, u >> 2, u & 3, tid3, w3, r3, g3);
                    gla_part2_load(RB, p, l, u2 >> 2, u2 & 3, tid3, w3, r3, g3);
                    gla_part2(lds, p, l, u >> 2, u & 3, RA, tid3, w3, r3, g3);
                    gla_part2(lds, p, l, u2 >> 2, u2 & 3, RB, tid3, w3, r3, g3);
                } else {
                    for (int u = bid; u < 512; u += G) { Gla2Regs RA; gla_part2_load(RA, p, l, u >> 2, u & 3, tid3, w3, r3, g3); gla_part2(lds, p, l, u >> 2, u & 3, RA, tid3, w3, r3, g3); }
                }
            }
            else if (k == 4) {
                pg8::Gemm g; g.A = Y; g.Bt = (const bf16_t*)(p.ws + WS_WOUT + l * WOUT_L); g.M = SEQ; g.N = DM; g.K = DM;
                pg8::StaticOrder S; S.init(SEQ, DM, G, bid);
                if (G == 256) {
                    pg8::EpiResLn E{l == 0 ? p.x : (const float*)nullptr, l == DEPTH - 1 ? p.out : (float*)nullptr, xb, (bf16_t*)(p.ws + WS_XL), p.ln_g + l * DM, p.ln_b + l * DM, (unsigned long long*)(p.ws + WS_XCH),
                                    (unsigned*)(p.ws + WS_CTL) + CW_CNT + l * 2048, 1.6817928305074292f, LN_EPS};
                    pg8::gemm_phase<pg8::EpiResLn, pg8::StaticOrder, false, true>(lds, g, S, E);
                } else {
                    pg8::EpiResid E{l == 0 ? p.x : xf, xf, DM, 1.6817928305074292f};
                    pg8::gemm_phase<pg8::EpiResid, pg8::StaticOrder, true, true>(lds, g, S, E);
                }
            } else if (G != 256) ln_phase(p, l, xf, l == DEPTH - 1 ? p.out : xf);
        }
        if (ph + 1 < p0.ph_hi && !(G == 256 && ph > 0 && (ph - 1) % 6 == 4)) xcd_barrier(bar);
    }
}

extern "C" void kernel_launch(void* const* d_in, const int* in_sizes, int n_in, void* d_out, int out_size, void* d_ws, size_t ws_size, hipStream_t stream) {
    static int grid = 0;
    if (grid == 0) {
        if (n_in != 11 || ws_size < WS_END) { fprintf(stderr, "kernel_launch: unexpected inputs (n_in %d, ws %zu)\n", n_in, ws_size); grid = -1; return; }
        int dev = 0, cus = 0, per_cu = 0;
        hipGetDevice(&dev); hipDeviceGetAttribute(&cus, hipDeviceAttributeMultiprocessorCount, dev);
        hipFuncSetAttribute((const void*)mega, hipFuncAttributeMaxDynamicSharedMemorySize, LDS_BYTES);
        hipOccupancyMaxActiveBlocksPerMultiprocessor(&per_cu, (const void*)mega, 512, LDS_BYTES);
        if (per_cu < 1) per_cu = 1;
        (void)hipGetLastError();
        grid = cus * per_cu;
    }
    if (grid < 0) return;
    Params p{};
    p.x = (const float*)d_in[0]; p.mem = (const float*)d_in[1]; p.w_in = (const float*)d_in[2]; p.rel = (const float*)d_in[3]; p.gate_w = (const float*)d_in[4];
    p.gate_b = (const float*)d_in[5]; p.norm_g = (const float*)d_in[6]; p.w_mkv = (const float*)d_in[7]; p.w_out = (const float*)d_in[8]; p.ln_g = (const float*)d_in[9]; p.ln_b = (const float*)d_in[10];
    p.out = (float*)d_out; p.ws = (unsigned char*)d_ws;
    if (hipMemsetAsync((char*)d_ws + WS_CTL, 0, CTL_BYTES, stream) != hipSuccess) { fprintf(stderr, "memset failed\n"); return; }
#if defined(MK_MULTI)
    for (int ph = 0; ph < NPH; ++ph) { p.ph_lo = ph; p.ph_hi = ph + 1; hipLaunchKernelGGL(mega, dim3(grid), dim3(512), LDS_BYTES, stream, p); }
#else
    p.ph_lo = 0; p.ph_hi = NPH;
    void* args[] = {&p};
    hipError_t e = hipLaunchCooperativeKernel((const void*)mega, dim3(grid), dim3(512), args, LDS_BYTES, stream);
    if (e != hipSuccess) fprintf(stderr, "cooperative launch failed: %s (grid %d)\n", hipGetErrorString(e), grid);
#endif
}
```

```cpp
#include <hip/hip_runtime.h>
#include <hip/hip_cooperative_groups.h>
#include <cstdio>
#include <cstdint>
namespace cg = cooperative_groups;
namespace pg8 {
#define PG8_LAS __attribute__((address_space(3)))
typedef unsigned short bf16_t;
typedef short bf16x8 __attribute__((ext_vector_type(8)));
typedef float f32x4 __attribute__((ext_vector_type(4)));
typedef unsigned u32x4 __attribute__((ext_vector_type(4)));
constexpr int BM = 256, BK = 64, HALF = 128, HTB = HALF * BK * 2  , STAGE_BYTES = 8 * HTB, NXCD = 8, WGM = 8;

__host__ __device__ __forceinline__ int lds_byte(int r, int c) { const int st = (r >> 4) * 2 + (c >> 5), rr = r & 15, cc = c & 31, ob = rr * 64 + cc * 2; return st * 1024 + (ob ^ (((ob >> 9) & 1) << 5)); }
__host__ __device__ __forceinline__ void stage_rc(int b, int& R, int& C) { const int st = b / 1024, sb = b % 1024, swz = sb ^ (((sb >> 9) & 1) << 5); R = (st >> 1) * 16 + swz / 64; C = (st & 1) * 32 + (swz % 64) / 2; }
__host__ __device__ __forceinline__ int perm32(int rho) { const int n = rho >> 4, i = rho & 15; return 8 * (i >> 2) + 4 * n + (i & 3); }

struct Unit { int pm, pn; };
struct Gemm { const bf16_t* A; const bf16_t* Bt; int M, N, K; };

struct StaticOrder {
    int nM, nN, nwg, G, c;
    __host__ __device__ void init(int M, int N, int G_, int c_) { nM = M / BM; nN = N / BM; nwg = nM * nN; G = G_; c = c_; }
    __host__ __device__ bool next(int i, Unit& u) const {
        const long L = (long)i * G + c; if (L >= nwg) return false;
        int wgid = (int)L; { const int q = nwg / NXCD, r = nwg % NXCD, xcd = wgid % NXCD, off = wgid / NXCD; wgid = (xcd < r ? xcd * (q + 1) : r * (q + 1) + (xcd - r) * q) + off; }
        const int nig = WGM * nN, gid = wgid / nig, fm = gid * WGM, gsz = (nM - fm) < WGM ? (nM - fm) : WGM;
        u.pm = fm + ((wgid % nig) % gsz); u.pn = (wgid % nig) / gsz; return true;
    }
    __device__ __forceinline__ void a_ready(const Unit&) const {}
    __device__ __forceinline__ void done(const Unit&) const {}
};

__device__ __forceinline__ unsigned cvt_pk_bf16(float lo, float hi) { unsigned r; asm volatile("v_cvt_pk_bf16_f32 %0, %1, %2" : "=v"(r) : "v"(lo), "v"(hi)); return r; }
typedef float f32x2 __attribute__((ext_vector_type(2)));
__device__ __forceinline__ f32x2 gelu_pk(f32x2 v) {
    const f32x2 av = __builtin_elementwise_abs(v), d = av * 0.2316418882f + 1.0f;
    f32x2 t; t.x = __builtin_amdgcn_rcpf(d.x); t.y = __builtin_amdgcn_rcpf(d.y);
    f32x2 q = t * 0.5307027145f + (-0.7265760135f); q = q * t + 0.7107068705f; q = q * t + (-0.142248368f); q = q * t + 0.127414796f; q = q * t;
    const f32x2 s = (v * v) * (-0.72134752044f);
    f32x2 e; e.x = __builtin_amdgcn_exp2f(s.x); e.y = __builtin_amdgcn_exp2f(s.y);
    const f32x2 m = v * (q * e), r = v - m;
    f32x2 o; o.x = v.x < 0.f ? m.x : r.x; o.y = v.y < 0.f ? m.y : r.y; return o;
}

template <int ACT  > struct EpiBf16 {
    static constexpr bool PERM = true, AFTER_DRAIN = false; static_assert(ACT == 0 || ACT == 1, "EpiBf16: ACT is 0 (none) or 1 (gelu_pk)");
    bf16_t* O; int ldc; const float* bias; int split_cols; size_t split_stride; float scale0;
    __device__ __forceinline__ void operator()(const f32x4 (&acc)[2][2][4][2], const Unit& u, int wr, int wc, int fr, int fq) const {
        const int row0 = u.pm * BM + wr * 64 + fr; int colt = u.pn * BM; bf16_t* base = O;
        float sc = 1.f; if (split_cols) { const int t = colt / split_cols; base += (size_t)t * split_stride; colt -= t * split_cols; if (t == 0) sc = scale0; }
        const int col0 = colt + wc * 32 + 8 * fq, bcol0 = u.pn * BM + wc * 32 + 8 * fq;
        f32x4 bv[2][2];
#pragma unroll
        for (int bj = 0; bj < 2; ++bj)
#pragma unroll
            for (int n = 0; n < 2; ++n) bv[bj][n] = bias ? *(const f32x4*)(bias + bcol0 + bj * HALF + 4 * n) : (f32x4){0.f, 0.f, 0.f, 0.f};
#pragma unroll
        for (int ai = 0; ai < 2; ++ai)
#pragma unroll
            for (int m = 0; m < 4; ++m) { bf16_t* rowp = base + (size_t)(row0 + ai * HALF + m * 16) * ldc + col0;
#pragma unroll
                for (int bj = 0; bj < 2; ++bj) { f32x4 v0 = acc[ai][bj][m][0] + bv[bj][0], v1 = acc[ai][bj][m][1] + bv[bj][1];
                    if (ACT == 1) { f32x2 a = gelu_pk((f32x2){v0[0], v0[1]}), b = gelu_pk((f32x2){v0[2], v0[3]}), c = gelu_pk((f32x2){v1[0], v1[1]}), d = gelu_pk((f32x2){v1[2], v1[3]});
                        v0 = (f32x4){a.x, a.y, b.x, b.y}; v1 = (f32x4){c.x, c.y, d.x, d.y}; }
                    v0 = v0 * sc; v1 = v1 * sc; u32x4 w; w.x = cvt_pk_bf16(v0[0], v0[1]); w.y = cvt_pk_bf16(v0[2], v0[3]); w.z = cvt_pk_bf16(v1[0], v1[1]); w.w = cvt_pk_bf16(v1[2], v1[3]);
                    *(u32x4*)(rowp + bj * HALF) = w; } }
    }
};
template <class Epi, class Sched, bool ALIGN_EPI = false, bool SP2 = false>
__device__ __forceinline__ void gemm_phase(PG8_LAS unsigned char* lds, const Gemm g, const Sched& S, const Epi& E) {
    int tid_ = threadIdx.x; asm volatile("" : "+v"(tid_)); const int tid = tid_, wid = __builtin_amdgcn_readfirstlane(tid >> 6), lane = tid & 63, wr = wid >> 2, wc = wid & 3, fr = lane & 15, fq = lane >> 4;
    const int K = g.K, nt = K / BK;
    unsigned voffA[2], voffB[2];
#pragma unroll
    for (int i = 0; i < 2; ++i) { int R, C; stage_rc(tid * 16 + i * 8192, R, C); const int Rb = Epi::PERM ? ((R & ~31) + perm32(R & 31)) : R;
        voffA[i] = (unsigned)(R * K + C) * 2u; voffB[i] = (unsigned)(Rb * K + C) * 2u; }
    const size_t kstep = (size_t)(BK * 2);
    const size_t hstep = (size_t)HALF * K * 2;
    const size_t tstep = 2 * hstep;
    const unsigned ldsw = (unsigned)wid * 1024u;
    const int aoff = lds_byte(wr * 64 + fr, fq * 8), boff = lds_byte(wc * 32 + fr, fq * 8);
#define PG8_SA(b, h) (((b) * 2 + (h)) * HTB)
#define PG8_SB(b, h) ((4 + (b) * 2 + (h)) * HTB)
#define PG8_STAGE(bufoff, gbase, voff) do { _Pragma("unroll") for (int _i = 0; _i < 2; ++_i) \
        __builtin_amdgcn_global_load_lds((const unsigned*)((const char*)(gbase) + (voff)[_i]), (PG8_LAS unsigned*)(lds + (bufoff) + ldsw + _i * 8192), 16, 0, 0); } while (0)
#define PG8_LDA(dst, b, h) do { _Pragma("unroll") for (int m = 0; m < 4; ++m) _Pragma("unroll") for (int k = 0; k < 2; ++k) dst[m][k] = *(const PG8_LAS bf16x8*)(lds + PG8_SA(b, h) + aoff + m * 2048 + k * 1024); } while (0)
#define PG8_LDB(dst, b, h) do { _Pragma("unroll") for (int n = 0; n < 2; ++n) _Pragma("unroll") for (int k = 0; k < 2; ++k) dst[n][k] = *(const PG8_LAS bf16x8*)(lds + PG8_SB(b, h) + boff + n * 2048 + k * 1024); } while (0)
#define PG8_MMA(ai, bj, At, Bt) do { __builtin_amdgcn_s_setprio(1); _Pragma("unroll") for (int m = 0; m < 4; ++m) _Pragma("unroll") for (int n = 0; n < 2; ++n) _Pragma("unroll") for (int k = 0; k < 2; ++k) \
        acc[ai][bj][m][n] = __builtin_amdgcn_mfma_f32_16x16x32_bf16(Bt[n][k], At[m][k], acc[ai][bj][m][n], 0, 0, 0); __builtin_amdgcn_s_setprio(0); } while (0)
#define PG8_WAIT_V(n) asm volatile("s_waitcnt vmcnt(" #n ")" ::: "memory")
#define PG8_WAIT_L(n) asm volatile("s_waitcnt lgkmcnt(" #n ")" ::: "memory")
#define PG8_BAR __builtin_amdgcn_s_barrier()
#define PG8_SCHED __builtin_amdgcn_sched_barrier(0)
    Unit cur, nxt; int ui = 0;
    if (!S.next(0, cur)) return;
    f32x4 acc[2][2][4][2];
#pragma unroll
    for (int a = 0; a < 2; ++a)
#pragma unroll
        for (int b = 0; b < 2; ++b)
#pragma unroll
            for (int m = 0; m < 4; ++m)
#pragma unroll
                for (int n = 0; n < 2; ++n) acc[a][b][m][n] = (f32x4){0.f, 0.f, 0.f, 0.f};
    bf16x8 At[4][2], B0[2][2], B1[2][2];
    const char* cA = (const char*)g.A + (size_t)cur.pm * tstep; const char* cB = (const char*)g.Bt + (size_t)cur.pn * tstep;
    S.a_ready(cur);
    if constexpr (SP2) {
        PG8_STAGE(PG8_SB(0, 0), cB, voffB); PG8_STAGE(PG8_SB(0, 1), cB + hstep, voffB); PG8_STAGE(PG8_SA(0, 0), cA, voffA); PG8_STAGE(PG8_SA(0, 1), cA + hstep, voffA);
        if (wr == 1) PG8_BAR;
        PG8_WAIT_V(2); PG8_BAR;
        PG8_STAGE(PG8_SB(1, 0), cB + kstep, voffB); PG8_STAGE(PG8_SA(1, 0), cA + kstep, voffA); PG8_STAGE(PG8_SB(1, 1), cB + hstep + kstep, voffB);
        PG8_WAIT_V(6); PG8_BAR;
    } else {
        PG8_STAGE(PG8_SB(0, 0), cB, voffB); PG8_STAGE(PG8_SA(0, 0), cA, voffA); PG8_STAGE(PG8_SB(0, 1), cB + hstep, voffB); PG8_STAGE(PG8_SA(0, 1), cA + hstep, voffA);
        if (wr == 1) PG8_BAR;
        PG8_WAIT_V(4); PG8_BAR;
        PG8_STAGE(PG8_SB(1, 0), cB + kstep, voffB); PG8_STAGE(PG8_SA(1, 0), cA + kstep, voffA); PG8_STAGE(PG8_SB(1, 1), cB + hstep + kstep, voffB);
        PG8_WAIT_V(6); PG8_BAR;
    }
    for (;;) {
        const bool has_next = S.next(ui + 1, nxt);
        const char* nA = has_next ? (const char*)g.A + (size_t)nxt.pm * tstep : cA; const char* nB = has_next ? (const char*)g.Bt + (size_t)nxt.pn * tstep : cB;
        for (int t = 0; t < nt; t += 2) {
            const bool last = (t == nt - 2);
            const char* a1 = cA + (size_t)(t + 1) * kstep;
            const char* a2 = last ? nA : cA + (size_t)(t + 2) * kstep; const char* b2 = last ? nB : cB + (size_t)(t + 2) * kstep;
            const char* a3 = a2 + kstep; const char* b3 = b2 + kstep;
            if (last && has_next) S.a_ready(nxt);
            if constexpr (SP2) {
            PG8_LDB(B0, 0, 0); PG8_LDB(B1, 0, 1); PG8_SCHED; PG8_LDA(At, 0, 0); PG8_STAGE(PG8_SA(1, 1), a1 + hstep, voffA);
            PG8_WAIT_V(8); PG8_WAIT_L(0); PG8_BAR; PG8_MMA(0, 0, At, B0); PG8_MMA(0, 1, At, B1); PG8_BAR; PG8_SCHED;
            PG8_LDA(At, 0, 1); PG8_STAGE(PG8_SB(0, 0), b2, voffB); PG8_STAGE(PG8_SB(0, 1), b2 + hstep, voffB); PG8_STAGE(PG8_SA(0, 0), a2, voffA);
            PG8_WAIT_V(8); PG8_WAIT_L(0); PG8_BAR; PG8_MMA(1, 0, At, B0); PG8_MMA(1, 1, At, B1); PG8_BAR; PG8_SCHED;
            PG8_LDB(B0, 1, 0); PG8_LDB(B1, 1, 1); PG8_SCHED; PG8_LDA(At, 1, 0); PG8_STAGE(PG8_SA(0, 1), a2 + hstep, voffA);
            PG8_WAIT_V(8); PG8_WAIT_L(0); PG8_BAR; PG8_MMA(0, 0, At, B0); PG8_MMA(0, 1, At, B1); PG8_BAR; PG8_SCHED;
            PG8_LDA(At, 1, 1); PG8_STAGE(PG8_SB(1, 0), b3, voffB); PG8_STAGE(PG8_SB(1, 1), b3 + hstep, voffB); PG8_STAGE(PG8_SA(1, 0), a3, voffA);
            PG8_WAIT_V(8); PG8_WAIT_L(0); PG8_BAR; PG8_MMA(1, 0, At, B0); PG8_MMA(1, 1, At, B1); PG8_BAR; PG8_SCHED;
            } else {
            PG8_LDB(B0, 0, 0); PG8_SCHED; PG8_LDA(At, 0, 0); PG8_STAGE(PG8_SA(1, 1), a1 + hstep, voffA);
            PG8_WAIT_L(8); PG8_BAR; PG8_WAIT_L(0); PG8_MMA(0, 0, At, B0); PG8_BAR; PG8_SCHED;
            PG8_LDB(B1, 0, 1); PG8_STAGE(PG8_SB(0, 0), b2, voffB);
            PG8_BAR; PG8_WAIT_L(0); PG8_MMA(0, 1, At, B1); PG8_BAR;
            PG8_LDA(At, 0, 1); PG8_STAGE(PG8_SA(0, 0), a2, voffA);
            PG8_BAR; PG8_WAIT_L(0); PG8_MMA(1, 0, At, B0); PG8_BAR; PG8_SCHED;
            PG8_STAGE(PG8_SB(0, 1), b2 + hstep, voffB);
            PG8_WAIT_V(6); PG8_BAR; PG8_MMA(1, 1, At, B1); PG8_BAR;
            PG8_LDB(B0, 1, 0); PG8_SCHED; PG8_LDA(At, 1, 0); PG8_STAGE(PG8_SA(0, 1), a2 + hstep, voffA);
            PG8_WAIT_L(8); PG8_BAR; PG8_WAIT_L(0); PG8_MMA(0, 0, At, B0); PG8_BAR; PG8_SCHED;
            PG8_LDB(B1, 1, 1); PG8_STAGE(PG8_SB(1, 0), b3, voffB);
            PG8_BAR; PG8_WAIT_L(0); PG8_MMA(0, 1, At, B1); PG8_BAR;
            PG8_LDA(At, 1, 1); PG8_STAGE(PG8_SA(1, 0), a3, voffA);
            PG8_BAR; PG8_WAIT_L(0); PG8_MMA(1, 0, At, B0); PG8_BAR; PG8_SCHED;
            PG8_STAGE(PG8_SB(1, 1), b3 + hstep, voffB);
            PG8_WAIT_V(6); PG8_BAR; PG8_MMA(1, 1, At, B1); PG8_BAR;
            }
        }
        if constexpr (ALIGN_EPI) { if (wr == 0) PG8_BAR; }
        if constexpr (!Epi::AFTER_DRAIN) { E(acc, cur, wr, wc, fr, fq); S.done(cur); }
        if (!has_next) break;
#pragma unroll
        for (int a = 0; a < 2; ++a)
#pragma unroll
            for (int b = 0; b < 2; ++b)
#pragma unroll
                for (int m = 0; m < 4; ++m)
#pragma unroll
                    for (int n = 0; n < 2; ++n) acc[a][b][m][n] = (f32x4){0.f, 0.f, 0.f, 0.f};
        cur = nxt; cA = nA; cB = nB; ++ui;
        if constexpr (ALIGN_EPI) { if (wr == 1) PG8_BAR; }
    }
    PG8_WAIT_V(0);
    if constexpr (!ALIGN_EPI) { if (wr == 0) PG8_BAR; }
    PG8_BAR;
    if constexpr (Epi::AFTER_DRAIN) { E.fused(acc, cur, wr, wc, fr, fq, lds, wid, lane); S.done(cur); }
#undef PG8_SA
#undef PG8_SB
#undef PG8_STAGE
#undef PG8_LDA
#undef PG8_LDB
#undef PG8_MMA
#undef PG8_WAIT_V
#undef PG8_WAIT_L
#undef PG8_BAR
#undef PG8_SCHED
}
}

namespace pg8 {
struct EpiResid {
    static constexpr bool PERM = false, AFTER_DRAIN = false;
    const float* base; float* out; int ldc; float alpha;
    __device__ __forceinline__ void operator()(const f32x4 (&acc)[2][2][4][2], const Unit& u, int wr, int wc, int fr, int fq) const {
        const int col0 = u.pn * BM + wc * 32 + 4 * fq;
#pragma unroll
        for (int ai = 0; ai < 2; ++ai)
#pragma unroll
            for (int m = 0; m < 4; ++m) { const int r = ai * HALF + wr * 64 + m * 16 + fr; const size_t off = (size_t)(u.pm * BM + r) * ldc + col0;
#pragma unroll
                for (int bj = 0; bj < 2; ++bj)
#pragma unroll
                    for (int n = 0; n < 2; ++n) { const f32x4 bs = *(const f32x4*)(base + off + bj * HALF + n * 16);
                        const f32x4 o = bs * alpha + acc[ai][bj][m][n]; *(f32x4*)(out + off + bj * HALF + n * 16) = o; }
                if (m & 1) asm volatile("" ::: "memory"); }
    }
};

struct EpiResLn {
    static constexpr bool PERM = false, AFTER_DRAIN = true;
    const float* base; float* out; bf16_t* xn; bf16_t* xl; const float* lg; const float* lb; unsigned long long* xbuf; unsigned* cnt; float alpha, eps;
    __device__ __forceinline__ void fused(f32x4 (&acc)[2][2][4][2], const Unit& u, int wr, int wc, int fr, int fq, PG8_LAS unsigned char* lds, int wid, int lane) const {
        typedef float f32x2v __attribute__((ext_vector_type(2))); typedef unsigned u32x2v __attribute__((ext_vector_type(2)));
        PG8_LAS f32x2v* P = (PG8_LAS f32x2v*)lds;
        PG8_LAS f32x2v* S = (PG8_LAS f32x2v*)(lds + 8192);
        const int col0 = u.pn * BM + wc * 32 + 4 * fq;
#pragma unroll
        for (int ai = 0; ai < 2; ++ai)
#pragma unroll
            for (int m = 0; m < 4; ++m) { const size_t off = (size_t)(u.pm * BM + ai * HALF + wr * 64 + m * 16 + fr) * 2048 + col0;
#pragma unroll
                for (int bj = 0; bj < 2; ++bj)
#pragma unroll
                    for (int n = 0; n < 2; ++n) { f32x4 bs;
                        if (base) bs = *(const f32x4*)(base + off + bj * HALF + n * 16);
                        else { const u32x2v h = *(const u32x2v*)(xn + off + bj * HALF + n * 16), q = *(const u32x2v*)(xl + off + bj * HALF + n * 16);
                            bs[0] = __uint_as_float(h.x << 16) + __uint_as_float(q.x << 16); bs[1] = __uint_as_float(h.x & 0xffff0000u) + __uint_as_float(q.x & 0xffff0000u);
                            bs[2] = __uint_as_float(h.y << 16) + __uint_as_float(q.y << 16); bs[3] = __uint_as_float(h.y & 0xffff0000u) + __uint_as_float(q.y & 0xffff0000u); }
                        acc[ai][bj][m][n] = bs * alpha + acc[ai][bj][m][n]; }
                asm volatile("" : "+v"(acc[ai][0][m][0]), "+v"(acc[ai][0][m][1]), "+v"(acc[ai][1][m][0]), "+v"(acc[ai][1][m][1]));
                if (m == 3) asm volatile("" ::: "memory"); }
#pragma unroll
        for (int ai = 0; ai < 2; ++ai)
#pragma unroll
            for (int m = 0; m < 4; ++m) {
                float s = 0.f;
#pragma unroll
                for (int bj = 0; bj < 2; ++bj)
#pragma unroll
                    for (int n = 0; n < 2; ++n) { const f32x4 x = acc[ai][bj][m][n]; s += (x[0] + x[1]) + (x[2] + x[3]); }
                s += __shfl_xor(s, 16); s += __shfl_xor(s, 32);
                const float mw = s * (1.0f / 64.0f); float q = 0.f;
#pragma unroll
                for (int bj = 0; bj < 2; ++bj)
#pragma unroll
                    for (int n = 0; n < 2; ++n) { const f32x4 d = acc[ai][bj][m][n] - mw; q += (d[0] * d[0] + d[1] * d[1]) + (d[2] * d[2] + d[3] * d[3]); }
                q += __shfl_xor(q, 16); q += __shfl_xor(q, 32);
                if (fq == 0) P[(ai * HALF + wr * 64 + m * 16 + fr) * 4 + wc] = (f32x2v){mw, q};
            }
        asm volatile("s_waitcnt lgkmcnt(0)" ::: "memory"); __builtin_amdgcn_s_barrier(); asm volatile("" ::: "memory");
        const int row = wid * 32 + (lane & 31);
        if (lane < 32) {
            const f32x2v a = P[row * 4 + 0], b = P[row * 4 + 1], c = P[row * 4 + 2], d = P[row * 4 + 3];
            const float mt = (a.x + b.x + c.x + d.x) * 0.25f;
            const float da = a.x - mt, db = b.x - mt, dc = c.x - mt, dd = d.x - mt;
            const float m2 = (a.y + b.y) + (c.y + d.y) + 64.0f * ((da * da + db * db) + (dc * dc + dd * dd));
            unsigned long long* slot = xbuf + ((size_t)(u.pm * BM + row) * 8 + u.pn);
            __hip_atomic_store(slot, ((unsigned long long)__float_as_uint(m2) << 32) | __float_as_uint(mt), __ATOMIC_RELAXED, __HIP_MEMORY_SCOPE_AGENT);
        }
        asm volatile("s_waitcnt vmcnt(0)" ::: "memory");
        if (lane == 0) __hip_atomic_fetch_add(cnt + 64 * u.pm, 1u, __ATOMIC_RELAXED, __HIP_MEMORY_SCOPE_AGENT);
        if (wid == 0) {
            unsigned sp = 0;
            while ((unsigned)__builtin_amdgcn_readfirstlane(__hip_atomic_load(cnt + 64 * u.pm, __ATOMIC_RELAXED, __HIP_MEMORY_SCOPE_AGENT)) < 64u) { __builtin_amdgcn_s_sleep(2); if (++sp > (1u << 22)) break; }
            __builtin_amdgcn_fence(__ATOMIC_ACQUIRE, "agent");
        }
        asm volatile("s_waitcnt vmcnt(0) lgkmcnt(0)" ::: "memory"); __builtin_amdgcn_s_barrier(); asm volatile("" ::: "memory");
        if (lane < 32) {
            const unsigned long long* slot = xbuf + (size_t)(u.pm * BM + row) * 8; float mt[8], m2[8]; float ms = 0.f;
#pragma unroll
            for (int t = 0; t < 8; ++t) { const unsigned long long w = __hip_atomic_load(slot + t, __ATOMIC_RELAXED, __HIP_MEMORY_SCOPE_AGENT); mt[t] = __uint_as_float((unsigned)w); m2[t] = __uint_as_float((unsigned)(w >> 32)); ms += mt[t]; }
            const float mean = ms * 0.125f; float q = 0.f;
#pragma unroll
            for (int t = 0; t < 8; ++t) { const float dm = mt[t] - mean; q += m2[t] + 256.0f * dm * dm; }
            S[row] = (f32x2v){mean, 1.0f / sqrtf(q * (1.0f / 2048.0f) + eps)};
        }
        asm volatile("s_waitcnt lgkmcnt(0)" ::: "memory"); __builtin_amdgcn_s_barrier(); asm volatile("" ::: "memory");
#pragma unroll
        for (int bj = 0; bj < 2; ++bj) { f32x4 gg[2], bb[2];
#pragma unroll
            for (int n = 0; n < 2; ++n) { gg[n] = *(const f32x4*)(lg + col0 + bj * HALF + n * 16); bb[n] = *(const f32x4*)(lb + col0 + bj * HALF + n * 16); }
#pragma unroll
            for (int ai = 0; ai < 2; ++ai)
#pragma unroll
                for (int m = 0; m < 4; ++m) { const int r = ai * HALF + wr * 64 + m * 16 + fr; const f32x2v sr = S[r];
#pragma unroll
                    for (int n = 0; n < 2; ++n) { const size_t off = (size_t)(u.pm * BM + r) * 2048 + col0 + bj * HALF + n * 16;
                        const f32x4 y = (acc[ai][bj][m][n] - sr.x) * sr.y * gg[n] + bb[n];
                        if (out) *(f32x4*)(out + off) = y;
                        else { u32x2v w; w.x = cvt_pk_bf16(y[0], y[1]); w.y = cvt_pk_bf16(y[2], y[3]); *(u32x2v*)(xn + off) = w;
                            u32x2v q; q.x = cvt_pk_bf16(y[0] - __uint_as_float(w.x << 16), y[1] - __uint_as_float(w.x & 0xffff0000u)); q.y = cvt_pk_bf16(y[2] - __uint_as_float(w.y << 16), y[3] - __uint_as_float(w.y & 0xffff0000u));
                            *(u32x2v*)(xl + off) = q; } } } }
    }
};
}

#define LAS __attribute__((address_space(3)))
#define GAS __attribute__((address_space(1)))
typedef unsigned short bf16_t;
typedef short bf16x8 __attribute__((ext_vector_type(8)));
typedef short bf16x4 __attribute__((ext_vector_type(4)));
typedef float f32x4 __attribute__((ext_vector_type(4)));
typedef unsigned u32x4 __attribute__((ext_vector_type(4)));
typedef unsigned u32x2 __attribute__((ext_vector_type(2)));

constexpr int SEQ = 8192, DM = 2048, DEPTH = 4, INW = 6672, NMEM = 256;
constexpr int NMAIN = 5376, NVT = 1536, NWT = NMAIN + NVT;
constexpr int C_AQ = 0, C_AK = 1024, C_AZ = 2048, C_BQ = 3072, C_BK = 3328, C_BZ = 3584, C_MQ = 4096, C_MZ = 4608, C_LR = 5120;
constexpr int NCH = SEQ / 64;
constexpr float LN_EPS = 1e-5f, RMS_EPS = 1e-6f;
constexpr float LOG2E = 1.4426950408889634f;
constexpr float ATT_SC = 0.08838834764831845f * LOG2E;
constexpr int LDS_BYTES = 147456;

constexpr size_t MiB = 1u << 20;
constexpr size_t WS_WIN = 0, WIN_L = (size_t)NWT * DM * 2;
constexpr size_t WS_WOUT = 112 * MiB, WOUT_L = (size_t)DM * DM * 2;
constexpr size_t WS_WMK = 144 * MiB, WS_WMV = 152 * MiB;
constexpr size_t WS_MEMB = 160 * MiB, WS_MK = 161 * MiB, WS_MVT = 162 * MiB;
constexpr size_t WS_XB = 164 * MiB, WS_XF = 196 * MiB, WS_HM = 260 * MiB, WS_Y = 368 * MiB;
constexpr int LDV = SEQ + 64;
constexpr size_t WS_U = 400 * MiB, WS_SP = 416 * MiB, WS_DCY = 424 * MiB, WS_CTL = 426 * MiB, CTL_BYTES = 65536, WS_XCH = 427 * MiB, WS_VT = 428 * MiB, WS_BG = 454 * MiB, WS_XL = 462 * MiB, WS_END = 494 * MiB;
constexpr int CW_CNT = 4096;
static_assert(WS_WIN + 4 * WIN_L <= WS_WOUT, "ws map");
static_assert(WS_HM + (size_t)SEQ * NMAIN * 2 <= WS_Y, "ws map");

struct Params {
    const float *x, *mem, *w_in, *rel, *gate_w, *gate_b, *norm_g, *w_mkv, *w_out, *ln_g, *ln_b;
    float* out; unsigned char* ws; int ph_lo, ph_hi;
};

typedef float f32x2_t __attribute__((ext_vector_type(2))); typedef __bf16 bf16x2_t __attribute__((ext_vector_type(2)));
__device__ __forceinline__ unsigned pk2(float lo, float hi) { const f32x2_t v = {lo, hi}; const bf16x2_t b = __builtin_convertvector(v, bf16x2_t); return __builtin_bit_cast(unsigned, b); }
__device__ __forceinline__ float bflo(unsigned w) { return __uint_as_float(w << 16); }
__device__ __forceinline__ float bfhi(unsigned w) { return __uint_as_float(w & 0xffff0000u); }
__device__ __forceinline__ float silu_f(float z) { return z / (1.0f + __expf(-z)); }
#define MFMA16(a, b, c) __builtin_amdgcn_mfma_f32_16x16x32_bf16((a), (b), (c), 0, 0, 0)

struct ConvItem { const GAS float* src; GAS bf16_t* dst; int ldw; bool ok; };
__device__ __forceinline__ void conv_load(const ConvItem& d, f32x4 (&v)[8]) {
#pragma unroll
    for (int i = 0; i < 8; ++i) v[i] = d.ok ? *(const GAS f32x4*)(d.src + (size_t)(8 * i) * d.ldw) : (f32x4){0.f, 0.f, 0.f, 0.f};
}
__device__ __forceinline__ void conv_store(const ConvItem& d, const f32x4 (&v)[8], LAS float* scr, int lane) {
    const int n4 = 4 * (lane & 7), kr = lane >> 3;
#pragma unroll
    for (int i = 0; i < 8; ++i) { LAS float* q = scr + (8 * i + kr) * 33 + n4; q[0] = v[i].x; q[1] = v[i].y; q[2] = v[i].z; q[3] = v[i].w; }
    asm volatile("s_waitcnt lgkmcnt(0)" ::: "memory");
    const int c = lane & 7;
#pragma unroll
    for (int j = 0; j < 4; ++j) { const int n = (lane >> 3) + 8 * j; const LAS float* s = scr + (8 * c) * 33 + n;
        u32x4 o; o.x = pk2(s[0 * 33], s[1 * 33]); o.y = pk2(s[2 * 33], s[3 * 33]); o.z = pk2(s[4 * 33], s[5 * 33]); o.w = pk2(s[6 * 33], s[7 * 33]);
        *(GAS u32x4*)(d.dst + (size_t)n * DM + 8 * c) = o; }
    asm volatile("s_waitcnt lgkmcnt(0)" ::: "memory");
}
__device__ __forceinline__ void in_seg(int drow, int& src_col, int& nvalid) {
    nvalid = 32;
    if (drow < 2048) src_col = drow;
    else if (drow < 3072) src_col = 3072 + (drow - 2048);
    else if (drow < 3328) src_col = 4096 + (drow - 3072);
    else if (drow < 3584) src_col = 4352 + (drow - 3328);
    else if (drow < 4096) src_col = 5120 + (drow - 3584);
    else if (drow < 4608) src_col = 5648 + (drow - 4096);
    else if (drow < 5120) src_col = 6160 + (drow - 4608);
    else if (drow < 5376) { src_col = 5632; nvalid = (drow == 5120) ? 16 : 0; }
    else if (drow < 6400) src_col = 2048 + (drow - 5376);
    else src_col = 4608 + (drow - 6400);
}
__device__ __forceinline__ ConvItem conv_decode(const Params& p, int l, int it, int lane) {
    constexpr int I_IN = 32 * (NWT / 32), I_OUT = 32 * (DM / 32);
    const int n4 = 4 * (lane & 7), kr = lane >> 3;
    ConvItem d; int r = it;
    if (r < I_IN) { const int g_ = r >> 5, nb = 8 * (g_ % 27) + (r & 7), k0 = 64 * (4 * (g_ / 27) + ((r >> 3) & 3)); int sc, nv; in_seg(32 * nb, sc, nv);
        d.ldw = INW; d.ok = n4 < nv; d.src = (const GAS float*)p.w_in + (size_t)l * DM * INW + (size_t)(k0 + kr) * INW + sc + n4;
        d.dst = (GAS bf16_t*)(p.ws + WS_WIN + l * WIN_L) + (size_t)(32 * nb) * DM + k0; return d; }
    r -= I_IN;
    if (r < I_OUT) { const int g_ = r >> 5, nb = 8 * (g_ % 8) + (r & 7), k0 = 64 * (4 * (g_ / 8) + ((r >> 3) & 3));
        d.ldw = DM; d.ok = true; d.src = (const GAS float*)p.w_out + (size_t)l * DM * DM + (size_t)(k0 + kr) * DM + 32 * nb + n4;
        d.dst = (GAS bf16_t*)(p.ws + WS_WOUT + l * WOUT_L) + (size_t)(32 * nb) * DM + k0; return d; }
    r -= I_OUT;
    { const int g_ = r >> 5, nb = 8 * (g_ % 4) + (r & 7), k0 = 64 * (4 * (g_ / 4) + ((r >> 3) & 3));
        d.ldw = 1024; d.ok = true; d.src = (const GAS float*)p.w_mkv + (size_t)l * DM * 1024 + (size_t)(k0 + kr) * 1024 + 32 * nb + n4;
        d.dst = (GAS bf16_t*)(p.ws + (nb < 16 ? WS_WMK : WS_WMV)) + (size_t)(l * 512 + 32 * (nb & 15)) * DM + k0; return d; }
}
__device__ __forceinline__ void convert_layer(const Params& p, int l, LAS unsigned char* lds, int wk, int nwk) {
    int tid_ = threadIdx.x; asm volatile("" : "+v"(tid_)); const int tid = tid_, lane = tid & 63, wave = tid >> 6;
    LAS float* scr = (LAS float*)(lds + wave * 8704);
    constexpr int I_L = 32 * (NWT / 32) + 32 * (DM / 32) + 32 * 32;
    if (wk >= I_L) return;
    ConvItem cur = conv_decode(p, l, wk, lane); f32x4 v[8]; conv_load(cur, v);
    for (int it = wk; it < I_L; it += nwk) {
        const int nx = it + nwk; ConvItem nxt = cur; f32x4 v2[8];
        if (nx < I_L) { nxt = conv_decode(p, l, nx, lane); conv_load(nxt, v2); }
        conv_store(cur, v, scr, lane);
        if (nx < I_L) { cur = nxt;
#pragma unroll
            for (int i = 0; i < 8; ++i) v[i] = v2[i]; }
    }
}
__device__ __forceinline__ void phase0(const Params& p, LAS unsigned char* lds) {
    int tid_ = threadIdx.x; asm volatile("" : "+v"(tid_)); const int tid = tid_, wave = tid >> 6;
    convert_layer(p, 0, lds, blockIdx.x * 8 + wave, gridDim.x * 8);
    const size_t gt = (size_t)blockIdx.x * 512 + tid, NT = (size_t)gridDim.x * 512;
    GAS bf16_t* xb = (GAS bf16_t*)(p.ws + WS_XB); const GAS f32x4* xs = (const GAS f32x4*)p.x;
    for (size_t i = gt; i < (size_t)SEQ * DM / 8; i += NT) { const f32x4 a = xs[2 * i], b = xs[2 * i + 1];
        u32x4 o; o.x = pk2(a.x, a.y); o.y = pk2(a.z, a.w); o.z = pk2(b.x, b.y); o.w = pk2(b.z, b.w); ((GAS u32x4*)xb)[i] = o; }
    GAS bf16_t* mb = (GAS bf16_t*)(p.ws + WS_MEMB); const GAS f32x4* ms = (const GAS f32x4*)p.mem;
    for (size_t i = gt; i < (size_t)NMEM * DM / 8; i += NT) { const f32x4 a = ms[2 * i], b = ms[2 * i + 1];
        u32x4 o; o.x = pk2(a.x, a.y); o.y = pk2(a.z, a.w); o.z = pk2(b.x, b.y); o.w = pk2(b.z, b.w); ((GAS u32x4*)mb)[i] = o; }
}

constexpr int A_KS = 0, A_KSZ = 64 * 272, A_VS = 2 * A_KSZ, A_VSZ = 128 * 144, A_BT = A_VS + 2 * A_VSZ;
template <bool BAND>
__device__ __forceinline__ void attn_step(LAS unsigned char* lds, int buf, int t, int cw, int w, int r16, int g, const bf16x8 (&qf)[4], f32x4 (&o)[8], float& m, float& l) {
    const LAS float* btab = (const LAS float*)(lds + A_BT);
    const LAS unsigned char* kb_ = lds + A_KS + buf * A_KSZ + r16 * 272 + g * 16;
    f32x4 s[4];
#pragma unroll
    for (int kb = 0; kb < 4; ++kb) { s[kb] = (f32x4){0.f, 0.f, 0.f, 0.f}; bf16x8 kfr[4];
#pragma unroll
        for (int ks = 0; ks < 4; ++ks) kfr[ks] = *(const LAS bf16x8*)(kb_ + kb * 16 * 272 + ks * 64);
#pragma unroll
        for (int ks = 0; ks < 4; ++ks) s[kb] = MFMA16(kfr[ks], qf[ks], s[kb]); }
    if (BAND) {
        const int delta = cw + 8 - t;
        if (delta >= 3) { const float bc = btab[256];
#pragma unroll
            for (int kb = 0; kb < 4; ++kb) s[kb] = s[kb] * ATT_SC + bc;
        } else { const int qi = 16 * (w & 3) + r16;
#pragma unroll
            for (int kb = 0; kb < 4; ++kb)
#pragma unroll
                for (int r = 0; r < 4; ++r) { int dist = 64 * delta + qi - (16 * kb + 4 * g + r); dist = dist > 128 ? 128 : (dist < -128 ? -128 : dist);
                    s[kb][r] = s[kb][r] * ATT_SC + btab[dist + 128]; }
        }
    } else {
#pragma unroll
        for (int kb = 0; kb < 4; ++kb) s[kb] = s[kb] * ATT_SC;
    }
    float mt = fmaxf(fmaxf(s[0][0], s[0][1]), fmaxf(s[0][2], s[0][3]));
#pragma unroll
    for (int kb = 1; kb < 4; ++kb) mt = fmaxf(mt, fmaxf(fmaxf(s[kb][0], s[kb][1]), fmaxf(s[kb][2], s[kb][3])));
    mt = fmaxf(mt, __shfl_xor(mt, 16)); mt = fmaxf(mt, __shfl_xor(mt, 32));
    const float mn = fmaxf(m, mt), alpha = __builtin_amdgcn_exp2f(m - mn); m = mn;
    float rs = 0.f;
#pragma unroll
    for (int kb = 0; kb < 4; ++kb)
#pragma unroll
        for (int r = 0; r < 4; ++r) { const float pv = __builtin_amdgcn_exp2f(s[kb][r] - mn); s[kb][r] = pv; rs += pv; }
    l = l * alpha + rs;
    if (__any(alpha != 1.0f)) {
#pragma unroll
        for (int i = 0; i < 8; ++i) o[i] = o[i] * alpha; }
    bf16x8 pb[2];
#pragma unroll
    for (int s2 = 0; s2 < 2; ++s2) { u32x4 pw; pw.x = pk2(s[2 * s2][0], s[2 * s2][1]); pw.y = pk2(s[2 * s2][2], s[2 * s2][3]);
        pw.z = pk2(s[2 * s2 + 1][0], s[2 * s2 + 1][1]); pw.w = pk2(s[2 * s2 + 1][2], s[2 * s2 + 1][3]); pb[s2] = __builtin_bit_cast(bf16x8, pw); }
    int voff_ = 0; asm volatile("" : "+v"(voff_), "+v"(pb[1]));
    const LAS unsigned char* vb_ = lds + A_VS + buf * A_VSZ + r16 * 144 + g * 8 + voff_;
    u32x2 vfr[2][4];
#pragma unroll
    for (int q = 0; q < 4; ++q) vfr[0][q] = *(const LAS u32x2*)(vb_ + (q >> 1) * 64 + (q & 1) * 32);
#pragma unroll
    for (int dvb = 0; dvb < 8; ++dvb) {
        if (dvb < 7) {
#pragma unroll
            for (int q = 0; q < 4; ++q) vfr[(dvb + 1) & 1][q] = *(const LAS u32x2*)(vb_ + (dvb + 1) * 16 * 144 + (q >> 1) * 64 + (q & 1) * 32); }
#pragma unroll
        for (int s2 = 0; s2 < 2; ++s2) { const u32x2 lo = vfr[dvb & 1][2 * s2], hi = vfr[dvb & 1][2 * s2 + 1];
            const u32x4 av = (u32x4){lo.x, lo.y, hi.x, hi.y}; o[dvb] = MFMA16(__builtin_bit_cast(bf16x8, av), pb[s2], o[dvb]); } }
}
template <bool BAND>
__device__ __forceinline__ void attn_unit(LAS unsigned char* lds, int q_row0, const bf16_t* Qh, int ldq, const bf16_t* Kh, int ldk, const bf16_t* Vth, int ldvt,
                                          const bf16_t* Zh, int ldz, bf16_t* Yh, int ldy, const float* bias_tab, int j2) {
    int tid_ = threadIdx.x; asm volatile("" : "+v"(tid_)); const int tid = tid_, lane = tid & 63, w = __builtin_amdgcn_readfirstlane(tid >> 6), r16 = lane & 15, g = lane >> 4;
    LAS float* btab = (LAS float*)(lds + A_BT);
    if (BAND) { for (int i = tid; i < 257; i += 512) btab[i] = ((const GAS float*)bias_tab)[i] * LOG2E; }
    const GAS bf16_t* qp = (const GAS bf16_t*)Qh + (size_t)(q_row0 + 16 * w + r16) * ldq + 8 * g;
    bf16x8 qf[4];
#pragma unroll
    for (int ks = 0; ks < 4; ++ks) qf[ks] = *(const GAS bf16x8*)(qp + 32 * ks);
    f32x4 o[8];
#pragma unroll
    for (int i = 0; i < 8; ++i) o[i] = (f32x4){0.f, 0.f, 0.f, 0.f};
    float m = -1e30f, l = 0.f;
    const int cw = BAND ? (w >> 2) : 0;
    const int nt = BAND ? 10 : 4;
    int t0 = 0; if (BAND) { t0 = 8 - 2 * j2; if (t0 < 0) t0 = 0; }
    u32x4 kA[2], vA[2], kB[2], vB[2];
#define A_GLOAD(kr, vr, t) do { const int key0_ = BAND ? 64 * (2 * j2 - 8 + (t)) : 64 * (t); \
        _Pragma("unroll") for (int i_ = 0; i_ < 2; ++i_) { const int id_ = tid + 512 * i_; \
            kr[i_] = *(const GAS u32x4*)((const GAS bf16_t*)Kh + (size_t)(key0_ + (id_ >> 4)) * ldk + (id_ & 15) * 8); \
            vr[i_] = *(const GAS u32x4*)((const GAS bf16_t*)Vth + (size_t)(id_ >> 3) * ldvt + key0_ + (id_ & 7) * 8); } } while (0)
#define A_LSTORE(kr, vr, buf) do { _Pragma("unroll") for (int i_ = 0; i_ < 2; ++i_) { const int id_ = tid + 512 * i_; \
            *(LAS u32x4*)(lds + A_KS + (buf) * A_KSZ + (id_ >> 4) * 272 + (id_ & 15) * 16) = kr[i_]; \
            *(LAS u32x4*)(lds + A_VS + (buf) * A_VSZ + (id_ >> 3) * 144 + (id_ & 7) * 16) = vr[i_]; } } while (0)
    A_GLOAD(kA, vA, t0); A_GLOAD(kB, vB, t0 + 1); A_LSTORE(kA, vA, 0); __syncthreads();
    for (int t = t0; t < nt; t += 2) {
        if (t + 2 < nt) A_GLOAD(kA, vA, t + 2);
        if (!BAND || (t >= cw && t <= cw + 8)) attn_step<BAND>(lds, 0, t, cw, w, r16, g, qf, o, m, l);
        A_LSTORE(kB, vB, 1);
        __syncthreads();
        if (t + 3 < nt) A_GLOAD(kB, vB, t + 3);
        if (!BAND || (t + 1 >= cw && t + 1 <= cw + 8)) attn_step<BAND>(lds, 1, t + 1, cw, w, r16, g, qf, o, m, l);
        if (t + 2 < nt) A_LSTORE(kA, vA, 0);
        __syncthreads();
    }
#undef A_GLOAD
#undef A_LSTORE
    l += __shfl_xor(l, 16); l += __shfl_xor(l, 32);
    const float inv = 1.0f / l;
    const size_t row = (size_t)(q_row0 + 16 * w + r16);
#pragma unroll
    for (int dvb = 0; dvb < 8; ++dvb) { const int col = 16 * dvb + 4 * g; const u32x2 z = *(const GAS u32x2*)((const GAS bf16_t*)Zh + row * ldz + col);
        const float y0 = o[dvb][0] * inv * silu_f(bflo(z.x)), y1 = o[dvb][1] * inv * silu_f(bfhi(z.x)), y2 = o[dvb][2] * inv * silu_f(bflo(z.y)), y3 = o[dvb][3] * inv * silu_f(bfhi(z.y));
        u32x2 yo; yo.x = pk2(y0, y1); yo.y = pk2(y2, y3); *(GAS u32x2*)((GAS bf16_t*)Yh + row * ldy + col) = yo; }
}


constexpr int P_HALF = 2 * A_KSZ + 2 * A_VSZ, P_BT = 2 * P_HALF;
static_assert(P_BT + 2 * 1028 <= LDS_BYTES - 64, "pair attention LDS map");
__device__ __forceinline__ void band_pair_step(LAS unsigned char* hl, const LAS float* btab, int buf, int t, int cw, int w4, int r16, int g,
                                               const bf16x8 (&qf)[2][4], f32x4 (&o)[2][8], float (&m)[2], f32x4 (&l)[2]) {
    const LAS unsigned char* kb_ = hl + buf * A_KSZ + r16 * 272 + g * 16;
    f32x4 s[2][4];
#pragma unroll
    for (int kb = 0; kb < 4; ++kb) { bf16x8 kfr[4];
#pragma unroll
        for (int ks = 0; ks < 4; ++ks) kfr[ks] = *(const LAS bf16x8*)(kb_ + kb * 16 * 272 + ks * 64);
#pragma unroll
        for (int rb = 0; rb < 2; ++rb) { s[rb][kb] = (f32x4){0.f, 0.f, 0.f, 0.f};
#pragma unroll
            for (int ks = 0; ks < 4; ++ks) s[rb][kb] = MFMA16(kfr[ks], qf[rb][ks], s[rb][kb]); } }
    const int delta = cw + 8 - t;
    bf16x8 pb[2][2];
    const bf16x8 ones = (bf16x8){16256, 16256, 16256, 16256, 16256, 16256, 16256, 16256};
#pragma unroll
    for (int rb = 0; rb < 2; ++rb) {
        float mn, alpha;
        if (delta >= 3) {
            const float bc = btab[256];
            float mt = fmaxf(fmaxf(s[rb][0][0], s[rb][0][1]), fmaxf(s[rb][0][2], s[rb][0][3]));
#pragma unroll
            for (int kb = 1; kb < 4; ++kb) mt = fmaxf(mt, fmaxf(fmaxf(s[rb][kb][0], s[rb][kb][1]), fmaxf(s[rb][kb][2], s[rb][kb][3])));
            mt = fmaxf(mt, __shfl_xor(mt, 16)); mt = fmaxf(mt, __shfl_xor(mt, 32));
            mn = fmaxf(m[rb], mt * ATT_SC + bc); alpha = __builtin_amdgcn_exp2f(m[rb] - mn); m[rb] = mn;
            const float off = bc - mn;
#pragma unroll
            for (int kb = 0; kb < 4; ++kb)
#pragma unroll
                for (int r = 0; r < 4; ++r) s[rb][kb][r] = __builtin_amdgcn_exp2f(s[rb][kb][r] * ATT_SC + off);
        } else { const int qi = 32 * (w4 & 1) + 16 * rb + r16;
#pragma unroll
            for (int kb = 0; kb < 4; ++kb)
#pragma unroll
                for (int r = 0; r < 4; ++r) { int dist = 64 * delta + qi - (16 * kb + 4 * g + r); dist = dist > 128 ? 128 : (dist < -128 ? -128 : dist);
                    s[rb][kb][r] = s[rb][kb][r] * ATT_SC + btab[dist + 128]; }
            float mt = fmaxf(fmaxf(s[rb][0][0], s[rb][0][1]), fmaxf(s[rb][0][2], s[rb][0][3]));
#pragma unroll
            for (int kb = 1; kb < 4; ++kb) mt = fmaxf(mt, fmaxf(fmaxf(s[rb][kb][0], s[rb][kb][1]), fmaxf(s[rb][kb][2], s[rb][kb][3])));
            mt = fmaxf(mt, __shfl_xor(mt, 16)); mt = fmaxf(mt, __shfl_xor(mt, 32));
            mn = fmaxf(m[rb], mt); alpha = __builtin_amdgcn_exp2f(m[rb] - mn); m[rb] = mn;
#pragma unroll
            for (int kb = 0; kb < 4; ++kb)
#pragma unroll
                for (int r = 0; r < 4; ++r) s[rb][kb][r] = __builtin_amdgcn_exp2f(s[rb][kb][r] - mn);
        }
        if (__any(alpha != 1.0f)) { l[rb] = l[rb] * alpha;
#pragma unroll
            for (int i = 0; i < 8; ++i) o[rb][i] = o[rb][i] * alpha; }
#pragma unroll
        for (int s2 = 0; s2 < 2; ++s2) { u32x4 pw; pw.x = pk2(s[rb][2 * s2][0], s[rb][2 * s2][1]); pw.y = pk2(s[rb][2 * s2][2], s[rb][2 * s2][3]);
            pw.z = pk2(s[rb][2 * s2 + 1][0], s[rb][2 * s2 + 1][1]); pw.w = pk2(s[rb][2 * s2 + 1][2], s[rb][2 * s2 + 1][3]); pb[rb][s2] = __builtin_bit_cast(bf16x8, pw);
            l[rb] = MFMA16(ones, pb[rb][s2], l[rb]); }
    }
    int voff_ = 0; asm volatile("" : "+v"(voff_), "+v"(pb[1][1]));
    const LAS unsigned char* vb_ = hl + 2 * A_KSZ + buf * A_VSZ + r16 * 144 + g * 8 + voff_;
#pragma unroll
    for (int dvb = 0; dvb < 8; ++dvb) { u32x2 vfr[4];
#pragma unroll
        for (int q = 0; q < 4; ++q) vfr[q] = *(const LAS u32x2*)(vb_ + dvb * 16 * 144 + (q >> 1) * 64 + (q & 1) * 32);
#pragma unroll
        for (int s2 = 0; s2 < 2; ++s2) { const u32x4 av = (u32x4){vfr[2 * s2].x, vfr[2 * s2].y, vfr[2 * s2 + 1].x, vfr[2 * s2 + 1].y};
#pragma unroll
            for (int rb = 0; rb < 2; ++rb) o[rb][dvb] = MFMA16(__builtin_bit_cast(bf16x8, av), pb[rb][s2], o[rb][dvb]); } }
}
__device__ __forceinline__ void band_pair_unit(LAS unsigned char* lds, const Params& p, int l, int j2, int hA) {
    int tid_ = threadIdx.x; asm volatile("" : "+v"(tid_)); const int tid = tid_, lane = tid & 63, w = __builtin_amdgcn_readfirstlane(tid >> 6), r16 = lane & 15, g = lane >> 4;
    const int half = w >> 2, w4 = w & 3, th = tid & 255, head = hA + half;
    LAS unsigned char* hl = lds + half * P_HALF;
    LAS float* btab = (LAS float*)(lds + P_BT + half * 1028);
    { const GAS float* bt = (const GAS float*)p.rel + (l * 8 + head) * 257; for (int i = th; i < 257; i += 256) btab[i] = bt[i] * LOG2E; }
    const GAS bf16_t* hm = (const GAS bf16_t*)(p.ws + WS_HM);
    const GAS bf16_t* Kh = hm + C_AK + head * 128; const GAS bf16_t* Vth = (const GAS bf16_t*)(p.ws + WS_VT) + (size_t)(head * 128) * LDV;
    const int row0 = 128 * j2 + 32 * w4 + r16;
    bf16x8 qf[2][4];
#pragma unroll
    for (int rb = 0; rb < 2; ++rb)
#pragma unroll
        for (int ks = 0; ks < 4; ++ks) qf[rb][ks] = *(const GAS bf16x8*)(hm + (size_t)(row0 + 16 * rb) * NMAIN + C_AQ + head * 128 + 32 * ks + 8 * g);
    f32x4 o[2][8];
#pragma unroll
    for (int rb = 0; rb < 2; ++rb)
#pragma unroll
        for (int i = 0; i < 8; ++i) o[rb][i] = (f32x4){0.f, 0.f, 0.f, 0.f};
    float m[2] = {-1e30f, -1e30f}; f32x4 l_[2] = {(f32x4){0.f, 0.f, 0.f, 0.f}, (f32x4){0.f, 0.f, 0.f, 0.f}};
    const int cw = w4 >> 1, nt = 10;
    int t0 = 8 - 2 * j2; if (t0 < 0) t0 = 0;
    u32x4 kr[4], vr[4];
#define P_GLOAD(t) do { const int key0_ = 64 * (2 * j2 - 8 + (t)); \
        _Pragma("unroll") for (int i_ = 0; i_ < 4; ++i_) { const int id_ = th + 256 * i_; \
            kr[i_] = *(const GAS u32x4*)(Kh + (size_t)(key0_ + (id_ >> 4)) * NMAIN + (id_ & 15) * 8); \
            vr[i_] = *(const GAS u32x4*)(Vth + (size_t)(id_ >> 3) * LDV + key0_ + (id_ & 7) * 8); } } while (0)
#define P_LSTORE(buf) do { _Pragma("unroll") for (int i_ = 0; i_ < 4; ++i_) { const int id_ = th + 256 * i_; \
            *(LAS u32x4*)(hl + (buf) * A_KSZ + (id_ >> 4) * 272 + (id_ & 15) * 16) = kr[i_]; \
            *(LAS u32x4*)(hl + 2 * A_KSZ + (buf) * A_VSZ + (id_ >> 3) * 144 + (id_ & 7) * 16) = vr[i_]; } } while (0)
    P_GLOAD(t0); P_LSTORE(0); __syncthreads();
    for (int t = t0; t < nt; ++t) {
        const int buf = (t - t0) & 1;
        if (t + 1 < nt) P_GLOAD(t + 1);
        if (t >= cw && t <= cw + 8) band_pair_step(hl, btab, buf, t, cw, w4, r16, g, qf, o, m, l_);
        if (t + 1 < nt) P_LSTORE(buf ^ 1);
        __syncthreads();
    }
#undef P_GLOAD
#undef P_LSTORE
    GAS bf16_t* Y = (GAS bf16_t*)(p.ws + WS_Y);
#pragma unroll
    for (int rb = 0; rb < 2; ++rb) { const float inv = 1.0f / l_[rb][0]; const size_t row = (size_t)(row0 + 16 * rb);
#pragma unroll
        for (int dvb = 0; dvb < 8; ++dvb) { const int col = 16 * dvb + 4 * g; const u32x2 z = *(const GAS u32x2*)(hm + row * NMAIN + C_AZ + head * 128 + col);
            const float y0 = o[rb][dvb][0] * inv * silu_f(bflo(z.x)), y1 = o[rb][dvb][1] * inv * silu_f(bfhi(z.x)), y2 = o[rb][dvb][2] * inv * silu_f(bflo(z.y)), y3 = o[rb][dvb][3] * inv * silu_f(bfhi(z.y));
            u32x2 yo; yo.x = pk2(y0, y1); yo.y = pk2(y2, y3); *(GAS u32x2*)(Y + row * DM + head * 128 + col) = yo; } }
}

constexpr int G_LR = 0, G_GW = 4096, G_GB = 8192, G_SEG = 8448, G_B = 10496, G_SSQ = 27136, G_QP = 27648, G_QM = 36864, G_KP = 46080, G_KM = 55296,
              G_KD = 64512, G_AT = 73728, G_VT = 82944, G_ST = 101376;
__device__ __forceinline__ void gla_compute_b(LAS unsigned char* lds, const bf16_t* hm_rows, const float* gw_l, const float* gb_l, int hb) {
    int tid_ = threadIdx.x; asm volatile("" : "+v"(tid_)); const int tid = tid_;
    LAS float* LR = (LAS float*)(lds + G_LR); LAS float* GW = (LAS float*)(lds + G_GW); LAS float* GB = (LAS float*)(lds + G_GB);
    LAS float* SEG = (LAS float*)(lds + G_SEG); LAS float* Bm = (LAS float*)(lds + G_B);
    if (tid < 128) { const int row = tid >> 1, half = tid & 1; const u32x4 v = *(const GAS u32x4*)((const GAS bf16_t*)hm_rows + (size_t)row * NMAIN + C_LR + 8 * half);
        LAS float* d = LR + row * 16 + 8 * half; d[0] = bflo(v.x); d[1] = bfhi(v.x); d[2] = bflo(v.y); d[3] = bfhi(v.y); d[4] = bflo(v.z); d[5] = bfhi(v.z); d[6] = bflo(v.w); d[7] = bfhi(v.w); }
    for (int i = tid; i < 1024; i += 512) GW[i] = ((const GAS float*)gw_l)[(i >> 6) * 256 + hb * 64 + (i & 63)];
    if (tid < 64) GB[tid] = ((const GAS float*)gb_l)[hb * 64 + tid];
    __syncthreads();
    const int d = tid & 63, tseg = tid >> 6;
    float gwr[16];
#pragma unroll
    for (int r = 0; r < 16; ++r) gwr[r] = GW[r * 64 + d];
    const float gbv = GB[d];
    float loc[8]; float run = 0.f;
#pragma unroll
    for (int tt = 0; tt < 8; ++tt) { const int t = 8 * tseg + tt; float x = gbv;
#pragma unroll
        for (int r = 0; r < 16; ++r) x += LR[t * 16 + r] * gwr[r];
        const float lg = (fminf(x, 0.f) - __logf(1.0f + __expf(-fabsf(x)))) * 0.0625f;
        run += lg; loc[tt] = run; }
    SEG[tseg * 64 + d] = run;
    __syncthreads();
    float off = 0.f;
#pragma unroll
    for (int s = 0; s < 8; ++s) { const float v = SEG[s * 64 + d]; off += (s < tseg) ? v : 0.f; }
#pragma unroll
    for (int tt = 0; tt < 8; ++tt) Bm[(8 * tseg + tt) * 65 + d] = off + loc[tt];
    __syncthreads();
}
__device__ __forceinline__ void gla_load_vt(LAS unsigned char* lds, const bf16_t* VTg, int hb, int c) {
    int tid_ = threadIdx.x; asm volatile("" : "+v"(tid_)); const int tid = tid_;
#pragma unroll
    for (int i = 0; i < 2; ++i) { const int id = tid + 512 * i, row = id >> 3, c8 = id & 7;
        *(LAS u32x4*)(lds + G_VT + row * 144 + c8 * 16) = *(const GAS u32x4*)((const GAS bf16_t*)VTg + (size_t)(1024 + hb * 128 + row) * LDV + 64 * c + 8 * c8); }
}
__device__ __forceinline__ void gla_part1(LAS unsigned char* lds, const Params& p, int l, int c, int hb) {
    int tid_ = threadIdx.x; asm volatile("" : "+v"(tid_)); const int tid = tid_, lane = tid & 63, w = __builtin_amdgcn_readfirstlane(tid >> 6), r16 = lane & 15, g = lane >> 4;
    const bf16_t* hm_rows = (const bf16_t*)(p.ws + WS_HM) + (size_t)(64 * c) * NMAIN;
    gla_compute_b(lds, hm_rows, p.gate_w + l * 16 * 256, p.gate_b + l * 256, hb);
    const LAS float* Bm = (const LAS float*)(lds + G_B);
    { GAS float* BG = (GAS float*)(p.ws + WS_BG) + (size_t)(64 * c) * 256 + hb * 64;
        const int t = tid >> 3, dc = tid & 7; f32x4 b0, b1;
        b0.x = Bm[t * 65 + 8 * dc + 0]; b0.y = Bm[t * 65 + 8 * dc + 1]; b0.z = Bm[t * 65 + 8 * dc + 2]; b0.w = Bm[t * 65 + 8 * dc + 3];
        b1.x = Bm[t * 65 + 8 * dc + 4]; b1.y = Bm[t * 65 + 8 * dc + 5]; b1.z = Bm[t * 65 + 8 * dc + 6]; b1.w = Bm[t * 65 + 8 * dc + 7];
        *(GAS f32x4*)(BG + (size_t)t * 256 + 8 * dc) = b0; *(GAS f32x4*)(BG + (size_t)t * 256 + 8 * dc + 4) = b1; }
    { const int t = tid >> 3, dc = tid & 7; const u32x4 kv = *(const GAS u32x4*)((const GAS bf16_t*)hm_rows + (size_t)t * NMAIN + C_BK + hb * 64 + 8 * dc);
        float kf[8] = {bflo(kv.x), bfhi(kv.x), bflo(kv.y), bfhi(kv.y), bflo(kv.z), bfhi(kv.z), bflo(kv.w), bfhi(kv.w)};
        LAS bf16_t* KD = (LAS bf16_t*)(lds + G_KD);
#pragma unroll
        for (int e = 0; e < 8; ++e) { const int d = 8 * dc + e; const float val = kf[e] * __expf(Bm[63 * 65 + d] - Bm[t * 65 + d]); KD[d * 72 + t] = (bf16_t)(pk2(val, 0.f) & 0xffffu); } }
    gla_load_vt(lds, (const bf16_t*)(p.ws + WS_VT), hb, c);
    if (tid < 64) ((GAS float*)(p.ws + WS_DCY))[(c * 4 + hb) * 64 + tid] = __expf(Bm[63 * 65 + tid]);
    __syncthreads();
    GAS bf16_t* U = (GAS bf16_t*)(p.ws + WS_U) + (size_t)(c * 4 + hb) * 8192;
    const LAS unsigned char* Ap = lds + G_VT + (16 * w + r16) * 144 + g * 16;
#pragma unroll
    for (int dkb = 0; dkb < 4; ++dkb) { const LAS unsigned char* Bp = lds + G_KD + (16 * dkb + r16) * 144 + g * 16; f32x4 acc = (f32x4){0.f, 0.f, 0.f, 0.f};
#pragma unroll
        for (int ks = 0; ks < 2; ++ks) acc = MFMA16(*(const LAS bf16x8*)(Bp + ks * 64), *(const LAS bf16x8*)(Ap + ks * 64), acc);
        u32x2 ub; ub.x = pk2(acc[0], acc[1]); ub.y = pk2(acc[2], acc[3]); *(GAS u32x2*)(U + (16 * w + r16) * 64 + 16 * dkb + 4 * g) = ub; }
    __syncthreads();
}
__device__ __forceinline__ void gla_scan(const Params& p, LAS unsigned char* lds) {
    int tid_ = threadIdx.x; asm volatile("" : "+v"(tid_)); const int tid = tid_, seg = tid >> 7, el = tid & 127;
    LAS float* CE = (LAS float*)lds;
    for (int eg = blockIdx.x; eg < 256; eg += gridDim.x) {
        const int e = eg * 128 + el, hb = e >> 13, rem = e & 8191, dk = rem & 63;
        const GAS bf16_t* U = (const GAS bf16_t*)(p.ws + WS_U) + (size_t)hb * 8192 + rem + (size_t)(seg * 32) * 32768;
        const GAS float* dcy = (const GAS float*)(p.ws + WS_DCY) + hb * 64 + dk + (seg * 32) * 256;
        GAS bf16_t* Sp = (GAS bf16_t*)(p.ws + WS_SP) + (size_t)hb * 8192 + rem + (size_t)(seg * 32) * 32768;
        float uv[32], dv[32];
#pragma unroll
        for (int j = 0; j < 32; ++j) { uv[j] = __uint_as_float(((unsigned)U[(size_t)j * 32768]) << 16); dv[j] = dcy[j * 256]; }
        float s = 0.f, pd = 1.f;
#pragma unroll
        for (int j = 0; j < 32; ++j) { const float u = uv[j], d = dv[j]; uv[j] = s; dv[j] = pd; s = d * s + u; pd *= d; }
        CE[seg * 128 + el] = s; CE[512 + seg * 128 + el] = pd;
        __syncthreads();
        float st = 0.f;
#pragma unroll
        for (int q = 0; q < 3; ++q) { const float se = CE[q * 128 + el], pe = CE[512 + q * 128 + el]; st = (q < seg) ? pe * st + se : st; }
#pragma unroll
        for (int j = 0; j < 32; ++j) Sp[(size_t)j * 32768] = (bf16_t)(pk2(uv[j] + dv[j] * st, 0.f) & 0xffffu);
        __syncthreads();
    }
}
struct Gla2Regs { u32x4 qv, kv; f32x4 b0, b1; u32x4 vt[2], st[2]; u32x2 zpre[4]; f32x4 gpre[4]; };
__device__ __forceinline__ void gla_part2_load(Gla2Regs& R, const Params& p, int l, int c, int hb, int tid, int w, int r16, int g) {
    const GAS bf16_t* hm_rows = (const GAS bf16_t*)(p.ws + WS_HM) + (size_t)(64 * c) * NMAIN;
    const int t = tid >> 3, dc = tid & 7;
    R.qv = *(const GAS u32x4*)(hm_rows + (size_t)t * NMAIN + C_BQ + hb * 64 + 8 * dc); R.kv = *(const GAS u32x4*)(hm_rows + (size_t)t * NMAIN + C_BK + hb * 64 + 8 * dc);
    const GAS float* BG = (const GAS float*)(p.ws + WS_BG) + (size_t)(64 * c + t) * 256 + hb * 64 + 8 * dc;
    R.b0 = *(const GAS f32x4*)BG; R.b1 = *(const GAS f32x4*)(BG + 4);
    const GAS bf16_t* VTg = (const GAS bf16_t*)(p.ws + WS_VT); const GAS bf16_t* Sp = (const GAS bf16_t*)(p.ws + WS_SP) + (size_t)(c * 4 + hb) * 8192;
#pragma unroll
    for (int i = 0; i < 2; ++i) { const int id = tid + 512 * i, row = id >> 3, c8 = id & 7;
        R.vt[i] = *(const GAS u32x4*)(VTg + (size_t)(1024 + hb * 128 + row) * LDV + 64 * c + 8 * c8); R.st[i] = *(const GAS u32x4*)(Sp + row * 64 + 8 * c8); }
    const int i_ = 16 * (w & 3) + r16;
#pragma unroll
    for (int q4 = 0; q4 < 4; ++q4) { const int dv0 = 16 * (4 * (w >> 2) + q4) + 4 * g;
        R.zpre[q4] = *(const GAS u32x2*)(hm_rows + (size_t)i_ * NMAIN + C_BZ + hb * 128 + dv0); R.gpre[q4] = *(const GAS f32x4*)((const GAS float*)p.norm_g + l * 128 + dv0); }
}
__device__ __forceinline__ void gla_part2(LAS unsigned char* lds, const Params& p, int l, int c, int hb, const Gla2Regs& R, int tid, int w, int r16, int g) {
    const bf16_t* hm_rows = (const bf16_t*)(p.ws + WS_HM) + (size_t)(64 * c) * NMAIN;
    u32x2 zpre[4]; f32x4 gpre[4];
#pragma unroll
    for (int q4 = 0; q4 < 4; ++q4) { zpre[q4] = R.zpre[q4]; gpre[q4] = R.gpre[q4]; }
    {
        const int t = tid >> 3, dc = tid & 7;
        const u32x4 qv = R.qv, kv = R.kv; const f32x4 b0 = R.b0, b1 = R.b1;
        u32x4 vt[2] = {R.vt[0], R.vt[1]}, st[2] = {R.st[0], R.st[1]};
        float qf[8] = {bflo(qv.x), bfhi(qv.x), bflo(qv.y), bfhi(qv.y), bflo(qv.z), bfhi(qv.z), bflo(qv.w), bfhi(qv.w)};
        float kf[8] = {bflo(kv.x), bfhi(kv.x), bflo(kv.y), bfhi(kv.y), bflo(kv.z), bfhi(kv.z), bflo(kv.w), bfhi(kv.w)};
        float bb[8] = {b0.x, b0.y, b0.z, b0.w, b1.x, b1.y, b1.z, b1.w};
        float qpv[8], qmv[8], kpv[8], kmv[8];
#pragma unroll
        for (int e = 0; e < 8; ++e) { const float ep = __expf(bb[e]), em = __expf(-bb[e]), q8 = qf[e] * 0.125f;
            qpv[e] = q8 * ep; qmv[e] = q8 * em; kpv[e] = kf[e] * ep; kmv[e] = kf[e] * em; }
        const int o = t * 144 + dc * 16;
        *(LAS u32x4*)(lds + G_QP + o) = (u32x4){pk2(qpv[0], qpv[1]), pk2(qpv[2], qpv[3]), pk2(qpv[4], qpv[5]), pk2(qpv[6], qpv[7])};
        *(LAS u32x4*)(lds + G_QM + o) = (u32x4){pk2(qmv[0], qmv[1]), pk2(qmv[2], qmv[3]), pk2(qmv[4], qmv[5]), pk2(qmv[6], qmv[7])};
        *(LAS u32x4*)(lds + G_KP + o) = (u32x4){pk2(kpv[0], kpv[1]), pk2(kpv[2], kpv[3]), pk2(kpv[4], kpv[5]), pk2(kpv[6], kpv[7])};
        *(LAS u32x4*)(lds + G_KM + o) = (u32x4){pk2(kmv[0], kmv[1]), pk2(kmv[2], kmv[3]), pk2(kmv[4], kmv[5]), pk2(kmv[6], kmv[7])};
#pragma unroll
        for (int i = 0; i < 2; ++i) { const int id = tid + 512 * i, row = id >> 3, c8 = id & 7;
            *(LAS u32x4*)(lds + G_VT + row * 144 + c8 * 16) = vt[i]; *(LAS u32x4*)(lds + G_ST + row * 144 + c8 * 16) = st[i]; }
    }
    __syncthreads();
    { const int ib = w >> 1; LAS bf16_t* AT = (LAS bf16_t*)(lds + G_AT);
        const LAS unsigned char* qpA = lds + G_QP + (16 * ib + r16) * 144 + g * 16; const LAS unsigned char* qmA = lds + G_QM + (16 * ib + r16) * 144 + g * 16;
#pragma unroll
        for (int jj = 0; jj < 2; ++jj) { const int jb = 2 * (w & 1) + jj;
            const LAS unsigned char* kmB = lds + G_KM + (16 * jb + r16) * 144 + g * 16; const LAS unsigned char* kpB = lds + G_KP + (16 * jb + r16) * 144 + g * 16;
            f32x4 lo = (f32x4){0.f, 0.f, 0.f, 0.f}, hi = lo;
#pragma unroll
            for (int ks = 0; ks < 2; ++ks) { lo = MFMA16(*(const LAS bf16x8*)(qpA + ks * 64), *(const LAS bf16x8*)(kmB + ks * 64), lo);
                hi = MFMA16(*(const LAS bf16x8*)(qmA + ks * 64), *(const LAS bf16x8*)(kpB + ks * 64), hi); }
#pragma unroll
            for (int r = 0; r < 4; ++r) { const int i = 16 * ib + 4 * g + r, j = 16 * jb + r16; const float v = (j <= i) ? lo[r] : hi[r]; AT[i * 72 + j] = (bf16_t)(pk2(v, 0.f) & 0xffffu); } } }
    __syncthreads();
    const int ib = w & 3, dvh = w >> 2;
    f32x4 oacc[4];
    { const LAS unsigned char* atA = lds + G_AT + (16 * ib + r16) * 144 + g * 16; const LAS unsigned char* qpA = lds + G_QP + (16 * ib + r16) * 144 + g * 16;
#pragma unroll
        for (int q4 = 0; q4 < 4; ++q4) { const int dvb = 4 * dvh + q4;
            const LAS unsigned char* vtB = lds + G_VT + (16 * dvb + r16) * 144 + g * 16; const LAS unsigned char* stB = lds + G_ST + (16 * dvb + r16) * 144 + g * 16;
            f32x4 acc = (f32x4){0.f, 0.f, 0.f, 0.f};
#pragma unroll
            for (int ks = 0; ks < 2; ++ks) { acc = MFMA16(*(const LAS bf16x8*)(vtB + ks * 64), *(const LAS bf16x8*)(atA + ks * 64), acc);
                acc = MFMA16(*(const LAS bf16x8*)(stB + ks * 64), *(const LAS bf16x8*)(qpA + ks * 64), acc); }
            oacc[q4] = acc; } }
    LAS float* SSQ = (LAS float*)(lds + G_SSQ);
    { float pr = 0.f;
#pragma unroll
        for (int q4 = 0; q4 < 4; ++q4) pr += (oacc[q4][0] * oacc[q4][0] + oacc[q4][1] * oacc[q4][1]) + (oacc[q4][2] * oacc[q4][2] + oacc[q4][3] * oacc[q4][3]);
        pr += __shfl_xor(pr, 16); pr += __shfl_xor(pr, 32);
        if (g == 0) SSQ[dvh * 64 + 16 * ib + r16] = pr; }
    __syncthreads();
    { const int i = 16 * ib + r16; const float rinv = rsqrtf((SSQ[i] + SSQ[64 + i]) * (1.0f / 128.0f) + RMS_EPS);
        GAS bf16_t* Yr = (GAS bf16_t*)(p.ws + WS_Y) + (size_t)(64 * c + i) * DM + 1024 + hb * 128;
#pragma unroll
        for (int q4 = 0; q4 < 4; ++q4) { const int dv0 = 16 * (4 * dvh + q4) + 4 * g; const u32x2 z = zpre[q4]; const f32x4 gg = gpre[q4];
            const float y0 = oacc[q4][0] * rinv * gg.x * silu_f(bflo(z.x)), y1 = oacc[q4][1] * rinv * gg.y * silu_f(bfhi(z.x)), y2 = oacc[q4][2] * rinv * gg.z * silu_f(bflo(z.y)), y3 = oacc[q4][3] * rinv * gg.w * silu_f(bfhi(z.y));
            u32x2 yo; yo.x = pk2(y0, y1); yo.y = pk2(y2, y3); *(GAS u32x2*)(Yr + dv0) = yo; } }
    __syncthreads();
}

__device__ __forceinline__ void ln_phase(const Params& p, int l, const float* tin, float* fout) {
    int tid_ = threadIdx.x; asm volatile("" : "+v"(tid_)); const int tid = tid_, lane = tid & 63, wave = tid >> 6;
    const int gw = blockIdx.x * 8 + wave, NGW = gridDim.x * 8;
    const float* lg = p.ln_g + l * DM; const float* lb = p.ln_b + l * DM; bf16_t* xb = (bf16_t*)(p.ws + WS_XB);
    for (int row = gw; row < SEQ; row += NGW) {
        const f32x4* xr = (const f32x4*)(tin + (size_t)row * DM) + lane;
        f32x4 v[8]; float s = 0.f;
#pragma unroll
        for (int j = 0; j < 8; ++j) { v[j] = xr[64 * j]; s += (v[j].x + v[j].y) + (v[j].z + v[j].w); }
#pragma unroll
        for (int o = 1; o < 64; o <<= 1) s += __shfl_xor(s, o);
        const float mean = s * (1.0f / DM); float s2 = 0.f;
#pragma unroll
        for (int j = 0; j < 8; ++j) { v[j] = v[j] - mean; s2 += (v[j].x * v[j].x + v[j].y * v[j].y) + (v[j].z * v[j].z + v[j].w * v[j].w); }
#pragma unroll
        for (int o = 1; o < 64; o <<= 1) s2 += __shfl_xor(s2, o);
        const float rstd = rsqrtf(s2 * (1.0f / DM) + LN_EPS);
        f32x4* orow = (f32x4*)(fout + (size_t)row * DM) + lane; u32x2* brow = (u32x2*)(xb + (size_t)row * DM) + lane;
#pragma unroll
        for (int j = 0; j < 8; ++j) { const f32x4 gg = ((const f32x4*)lg)[lane + 64 * j], bb = ((const f32x4*)lb)[lane + 64 * j];
            const f32x4 y = v[j] * rstd * gg + bb; orow[64 * j] = y; u32x2 o2; o2.x = pk2(y.x, y.y); o2.y = pk2(y.z, y.w); brow[64 * j] = o2; }
    }
}

#define XB_TMO      128
#define XB_XCNT(j)  (256  + 64 * (j))
#define XB_XSUB(j)  (1280 + 64 * (j))
#define XB_XGEN(j)  (2304 + 64 * (j))
#define XB_TOP      3328
#define XB_TOPGEN   3392
#define XCD_BAR_WORDS 3456
#define XB_SPIN_CAP (1u << 18)

__device__ __forceinline__ unsigned xb_ld(unsigned* p)              { return __hip_atomic_load(p, __ATOMIC_RELAXED, __HIP_MEMORY_SCOPE_AGENT); }
__device__ __forceinline__ unsigned xb_add(unsigned* p, unsigned v) { return __hip_atomic_fetch_add(p, v, __ATOMIC_RELAXED, __HIP_MEMORY_SCOPE_AGENT); }
__device__ __forceinline__ unsigned xb_xcc_id() { return (unsigned)__builtin_amdgcn_s_getreg((3 << 11) | 20) & 0xFu; }
#define XB_SPIN(cond, bar) do { unsigned _sp = 0; while (cond) { __builtin_amdgcn_s_sleep(1); \
    if ((++_sp & 255u) == 0u) { if (xb_ld(&(bar)[XB_TMO])) break; if (_sp > XB_SPIN_CAP) { atomicAdd(&(bar)[XB_TMO], 1u); break; } } } } while (0)

struct XcdBarrier {
    unsigned* bar; unsigned x;
    volatile LAS unsigned* st;
};

__device__ __forceinline__ XcdBarrier xcd_barrier_post(unsigned* bar, volatile LAS unsigned* st) {
    XcdBarrier b; b.bar = bar; b.x = xb_xcc_id(); b.st = st;
    if (threadIdx.x == 0) (void)xb_add(&bar[XB_XCNT(b.x)], 1u);
    return b;
}
__device__ __forceinline__ void xcd_barrier_complete(unsigned* bar, unsigned x, unsigned& nloc, unsigned& nx) {
    const unsigned G = gridDim.x * gridDim.y * gridDim.z;
    unsigned sum, cnt, mine, sp = 0u;
    for (;;) {
        sum = 0u; cnt = 0u; mine = 0u;
#pragma unroll
        for (unsigned j = 0; j < 16; ++j) { const unsigned c = xb_ld(&bar[XB_XCNT(j)]); sum += c; cnt += (c > 0u) ? 1u : 0u; mine = (j == x) ? c : mine; }
        if (sum == G) break;
        __builtin_amdgcn_s_sleep(1);
        if ((++sp & 255u) == 0u) { if (xb_ld(&bar[XB_TMO])) break; if (sp > XB_SPIN_CAP) { atomicAdd(&bar[XB_TMO], 1u); break; } }
    }
    nloc = mine > 0u ? mine : 1u; nx = cnt > 0u ? cnt : 1u;
}

__device__ __forceinline__ void xcd_barrier(const XcdBarrier& b) {
    asm volatile("s_waitcnt vmcnt(0)" ::: "memory");
    __syncthreads();
    if (threadIdx.x == 0) {
        unsigned* bar = b.bar;
        __builtin_amdgcn_s_waitcnt(0);
        unsigned nloc = b.st[0], nx = b.st[1];
        if (nloc == 0u) { xcd_barrier_complete(bar, b.x, nloc, nx); b.st[0] = nloc; b.st[1] = nx; }
        const unsigned old = xb_add(&bar[XB_XSUB(b.x)], 1u);
        const unsigned gen = old / nloc;
        if (old + 1u == (gen + 1u) * nloc) {
            __builtin_amdgcn_fence(__ATOMIC_RELEASE, "agent");
            asm volatile("s_waitcnt vmcnt(0)" ::: "memory");
            const unsigned og = xb_add(&bar[XB_TOP], 1u);
            const unsigned tg = og / nx;
            if (og + 1u == (tg + 1u) * nx) xb_add(&bar[XB_TOPGEN], 1u);
            else XB_SPIN(xb_ld(&bar[XB_TOPGEN]) == tg, bar);
            __builtin_amdgcn_fence(__ATOMIC_ACQUIRE, "agent");
            xb_add(&bar[XB_XGEN(b.x)], 1u);
            asm volatile("s_waitcnt vmcnt(0)" ::: "memory");
        } else {
            XB_SPIN(xb_ld(&bar[XB_XGEN(b.x)]) == gen, bar);
            __builtin_amdgcn_fence(__ATOMIC_ACQUIRE, "agent");
            asm volatile("s_waitcnt vmcnt(0)" ::: "memory");
        }
    }
    __syncthreads();
}

constexpr int NPH = 1 + 6 * DEPTH;
__global__ void __launch_bounds__(512, 2) mega(Params p_in) {
    extern __shared__ __attribute__((aligned(16))) unsigned char lds_raw[];
    LAS unsigned char* lds = (LAS unsigned char*)lds_raw;
    cg::grid_group grid = cg::this_grid();
    const int bid = blockIdx.x, G = gridDim.x;
    volatile LAS unsigned* misc = (volatile LAS unsigned*)(lds + LDS_BYTES - 64);
    if (threadIdx.x < 16) misc[threadIdx.x] = 0u;
    __syncthreads();
    const XcdBarrier bar = xcd_barrier_post((unsigned*)(p_in.ws + WS_CTL), misc);
    if (p_in.ph_hi - p_in.ph_lo > 1) grid.sync();
    const Params& p0 = p_in;
    for (int ph = p0.ph_lo; ph < p0.ph_hi; ++ph) {
        Params p = p0; asm volatile("" : "+s"(p.ws));
        bf16_t* xb = (bf16_t*)(p.ws + WS_XB); float* xf = (float*)(p.ws + WS_XF);
        bf16_t* hm = (bf16_t*)(p.ws + WS_HM); bf16_t* VT = (bf16_t*)(p.ws + WS_VT); bf16_t* Y = (bf16_t*)(p.ws + WS_Y);
        if (ph == 0) phase0(p, lds);
        else {
            const int l = (ph - 1) / 6, k = (ph - 1) % 6;
            const bf16_t* win = (const bf16_t*)(p.ws + WS_WIN + l * WIN_L);
            if (k == 0) {
                for (int gi = 0; gi < 4; ++gi) {
                    pg8::Gemm g; bf16_t* O; int ldc, c;
                    if (gi == 0) { g.A = xb; g.Bt = win; g.M = SEQ; g.N = NMAIN; O = hm; ldc = NMAIN; c = bid; }
                    else if (gi == 1) { g.A = win + (size_t)NMAIN * DM; g.Bt = xb; g.M = NVT; g.N = SEQ; O = VT; ldc = LDV; c = G - 1 - bid; }
                    else if (gi == 2) { g.A = (const bf16_t*)(p.ws + WS_MEMB); g.Bt = (const bf16_t*)(p.ws + WS_WMK) + (size_t)l * 512 * DM; g.M = NMEM; g.N = 512; O = (bf16_t*)(p.ws + WS_MK) + l * 512; ldc = 2048;
                        c = (bid >= G - 16 && bid < G - 14) ? bid - (G - 16) : (1 << 24); }
                    else { g.A = (const bf16_t*)(p.ws + WS_WMV) + (size_t)l * 512 * DM; g.Bt = (const bf16_t*)(p.ws + WS_MEMB); g.M = 512; g.N = NMEM; O = (bf16_t*)(p.ws + WS_MVT) + (size_t)l * 512 * NMEM; ldc = NMEM;
                        c = (bid >= G - 14 && bid < G - 12) ? bid - (G - 14) : (1 << 24); }
                    g.K = DM;
                    pg8::StaticOrder S; S.init(g.M, g.N, G, c);
                    pg8::EpiBf16<0> E{O, ldc, nullptr, 0, 0, 1.f};
                    pg8::gemm_phase<pg8::EpiBf16<0>, pg8::StaticOrder, true, true>(lds, g, S, E);
                }
                if (l + 1 < DEPTH) {
                    int wkb = bid, nwb = G;
                    if (G == 256) { nwb = 144; wkb = bid < 64 ? bid : (bid >= 160 && bid < 240 ? bid - 96 : -1); }
                    if (wkb >= 0) { int t2_ = threadIdx.x; asm volatile("" : "+v"(t2_)); convert_layer(p, l + 1, lds, wkb * 8 + (t2_ >> 6), nwb * 8); }
                }
            } else if (k == 1) {
                for (int u = bid; u < 256; u += G) band_pair_unit(lds, p, l, u >> 2, 2 * (u & 3));
                for (int u = bid; u < 256; u += G) { const int head = u & 3, qb = u >> 2;
                    attn_unit<false>(lds, 128 * qb, hm + C_MQ + head * 128, NMAIN, (const bf16_t*)(p.ws + WS_MK) + l * 512 + head * 128, 2048,
                                     (const bf16_t*)(p.ws + WS_MVT) + (size_t)(l * 512 + head * 128) * NMEM, NMEM, hm + C_MZ + head * 128, NMAIN, Y + 1536 + head * 128, DM, nullptr, 0); }
                for (int u = bid; u < 512; u += G) gla_part1(lds, p, l, u >> 2, u & 3);
            } else if (k == 2) gla_scan(p, lds);
            else if (k == 3) {
                int t3_ = threadIdx.x; asm volatile("" : "+v"(t3_)); const int tid3 = t3_, w3 = __builtin_amdgcn_readfirstlane(tid3 >> 6), r3 = tid3 & 15, g3 = (tid3 & 63) >> 4;
                if (G == 256) {
                    Gla2Regs RA, RB; const int u = bid, u2 = bid + 256;
                    gla_part2_load(RA, p, l, u >> 2, u & 3, tid3, w3, r3, g3);
                    gla_part2_load(RB, p, l, u2 >> 2, u2 & 3, tid3, w3, r3, g3);
                    gla_part2(lds, p, l, u >> 2, u & 3, RA, tid3, w3, r3, g3);
                    gla_part2(lds, p, l, u2 >> 2, u2 & 3, RB, tid3, w3, r3, g3);
                } else {
                    for (int u = bid; u < 512; u += G) { Gla2Regs RA; gla_part2_load(RA, p, l, u >> 2, u & 3, tid3, w3, r3, g3); gla_part2(lds, p, l, u >> 2, u & 3, RA, tid3, w3, r3, g3); }
                }
            }
            else if (k == 4) {
                pg8::Gemm g; g.A = Y; g.Bt = (const bf16_t*)(p.ws + WS_WOUT + l * WOUT_L); g.M = SEQ; g.N = DM; g.K = DM;
                pg8::StaticOrder S; S.init(SEQ, DM, G, bid);
                if (G == 256) {
                    pg8::EpiResLn E{l == 0 ? p.x : (const float*)nullptr, l == DEPTH - 1 ? p.out : (float*)nullptr, xb, (bf16_t*)(p.ws + WS_XL), p.ln_g + l * DM, p.ln_b + l * DM, (unsigned long long*)(p.ws + WS_XCH),
                                    (unsigned*)(p.ws + WS_CTL) + CW_CNT + l * 2048, 1.6817928305074292f, LN_EPS};
                    pg8::gemm_phase<pg8::EpiResLn, pg8::StaticOrder, false, true>(lds, g, S, E);
                } else {
                    pg8::EpiResid E{l == 0 ? p.x : xf, xf, DM, 1.6817928305074292f};
                    pg8::gemm_phase<pg8::EpiResid, pg8::StaticOrder, true, true>(lds, g, S, E);
                }
            } else if (G != 256) ln_phase(p, l, xf, l == DEPTH - 1 ? p.out : xf);
        }
        if (ph + 1 < p0.ph_hi && !(G == 256 && ph > 0 && (ph - 1) % 6 == 4)) xcd_barrier(bar);
    }
}

extern "C" void kernel_launch(void* const* d_in, const int* in_sizes, int n_in, void* d_out, int out_size, void* d_ws, size_t ws_size, hipStream_t stream) {
    static int grid = 0;
    if (grid == 0) {
        if (n_in != 11 || ws_size < WS_END) { fprintf(stderr, "kernel_launch: unexpected inputs (n_in %d, ws %zu)\n", n_in, ws_size); grid = -1; return; }
        int dev = 0, cus = 0, per_cu = 0;
        hipGetDevice(&dev); hipDeviceGetAttribute(&cus, hipDeviceAttributeMultiprocessorCount, dev);
        hipFuncSetAttribute((const void*)mega, hipFuncAttributeMaxDynamicSharedMemorySize, LDS_BYTES);
        hipOccupancyMaxActiveBlocksPerMultiprocessor(&per_cu, (const void*)mega, 512, LDS_BYTES);
        if (per_cu < 1) per_cu = 1;
        (void)hipGetLastError();
        grid = cus * per_cu;
    }
    if (grid < 0) return;
    Params p{};
    p.x = (const float*)d_in[0]; p.mem = (const float*)d_in[1]; p.w_in = (const float*)d_in[2]; p.rel = (const float*)d_in[3]; p.gate_w = (const float*)d_in[4];
    p.gate_b = (const float*)d_in[5]; p.norm_g = (const float*)d_in[6]; p.w_mkv = (const float*)d_in[7]; p.w_out = (const float*)d_in[8]; p.ln_g = (const float*)d_in[9]; p.ln_b = (const float*)d_in[10];
    p.out = (float*)d_out; p.ws = (unsigned char*)d_ws;
    if (hipMemsetAsync((char*)d_ws + WS_CTL, 0, CTL_BYTES, stream) != hipSuccess) { fprintf(stderr, "memset failed\n"); return; }
#if defined(MK_MULTI)
    for (int ph = 0; ph < NPH; ++ph) { p.ph_lo = ph; p.ph_hi = ph + 1; hipLaunchKernelGGL(mega, dim3(grid), dim3(512), LDS_BYTES, stream, p); }
#else
    p.ph_lo = 0; p.ph_hi = NPH;
    void* args[] = {&p};
    hipError_t e = hipLaunchCooperativeKernel((const void*)mega, dim3(grid), dim3(512), args, LDS_BYTES, stream);
    if (e != hipSuccess) fprintf(stderr, "cooperative launch failed: %s (grid %d)\n", hipGetErrorString(e), grid);
#endif
}
```

```cpp
#include <hip/hip_runtime.h>
#include <hip/hip_cooperative_groups.h>
#include <cstdio>
#include <cstdint>
namespace cg = cooperative_groups;
namespace pg8 {
#define PG8_LAS __attribute__((address_space(3)))
typedef unsigned short bf16_t;
typedef short bf16x8 __attribute__((ext_vector_type(8)));
typedef float f32x4 __attribute__((ext_vector_type(4)));
typedef unsigned u32x4 __attribute__((ext_vector_type(4)));
constexpr int BM = 256, BK = 64, HALF = 128, HTB = HALF * BK * 2  , STAGE_BYTES = 8 * HTB, NXCD = 8, WGM = 8;

__host__ __device__ __forceinline__ int lds_byte(int r, int c) { const int st = (r >> 4) * 2 + (c >> 5), rr = r & 15, cc = c & 31, ob = rr * 64 + cc * 2; return st * 1024 + (ob ^ (((ob >> 9) & 1) << 5)); }
__host__ __device__ __forceinline__ void stage_rc(int b, int& R, int& C) { const int st = b / 1024, sb = b % 1024, swz = sb ^ (((sb >> 9) & 1) << 5); R = (st >> 1) * 16 + swz / 64; C = (st & 1) * 32 + (swz % 64) / 2; }
__host__ __device__ __forceinline__ int perm32(int rho) { const int n = rho >> 4, i = rho & 15; return 8 * (i >> 2) + 4 * n + (i & 3); }

struct Unit { int pm, pn; };
struct Gemm { const bf16_t* A; const bf16_t* Bt; int M, N, K; };

struct StaticOrder {
    int nM, nN, nwg, G, c;
    __host__ __device__ void init(int M, int N, int G_, int c_) { nM = M / BM; nN = N / BM; nwg = nM * nN; G = G_; c = c_; }
    __host__ __device__ bool next(int i, Unit& u) const {
        const long L = (long)i * G + c; if (L >= nwg) return false;
        int wgid = (int)L; { const int q = nwg / NXCD, r = nwg % NXCD, xcd = wgid % NXCD, off = wgid / NXCD; wgid = (xcd < r ? xcd * (q + 1) : r * (q + 1) + (xcd - r) * q) + off; }
        const int nig = WGM * nN, gid = wgid / nig, fm = gid * WGM, gsz = (nM - fm) < WGM ? (nM - fm) : WGM;
        u.pm = fm + ((wgid % nig) % gsz); u.pn = (wgid % nig) / gsz; return true;
    }
    __device__ __forceinline__ void a_ready(const Unit&) const {}
    __device__ __forceinline__ void done(const Unit&) const {}
};

__device__ __forceinline__ unsigned cvt_pk_bf16(float lo, float hi) { unsigned r; asm volatile("v_cvt_pk_bf16_f32 %0, %1, %2" : "=v"(r) : "v"(lo), "v"(hi)); return r; }
typedef float f32x2 __attribute__((ext_vector_type(2)));
__device__ __forceinline__ f32x2 gelu_pk(f32x2 v) {
    const f32x2 av = __builtin_elementwise_abs(v), d = av * 0.2316418882f + 1.0f;
    f32x2 t; t.x = __builtin_amdgcn_rcpf(d.x); t.y = __builtin_amdgcn_rcpf(d.y);
    f32x2 q = t * 0.5307027145f + (-0.7265760135f); q = q * t + 0.7107068705f; q = q * t + (-0.142248368f); q = q * t + 0.127414796f; q = q * t;
    const f32x2 s = (v * v) * (-0.72134752044f);
    f32x2 e; e.x = __builtin_amdgcn_exp2f(s.x); e.y = __builtin_amdgcn_exp2f(s.y);
    const f32x2 m = v * (q * e), r = v - m;
    f32x2 o; o.x = v.x < 0.f ? m.x : r.x; o.y = v.y < 0.f ? m.y : r.y; return o;
}

template <int ACT  > struct EpiBf16 {
    static constexpr bool PERM = true, AFTER_DRAIN = false; static_assert(ACT == 0 || ACT == 1, "EpiBf16: ACT is 0 (none) or 1 (gelu_pk)");
    bf16_t* O; int ldc; const float* bias; int split_cols; size_t split_stride; float scale0;
    __device__ __forceinline__ void operator()(const f32x4 (&acc)[2][2][4][2], const Unit& u, int wr, int wc, int fr, int fq) const {
        const int row0 = u.pm * BM + wr * 64 + fr; int colt = u.pn * BM; bf16_t* base = O;
        float sc = 1.f; if (split_cols) { const int t = colt / split_cols; base += (size_t)t * split_stride; colt -= t * split_cols; if (t == 0) sc = scale0; }
        const int col0 = colt + wc * 32 + 8 * fq, bcol0 = u.pn * BM + wc * 32 + 8 * fq;
        f32x4 bv[2][2];
#pragma unroll
        for (int bj = 0; bj < 2; ++bj)
#pragma unroll
            for (int n = 0; n < 2; ++n) bv[bj][n] = bias ? *(const f32x4*)(bias + bcol0 + bj * HALF + 4 * n) : (f32x4){0.f, 0.f, 0.f, 0.f};
#pragma unroll
        for (int ai = 0; ai < 2; ++ai)
#pragma unroll
            for (int m = 0; m < 4; ++m) { bf16_t* rowp = base + (size_t)(row0 + ai * HALF + m * 16) * ldc + col0;
#pragma unroll
                for (int bj = 0; bj < 2; ++bj) { f32x4 v0 = acc[ai][bj][m][0] + bv[bj][0], v1 = acc[ai][bj][m][1] + bv[bj][1];
                    if (ACT == 1) { f32x2 a = gelu_pk((f32x2){v0[0], v0[1]}), b = gelu_pk((f32x2){v0[2], v0[3]}), c = gelu_pk((f32x2){v1[0], v1[1]}), d = gelu_pk((f32x2){v1[2], v1[3]});
                        v0 = (f32x4){a.x, a.y, b.x, b.y}; v1 = (f32x4){c.x, c.y, d.x, d.y}; }
                    v0 = v0 * sc; v1 = v1 * sc; u32x4 w; w.x = cvt_pk_bf16(v0[0], v0[1]); w.y = cvt_pk_bf16(v0[2], v0[3]); w.z = cvt_pk_bf16(v1[0], v1[1]); w.w = cvt_pk_bf16(v1[2], v1[3]);
                    *(u32x4*)(rowp + bj * HALF) = w; } }
    }
};
template <class Epi, class Sched, bool ALIGN_EPI = false, bool SP2 = false>
__device__ __forceinline__ void gemm_phase(PG8_LAS unsigned char* lds, const Gemm g, const Sched& S, const Epi& E) {
    int tid_ = threadIdx.x; asm volatile("" : "+v"(tid_)); const int tid = tid_, wid = __builtin_amdgcn_readfirstlane(tid >> 6), lane = tid & 63, wr = wid >> 2, wc = wid & 3, fr = lane & 15, fq = lane >> 4;
    const int K = g.K, nt = K / BK;
    unsigned voffA[2], voffB[2];
#pragma unroll
    for (int i = 0; i < 2; ++i) { int R, C; stage_rc(tid * 16 + i * 8192, R, C); const int Rb = Epi::PERM ? ((R & ~31) + perm32(R & 31)) : R;
        voffA[i] = (unsigned)(R * K + C) * 2u; voffB[i] = (unsigned)(Rb * K + C) * 2u; }
    const size_t kstep = (size_t)(BK * 2);
    const size_t hstep = (size_t)HALF * K * 2;
    const size_t tstep = 2 * hstep;
    const unsigned ldsw = (unsigned)wid * 1024u;
    const int aoff = lds_byte(wr * 64 + fr, fq * 8), boff = lds_byte(wc * 32 + fr, fq * 8);
#define PG8_SA(b, h) (((b) * 2 + (h)) * HTB)
#define PG8_SB(b, h) ((4 + (b) * 2 + (h)) * HTB)
#define PG8_STAGE(bufoff, gbase, voff) do { _Pragma("unroll") for (int _i = 0; _i < 2; ++_i) \
        __builtin_amdgcn_global_load_lds((const unsigned*)((const char*)(gbase) + (voff)[_i]), (PG8_LAS unsigned*)(lds + (bufoff) + ldsw + _i * 8192), 16, 0, 0); } while (0)
#define PG8_LDA(dst, b, h) do { _Pragma("unroll") for (int m = 0; m < 4; ++m) _Pragma("unroll") for (int k = 0; k < 2; ++k) dst[m][k] = *(const PG8_LAS bf16x8*)(lds + PG8_SA(b, h) + aoff + m * 2048 + k * 1024); } while (0)
#define PG8_LDB(dst, b, h) do { _Pragma("unroll") for (int n = 0; n < 2; ++n) _Pragma("unroll") for (int k = 0; k < 2; ++k) dst[n][k] = *(const PG8_LAS bf16x8*)(lds + PG8_SB(b, h) + boff + n * 2048 + k * 1024); } while (0)
#define PG8_MMA(ai, bj, At, Bt) do { __builtin_amdgcn_s_setprio(1); _Pragma("unroll") for (int m = 0; m < 4; ++m) _Pragma("unroll") for (int n = 0; n < 2; ++n) _Pragma("unroll") for (int k = 0; k < 2; ++k) \
        acc[ai][bj][m][n] = __builtin_amdgcn_mfma_f32_16x16x32_bf16(Bt[n][k], At[m][k], acc[ai][bj][m][n], 0, 0, 0); __builtin_amdgcn_s_setprio(0); } while (0)
#define PG8_WAIT_V(n) asm volatile("s_waitcnt vmcnt(" #n ")" ::: "memory")
#define PG8_WAIT_L(n) asm volatile("s_waitcnt lgkmcnt(" #n ")" ::: "memory")
#define PG8_BAR __builtin_amdgcn_s_barrier()
#define PG8_SCHED __builtin_amdgcn_sched_barrier(0)
    Unit cur, nxt; int ui = 0;
    if (!S.next(0, cur)) return;
    f32x4 acc[2][2][4][2];
#pragma unroll
    for (int a = 0; a < 2; ++a)
#pragma unroll
        for (int b = 0; b < 2; ++b)
#pragma unroll
            for (int m = 0; m < 4; ++m)
#pragma unroll
                for (int n = 0; n < 2; ++n) acc[a][b][m][n] = (f32x4){0.f, 0.f, 0.f, 0.f};
    bf16x8 At[4][2], B0[2][2], B1[2][2];
    const char* cA = (const char*)g.A + (size_t)cur.pm * tstep; const char* cB = (const char*)g.Bt + (size_t)cur.pn * tstep;
    S.a_ready(cur);
    if constexpr (SP2) {
        PG8_STAGE(PG8_SB(0, 0), cB, voffB); PG8_STAGE(PG8_SB(0, 1), cB + hstep, voffB); PG8_STAGE(PG8_SA(0, 0), cA, voffA); PG8_STAGE(PG8_SA(0, 1), cA + hstep, voffA);
        if (wr == 1) PG8_BAR;
        PG8_WAIT_V(2); PG8_BAR;
        PG8_STAGE(PG8_SB(1, 0), cB + kstep, voffB); PG8_STAGE(PG8_SA(1, 0), cA + kstep, voffA); PG8_STAGE(PG8_SB(1, 1), cB + hstep + kstep, voffB);
        PG8_WAIT_V(6); PG8_BAR;
    } else {
        PG8_STAGE(PG8_SB(0, 0), cB, voffB); PG8_STAGE(PG8_SA(0, 0), cA, voffA); PG8_STAGE(PG8_SB(0, 1), cB + hstep, voffB); PG8_STAGE(PG8_SA(0, 1), cA + hstep, voffA);
        if (wr == 1) PG8_BAR;
        PG8_WAIT_V(4); PG8_BAR;
        PG8_STAGE(PG8_SB(1, 0), cB + kstep, voffB); PG8_STAGE(PG8_SA(1, 0), cA + kstep, voffA); PG8_STAGE(PG8_SB(1, 1), cB + hstep + kstep, voffB);
        PG8_WAIT_V(6); PG8_BAR;
    }
    for (;;) {
        const bool has_next = S.next(ui + 1, nxt);
        const char* nA = has_next ? (const char*)g.A + (size_t)nxt.pm * tstep : cA; const char* nB = has_next ? (const char*)g.Bt + (size_t)nxt.pn * tstep : cB;
        for (int t = 0; t < nt; t += 2) {
            const bool last = (t == nt - 2);
            const char* a1 = cA + (size_t)(t + 1) * kstep;
            const char* a2 = last ? nA : cA + (size_t)(t + 2) * kstep; const char* b2 = last ? nB : cB + (size_t)(t + 2) * kstep;
            const char* a3 = a2 + kstep; const char* b3 = b2 + kstep;
            if (last && has_next) S.a_ready(nxt);
            if constexpr (SP2) {
            PG8_LDB(B0, 0, 0); PG8_LDB(B1, 0, 1); PG8_SCHED; PG8_LDA(At, 0, 0); PG8_STAGE(PG8_SA(1, 1), a1 + hstep, voffA);
            PG8_WAIT_V(8); PG8_WAIT_L(0); PG8_BAR; PG8_MMA(0, 0, At, B0); PG8_MMA(0, 1, At, B1); PG8_BAR; PG8_SCHED;
            PG8_LDA(At, 0, 1); PG8_STAGE(PG8_SB(0, 0), b2, voffB); PG8_STAGE(PG8_SB(0, 1), b2 + hstep, voffB); PG8_STAGE(PG8_SA(0, 0), a2, voffA);
            PG8_WAIT_V(8); PG8_WAIT_L(0); PG8_BAR; PG8_MMA(1, 0, At, B0); PG8_MMA(1, 1, At, B1); PG8_BAR; PG8_SCHED;
            PG8_LDB(B0, 1, 0); PG8_LDB(B1, 1, 1); PG8_SCHED; PG8_LDA(At, 1, 0); PG8_STAGE(PG8_SA(0, 1), a2 + hstep, voffA);
            PG8_WAIT_V(8); PG8_WAIT_L(0); PG8_BAR; PG8_MMA(0, 0, At, B0); PG8_MMA(0, 1, At, B1); PG8_BAR; PG8_SCHED;
            PG8_LDA(At, 1, 1); PG8_STAGE(PG8_SB(1, 0), b3, voffB); PG8_STAGE(PG8_SB(1, 1), b3 + hstep, voffB); PG8_STAGE(PG8_SA(1, 0), a3, voffA);
            PG8_WAIT_V(8); PG8_WAIT_L(0); PG8_BAR; PG8_MMA(1, 0, At, B0); PG8_MMA(1, 1, At, B1); PG8_BAR; PG8_SCHED;
            } else {
            PG8_LDB(B0, 0, 0); PG8_SCHED; PG8_LDA(At, 0, 0); PG8_STAGE(PG8_SA(1, 1), a1 + hstep, voffA);
            PG8_WAIT_L(8); PG8_BAR; PG8_WAIT_L(0); PG8_MMA(0, 0, At, B0); PG8_BAR; PG8_SCHED;
            PG8_LDB(B1, 0, 1); PG8_STAGE(PG8_SB(0, 0), b2, voffB);
            PG8_BAR; PG8_WAIT_L(0); PG8_MMA(0, 1, At, B1); PG8_BAR;
            PG8_LDA(At, 0, 1); PG8_STAGE(PG8_SA(0, 0), a2, voffA);
            PG8_BAR; PG8_WAIT_L(0); PG8_MMA(1, 0, At, B0); PG8_BAR; PG8_SCHED;
            PG8_STAGE(PG8_SB(0, 1), b2 + hstep, voffB);
            PG8_WAIT_V(6); PG8_BAR; PG8_MMA(1, 1, At, B1); PG8_BAR;
            PG8_LDB(B0, 1, 0); PG8_SCHED; PG8_LDA(At, 1, 0); PG8_STAGE(PG8_SA(0, 1), a2 + hstep, voffA);
            PG8_WAIT_L(8); PG8_BAR; PG8_WAIT_L(0); PG8_MMA(0, 0, At, B0); PG8_BAR; PG8_SCHED;
            PG8_LDB(B1, 1, 1); PG8_STAGE(PG8_SB(1, 0), b3, voffB);
            PG8_BAR; PG8_WAIT_L(0); PG8_MMA(0, 1, At, B1); PG8_BAR;
            PG8_LDA(At, 1, 1); PG8_STAGE(PG8_SA(1, 0), a3, voffA);
            PG8_BAR; PG8_WAIT_L(0); PG8_MMA(1, 0, At, B0); PG8_BAR; PG8_SCHED;
            PG8_STAGE(PG8_SB(1, 1), b3 + hstep, voffB);
            PG8_WAIT_V(6); PG8_BAR; PG8_MMA(1, 1, At, B1); PG8_BAR;
            }
        }
        if constexpr (ALIGN_EPI) { if (wr == 0) PG8_BAR; }
        if constexpr (!Epi::AFTER_DRAIN) { E(acc, cur, wr, wc, fr, fq); S.done(cur); }
        if (!has_next) break;
#pragma unroll
        for (int a = 0; a < 2; ++a)
#pragma unroll
            for (int b = 0; b < 2; ++b)
#pragma unroll
                for (int m = 0; m < 4; ++m)
#pragma unroll
                    for (int n = 0; n < 2; ++n) acc[a][b][m][n] = (f32x4){0.f, 0.f, 0.f, 0.f};
        cur = nxt; cA = nA; cB = nB; ++ui;
        if constexpr (ALIGN_EPI) { if (wr == 1) PG8_BAR; }
    }
    PG8_WAIT_V(0);
    if constexpr (!ALIGN_EPI) { if (wr == 0) PG8_BAR; }
    PG8_BAR;
    if constexpr (Epi::AFTER_DRAIN) { E.fused(acc, cur, wr, wc, fr, fq, lds, wid, lane); S.done(cur); }
#undef PG8_SA
#undef PG8_SB
#undef PG8_STAGE
#undef PG8_LDA
#undef PG8_LDB
#undef PG8_MMA
#undef PG8_WAIT_V
#undef PG8_WAIT_L
#undef PG8_BAR
#undef PG8_SCHED
}
}

namespace pg8 {
struct EpiResid {
    static constexpr bool PERM = false, AFTER_DRAIN = false;
    const float* base; float* out; int ldc; float alpha;
    __device__ __forceinline__ void operator()(const f32x4 (&acc)[2][2][4][2], const Unit& u, int wr, int wc, int fr, int fq) const {
        const int col0 = u.pn * BM + wc * 32 + 4 * fq;
#pragma unroll
        for (int ai = 0; ai < 2; ++ai)
#pragma unroll
            for (int m = 0; m < 4; ++m) { const int r = ai * HALF + wr * 64 + m * 16 + fr; const size_t off = (size_t)(u.pm * BM + r) * ldc + col0;
#pragma unroll
                for (int bj = 0; bj < 2; ++bj)
#pragma unroll
                    for (int n = 0; n < 2; ++n) { const f32x4 bs = *(const f32x4*)(base + off + bj * HALF + n * 16);
                        const f32x4 o = bs * alpha + acc[ai][bj][m][n]; *(f32x4*)(out + off + bj * HALF + n * 16) = o; }
                if (m & 1) asm volatile("" ::: "memory"); }
    }
};

struct EpiResLn {
    static constexpr bool PERM = false, AFTER_DRAIN = true;
    const float* base; float* out; bf16_t* xn; bf16_t* xl; const float* lg; const float* lb; unsigned long long* xbuf; unsigned* cnt; float alpha, eps;
    __device__ __forceinline__ void fused(f32x4 (&acc)[2][2][4][2], const Unit& u, int wr, int wc, int fr, int fq, PG8_LAS unsigned char* lds, int wid, int lane) const {
        typedef float f32x2v __attribute__((ext_vector_type(2))); typedef unsigned u32x2v __attribute__((ext_vector_type(2)));
        PG8_LAS f32x2v* P = (PG8_LAS f32x2v*)lds;
        PG8_LAS f32x2v* S = (PG8_LAS f32x2v*)(lds + 8192);
        const int col0 = u.pn * BM + wc * 32 + 4 * fq;
        const int tid_ = wid * 64 + lane; bf16_t* xl_t = xl + (size_t)(u.pm * 8 + u.pn) * 65536;
#pragma unroll
        for (int ai = 0; ai < 2; ++ai)
#pragma unroll
            for (int m = 0; m < 4; ++m) { const size_t off = (size_t)(u.pm * BM + ai * HALF + wr * 64 + m * 16 + fr) * 2048 + col0;
#pragma unroll
                for (int bj = 0; bj < 2; ++bj) { u32x4 lo16 = (u32x4){0u, 0u, 0u, 0u};
                    if (!base) lo16 = *(const u32x4*)(xl_t + ((size_t)(((ai * 4 + m) * 2 + bj) * 512 + tid_) * 8));
#pragma unroll
                    for (int n = 0; n < 2; ++n) { f32x4 bs;
                        if (base) bs = *(const f32x4*)(base + off + bj * HALF + n * 16);
                        else { const u32x2v h = *(const u32x2v*)(xn + off + bj * HALF + n * 16); const unsigned qx = n ? lo16.z : lo16.x, qy = n ? lo16.w : lo16.y;
                            bs[0] = __uint_as_float(h.x << 16) + __uint_as_float(qx << 16); bs[1] = __uint_as_float(h.x & 0xffff0000u) + __uint_as_float(qx & 0xffff0000u);
                            bs[2] = __uint_as_float(h.y << 16) + __uint_as_float(qy << 16); bs[3] = __uint_as_float(h.y & 0xffff0000u) + __uint_as_float(qy & 0xffff0000u); }
                        acc[ai][bj][m][n] = bs * alpha + acc[ai][bj][m][n]; } }
                asm volatile("" : "+v"(acc[ai][0][m][0]), "+v"(acc[ai][0][m][1]), "+v"(acc[ai][1][m][0]), "+v"(acc[ai][1][m][1]));
                if (m == 3) asm volatile("" ::: "memory"); }
#pragma unroll
        for (int ai = 0; ai < 2; ++ai)
#pragma unroll
            for (int m = 0; m < 4; ++m) {
                float s = 0.f;
#pragma unroll
                for (int bj = 0; bj < 2; ++bj)
#pragma unroll
                    for (int n = 0; n < 2; ++n) { const f32x4 x = acc[ai][bj][m][n]; s += (x[0] + x[1]) + (x[2] + x[3]); }
                s += __shfl_xor(s, 16); s += __shfl_xor(s, 32);
                const float mw = s * (1.0f / 64.0f); float q = 0.f;
#pragma unroll
                for (int bj = 0; bj < 2; ++bj)
#pragma unroll
                    for (int n = 0; n < 2; ++n) { const f32x4 d = acc[ai][bj][m][n] - mw; q += (d[0] * d[0] + d[1] * d[1]) + (d[2] * d[2] + d[3] * d[3]); }
                q += __shfl_xor(q, 16); q += __shfl_xor(q, 32);
                if (fq == 0) P[(ai * HALF + wr * 64 + m * 16 + fr) * 4 + wc] = (f32x2v){mw, q};
            }
        asm volatile("s_waitcnt lgkmcnt(0)" ::: "memory"); __builtin_amdgcn_s_barrier(); asm volatile("" ::: "memory");
        const int row = wid * 32 + (lane & 31);
        if (lane < 32) {
            const f32x2v a = P[row * 4 + 0], b = P[row * 4 + 1], c = P[row * 4 + 2], d = P[row * 4 + 3];
            const float mt = (a.x + b.x + c.x + d.x) * 0.25f;
            const float da = a.x - mt, db = b.x - mt, dc = c.x - mt, dd = d.x - mt;
            const float m2 = (a.y + b.y) + (c.y + d.y) + 64.0f * ((da * da + db * db) + (dc * dc + dd * dd));
            unsigned long long* slot = xbuf + ((size_t)(u.pm * BM + row) * 8 + u.pn);
            __hip_atomic_store(slot, ((unsigned long long)__float_as_uint(m2) << 32) | __float_as_uint(mt), __ATOMIC_RELAXED, __HIP_MEMORY_SCOPE_AGENT);
        }
        asm volatile("s_waitcnt vmcnt(0)" ::: "memory");
        if (lane == 0) __hip_atomic_fetch_add(cnt + 64 * u.pm, 1u, __ATOMIC_RELAXED, __HIP_MEMORY_SCOPE_AGENT);
        if (wid == 0) {
            unsigned sp = 0;
            while ((unsigned)__builtin_amdgcn_readfirstlane(__hip_atomic_load(cnt + 64 * u.pm, __ATOMIC_RELAXED, __HIP_MEMORY_SCOPE_AGENT)) < 64u) { __builtin_amdgcn_s_sleep(2); if (++sp > (1u << 22)) break; }
            __builtin_amdgcn_fence(__ATOMIC_ACQUIRE, "agent");
        }
        asm volatile("s_waitcnt vmcnt(0) lgkmcnt(0)" ::: "memory"); __builtin_amdgcn_s_barrier(); asm volatile("" ::: "memory");
        if (lane < 32) {
            const unsigned long long* slot = xbuf + (size_t)(u.pm * BM + row) * 8; float mt[8], m2[8]; float ms = 0.f;
#pragma unroll
            for (int t = 0; t < 8; ++t) { const unsigned long long w = __hip_atomic_load(slot + t, __ATOMIC_RELAXED, __HIP_MEMORY_SCOPE_AGENT); mt[t] = __uint_as_float((unsigned)w); m2[t] = __uint_as_float((unsigned)(w >> 32)); ms += mt[t]; }
            const float mean = ms * 0.125f; float q = 0.f;
#pragma unroll
            for (int t = 0; t < 8; ++t) { const float dm = mt[t] - mean; q += m2[t] + 256.0f * dm * dm; }
            S[row] = (f32x2v){mean, 1.0f / sqrtf(q * (1.0f / 2048.0f) + eps)};
        }
        asm volatile("s_waitcnt lgkmcnt(0)" ::: "memory"); __builtin_amdgcn_s_barrier(); asm volatile("" ::: "memory");
#pragma unroll
        for (int bj = 0; bj < 2; ++bj) { f32x4 gg[2], bb[2];
#pragma unroll
            for (int n = 0; n < 2; ++n) { gg[n] = *(const f32x4*)(lg + col0 + bj * HALF + n * 16); bb[n] = *(const f32x4*)(lb + col0 + bj * HALF + n * 16); }
#pragma unroll
            for (int ai = 0; ai < 2; ++ai)
#pragma unroll
                for (int m = 0; m < 4; ++m) { const int r = ai * HALF + wr * 64 + m * 16 + fr; const f32x2v sr = S[r]; u32x4 lo16;
#pragma unroll
                    for (int n = 0; n < 2; ++n) { const size_t off = (size_t)(u.pm * BM + r) * 2048 + col0 + bj * HALF + n * 16;
                        const f32x4 y = (acc[ai][bj][m][n] - sr.x) * sr.y * gg[n] + bb[n];
                        if (out) *(f32x4*)(out + off) = y;
                        else { u32x2v w; w.x = cvt_pk_bf16(y[0], y[1]); w.y = cvt_pk_bf16(y[2], y[3]); *(u32x2v*)(xn + off) = w;
                            const unsigned q0 = cvt_pk_bf16(y[0] - __uint_as_float(w.x << 16), y[1] - __uint_as_float(w.x & 0xffff0000u)), q1 = cvt_pk_bf16(y[2] - __uint_as_float(w.y << 16), y[3] - __uint_as_float(w.y & 0xffff0000u));
                            if (n == 0) { lo16.x = q0; lo16.y = q1; } else { lo16.z = q0; lo16.w = q1; } } }
                    if (!out) *(u32x4*)(xl_t + ((size_t)(((ai * 4 + m) * 2 + bj) * 512 + tid_) * 8)) = lo16; } }
    }
};
}

#define LAS __attribute__((address_space(3)))
#define GAS __attribute__((address_space(1)))
typedef unsigned short bf16_t;
typedef short bf16x8 __attribute__((ext_vector_type(8)));
typedef short bf16x4 __attribute__((ext_vector_type(4)));
typedef float f32x4 __attribute__((ext_vector_type(4)));
typedef unsigned u32x4 __attribute__((ext_vector_type(4)));
typedef unsigned u32x2 __attribute__((ext_vector_type(2)));

constexpr int SEQ = 8192, DM = 2048, DEPTH = 4, INW = 6672, NMEM = 256;
constexpr int NMAIN = 5376, NVT = 1536, NWT = NMAIN + NVT;
constexpr int C_AQ = 0, C_AK = 1024, C_AZ = 2048, C_BQ = 3072, C_BK = 3328, C_BZ = 3584, C_MQ = 4096, C_MZ = 4608, C_LR = 5120;
constexpr int NCH = SEQ / 64;
constexpr float LN_EPS = 1e-5f, RMS_EPS = 1e-6f;
constexpr float LOG2E = 1.4426950408889634f;
constexpr float ATT_SC = 0.08838834764831845f * LOG2E;
constexpr int LDS_BYTES = 147456;

constexpr size_t MiB = 1u << 20;
constexpr size_t WS_WIN = 0, WIN_L = (size_t)NWT * DM * 2;
constexpr size_t WS_WOUT = 112 * MiB, WOUT_L = (size_t)DM * DM * 2;
constexpr size_t WS_WMK = 144 * MiB, WS_WMV = 152 * MiB;
constexpr size_t WS_MEMB = 160 * MiB, WS_MK = 161 * MiB, WS_MVT = 162 * MiB;
constexpr size_t WS_XB = 164 * MiB, WS_XF = 196 * MiB, WS_HM = 260 * MiB, WS_Y = 368 * MiB;
constexpr int LDV = SEQ + 64;
constexpr size_t WS_U = 400 * MiB, WS_SP = 416 * MiB, WS_DCY = 424 * MiB, WS_CTL = 426 * MiB, CTL_BYTES = 65536, WS_XCH = 427 * MiB, WS_VT = 428 * MiB, WS_BG = 454 * MiB, WS_XL = 462 * MiB, WS_END = 494 * MiB;
constexpr int CW_CNT = 4096;
static_assert(WS_WIN + 4 * WIN_L <= WS_WOUT, "ws map");
static_assert(WS_HM + (size_t)SEQ * NMAIN * 2 <= WS_Y, "ws map");

struct Params {
    const float *x, *mem, *w_in, *rel, *gate_w, *gate_b, *norm_g, *w_mkv, *w_out, *ln_g, *ln_b;
    float* out; unsigned char* ws; int ph_lo, ph_hi;
};

typedef float f32x2_t __attribute__((ext_vector_type(2))); typedef __bf16 bf16x2_t __attribute__((ext_vector_type(2)));
__device__ __forceinline__ unsigned pk2(float lo, float hi) { const f32x2_t v = {lo, hi}; const bf16x2_t b = __builtin_convertvector(v, bf16x2_t); return __builtin_bit_cast(unsigned, b); }
__device__ __forceinline__ float bflo(unsigned w) { return __uint_as_float(w << 16); }
__device__ __forceinline__ float bfhi(unsigned w) { return __uint_as_float(w & 0xffff0000u); }
__device__ __forceinline__ float silu_f(float z) { return z / (1.0f + __expf(-z)); }
#define MFMA16(a, b, c) __builtin_amdgcn_mfma_f32_16x16x32_bf16((a), (b), (c), 0, 0, 0)

struct ConvItem { const GAS float* src; GAS bf16_t* dst; int ldw; bool ok; };
__device__ __forceinline__ void conv_load(const ConvItem& d, f32x4 (&v)[8]) {
#pragma unroll
    for (int i = 0; i < 8; ++i) v[i] = d.ok ? *(const GAS f32x4*)(d.src + (size_t)(8 * i) * d.ldw) : (f32x4){0.f, 0.f, 0.f, 0.f};
}
__device__ __forceinline__ void conv_store(const ConvItem& d, const f32x4 (&v)[8], LAS float* scr, int lane) {
    const int n4 = 4 * (lane & 7), kr = lane >> 3;
#pragma unroll
    for (int i = 0; i < 8; ++i) { LAS float* q = scr + (8 * i + kr) * 33 + n4; q[0] = v[i].x; q[1] = v[i].y; q[2] = v[i].z; q[3] = v[i].w; }
    asm volatile("s_waitcnt lgkmcnt(0)" ::: "memory");
    const int c = lane & 7;
#pragma unroll
    for (int j = 0; j < 4; ++j) { const int n = (lane >> 3) + 8 * j; const LAS float* s = scr + (8 * c) * 33 + n;
        u32x4 o; o.x = pk2(s[0 * 33], s[1 * 33]); o.y = pk2(s[2 * 33], s[3 * 33]); o.z = pk2(s[4 * 33], s[5 * 33]); o.w = pk2(s[6 * 33], s[7 * 33]);
        *(GAS u32x4*)(d.dst + (size_t)n * DM + 8 * c) = o; }
    asm volatile("s_waitcnt lgkmcnt(0)" ::: "memory");
}
__device__ __forceinline__ void in_seg(int drow, int& src_col, int& nvalid) {
    nvalid = 32;
    if (drow < 2048) src_col = drow;
    else if (drow < 3072) src_col = 3072 + (drow - 2048);
    else if (drow < 3328) src_col = 4096 + (drow - 3072);
    else if (drow < 3584) src_col = 4352 + (drow - 3328);
    else if (drow < 4096) src_col = 5120 + (drow - 3584);
    else if (drow < 4608) src_col = 5648 + (drow - 4096);
    else if (drow < 5120) src_col = 6160 + (drow - 4608);
    else if (drow < 5376) { src_col = 5632; nvalid = (drow == 5120) ? 16 : 0; }
    else if (drow < 6400) src_col = 2048 + (drow - 5376);
    else src_col = 4608 + (drow - 6400);
}
__device__ __forceinline__ ConvItem conv_decode(const Params& p, int l, int it, int lane) {
    constexpr int I_IN = 32 * (NWT / 32), I_OUT = 32 * (DM / 32);
    const int n4 = 4 * (lane & 7), kr = lane >> 3;
    ConvItem d; int r = it;
    if (r < I_IN) { const int g_ = r >> 5, nb = 8 * (g_ % 27) + (r & 7), k0 = 64 * (4 * (g_ / 27) + ((r >> 3) & 3)); int sc, nv; in_seg(32 * nb, sc, nv);
        d.ldw = INW; d.ok = n4 < nv; d.src = (const GAS float*)p.w_in + (size_t)l * DM * INW + (size_t)(k0 + kr) * INW + sc + n4;
        d.dst = (GAS bf16_t*)(p.ws + WS_WIN + l * WIN_L) + (size_t)(32 * nb) * DM + k0; return d; }
    r -= I_IN;
    if (r < I_OUT) { const int g_ = r >> 5, nb = 8 * (g_ % 8) + (r & 7), k0 = 64 * (4 * (g_ / 8) + ((r >> 3) & 3));
        d.ldw = DM; d.ok = true; d.src = (const GAS float*)p.w_out + (size_t)l * DM * DM + (size_t)(k0 + kr) * DM + 32 * nb + n4;
        d.dst = (GAS bf16_t*)(p.ws + WS_WOUT + l * WOUT_L) + (size_t)(32 * nb) * DM + k0; return d; }
    r -= I_OUT;
    { const int g_ = r >> 5, nb = 8 * (g_ % 4) + (r & 7), k0 = 64 * (4 * (g_ / 4) + ((r >> 3) & 3));
        d.ldw = 1024; d.ok = true; d.src = (const GAS float*)p.w_mkv + (size_t)l * DM * 1024 + (size_t)(k0 + kr) * 1024 + 32 * nb + n4;
        d.dst = (GAS bf16_t*)(p.ws + (nb < 16 ? WS_WMK : WS_WMV)) + (size_t)(l * 512 + 32 * (nb & 15)) * DM + k0; return d; }
}
__device__ __forceinline__ void convert_layer(const Params& p, int l, LAS unsigned char* lds, int wk, int nwk) {
    int tid_ = threadIdx.x; asm volatile("" : "+v"(tid_)); const int tid = tid_, lane = tid & 63, wave = tid >> 6;
    LAS float* scr = (LAS float*)(lds + wave * 8704);
    constexpr int I_L = 32 * (NWT / 32) + 32 * (DM / 32) + 32 * 32;
    if (wk >= I_L) return;
    ConvItem cur = conv_decode(p, l, wk, lane); f32x4 v[8]; conv_load(cur, v);
    for (int it = wk; it < I_L; it += nwk) {
        const int nx = it + nwk; ConvItem nxt = cur; f32x4 v2[8];
        if (nx < I_L) { nxt = conv_decode(p, l, nx, lane); conv_load(nxt, v2); }
        conv_store(cur, v, scr, lane);
        if (nx < I_L) { cur = nxt;
#pragma unroll
            for (int i = 0; i < 8; ++i) v[i] = v2[i]; }
    }
}
__device__ __forceinline__ void phase0(const Params& p, LAS unsigned char* lds) {
    int tid_ = threadIdx.x; asm volatile("" : "+v"(tid_)); const int tid = tid_, wave = tid >> 6;
    convert_layer(p, 0, lds, blockIdx.x * 8 + wave, gridDim.x * 8);
    const size_t gt = (size_t)blockIdx.x * 512 + tid, NT = (size_t)gridDim.x * 512;
    GAS bf16_t* xb = (GAS bf16_t*)(p.ws + WS_XB); const GAS f32x4* xs = (const GAS f32x4*)p.x;
    for (size_t i = gt; i < (size_t)SEQ * DM / 8; i += NT) { const f32x4 a = xs[2 * i], b = xs[2 * i + 1];
        u32x4 o; o.x = pk2(a.x, a.y); o.y = pk2(a.z, a.w); o.z = pk2(b.x, b.y); o.w = pk2(b.z, b.w); ((GAS u32x4*)xb)[i] = o; }
    GAS bf16_t* mb = (GAS bf16_t*)(p.ws + WS_MEMB); const GAS f32x4* ms = (const GAS f32x4*)p.mem;
    for (size_t i = gt; i < (size_t)NMEM * DM / 8; i += NT) { const f32x4 a = ms[2 * i], b = ms[2 * i + 1];
        u32x4 o; o.x = pk2(a.x, a.y); o.y = pk2(a.z, a.w); o.z = pk2(b.x, b.y); o.w = pk2(b.z, b.w); ((GAS u32x4*)mb)[i] = o; }
}

constexpr int A_KS = 0, A_KSZ = 64 * 272, A_VS = 2 * A_KSZ, A_VSZ = 128 * 144, A_BT = A_VS + 2 * A_VSZ;
template <bool BAND>
__device__ __forceinline__ void attn_step(LAS unsigned char* lds, int buf, int t, int cw, int w, int r16, int g, const bf16x8 (&qf)[4], f32x4 (&o)[8], float& m, float& l) {
    const LAS float* btab = (const LAS float*)(lds + A_BT);
    const LAS unsigned char* kb_ = lds + A_KS + buf * A_KSZ + r16 * 272 + g * 16;
    f32x4 s[4];
#pragma unroll
    for (int kb = 0; kb < 4; ++kb) { s[kb] = (f32x4){0.f, 0.f, 0.f, 0.f}; bf16x8 kfr[4];
#pragma unroll
        for (int ks = 0; ks < 4; ++ks) kfr[ks] = *(const LAS bf16x8*)(kb_ + kb * 16 * 272 + ks * 64);
#pragma unroll
        for (int ks = 0; ks < 4; ++ks) s[kb] = MFMA16(kfr[ks], qf[ks], s[kb]); }
    if (BAND) {
        const int delta = cw + 8 - t;
        if (delta >= 3) { const float bc = btab[256];
#pragma unroll
            for (int kb = 0; kb < 4; ++kb) s[kb] = s[kb] * ATT_SC + bc;
        } else { const int qi = 16 * (w & 3) + r16;
#pragma unroll
            for (int kb = 0; kb < 4; ++kb)
#pragma unroll
                for (int r = 0; r < 4; ++r) { int dist = 64 * delta + qi - (16 * kb + 4 * g + r); dist = dist > 128 ? 128 : (dist < -128 ? -128 : dist);
                    s[kb][r] = s[kb][r] * ATT_SC + btab[dist + 128]; }
        }
    } else {
#pragma unroll
        for (int kb = 0; kb < 4; ++kb) s[kb] = s[kb] * ATT_SC;
    }
    float mt = fmaxf(fmaxf(s[0][0], s[0][1]), fmaxf(s[0][2], s[0][3]));
#pragma unroll
    for (int kb = 1; kb < 4; ++kb) mt = fmaxf(mt, fmaxf(fmaxf(s[kb][0], s[kb][1]), fmaxf(s[kb][2], s[kb][3])));
    mt = fmaxf(mt, __shfl_xor(mt, 16)); mt = fmaxf(mt, __shfl_xor(mt, 32));
    const float mn = fmaxf(m, mt), alpha = __builtin_amdgcn_exp2f(m - mn); m = mn;
    float rs = 0.f;
#pragma unroll
    for (int kb = 0; kb < 4; ++kb)
#pragma unroll
        for (int r = 0; r < 4; ++r) { const float pv = __builtin_amdgcn_exp2f(s[kb][r] - mn); s[kb][r] = pv; rs += pv; }
    l = l * alpha + rs;
    if (__any(alpha != 1.0f)) {
#pragma unroll
        for (int i = 0; i < 8; ++i) o[i] = o[i] * alpha; }
    bf16x8 pb[2];
#pragma unroll
    for (int s2 = 0; s2 < 2; ++s2) { u32x4 pw; pw.x = pk2(s[2 * s2][0], s[2 * s2][1]); pw.y = pk2(s[2 * s2][2], s[2 * s2][3]);
        pw.z = pk2(s[2 * s2 + 1][0], s[2 * s2 + 1][1]); pw.w = pk2(s[2 * s2 + 1][2], s[2 * s2 + 1][3]); pb[s2] = __builtin_bit_cast(bf16x8, pw); }
    int voff_ = 0; asm volatile("" : "+v"(voff_), "+v"(pb[1]));
    const LAS unsigned char* vb_ = lds + A_VS + buf * A_VSZ + r16 * 144 + g * 8 + voff_;
    u32x2 vfr[2][4];
#pragma unroll
    for (int q = 0; q < 4; ++q) vfr[0][q] = *(const LAS u32x2*)(vb_ + (q >> 1) * 64 + (q & 1) * 32);
#pragma unroll
    for (int dvb = 0; dvb < 8; ++dvb) {
        if (dvb < 7) {
#pragma unroll
            for (int q = 0; q < 4; ++q) vfr[(dvb + 1) & 1][q] = *(const LAS u32x2*)(vb_ + (dvb + 1) * 16 * 144 + (q >> 1) * 64 + (q & 1) * 32); }
#pragma unroll
        for (int s2 = 0; s2 < 2; ++s2) { const u32x2 lo = vfr[dvb & 1][2 * s2], hi = vfr[dvb & 1][2 * s2 + 1];
            const u32x4 av = (u32x4){lo.x, lo.y, hi.x, hi.y}; o[dvb] = MFMA16(__builtin_bit_cast(bf16x8, av), pb[s2], o[dvb]); } }
}
template <bool BAND>
__device__ __forceinline__ void attn_unit(LAS unsigned char* lds, int q_row0, const bf16_t* Qh, int ldq, const bf16_t* Kh, int ldk, const bf16_t* Vth, int ldvt,
                                          const bf16_t* Zh, int ldz, bf16_t* Yh, int ldy, const float* bias_tab, int j2) {
    int tid_ = threadIdx.x; asm volatile("" : "+v"(tid_)); const int tid = tid_, lane = tid & 63, w = __builtin_amdgcn_readfirstlane(tid >> 6), r16 = lane & 15, g = lane >> 4;
    LAS float* btab = (LAS float*)(lds + A_BT);
    if (BAND) { for (int i = tid; i < 257; i += 512) btab[i] = ((const GAS float*)bias_tab)[i] * LOG2E; }
    const GAS bf16_t* qp = (const GAS bf16_t*)Qh + (size_t)(q_row0 + 16 * w + r16) * ldq + 8 * g;
    bf16x8 qf[4];
#pragma unroll
    for (int ks = 0; ks < 4; ++ks) qf[ks] = *(const GAS bf16x8*)(qp + 32 * ks);
    f32x4 o[8];
#pragma unroll
    for (int i = 0; i < 8; ++i) o[i] = (f32x4){0.f, 0.f, 0.f, 0.f};
    float m = -1e30f, l = 0.f;
    const int cw = BAND ? (w >> 2) : 0;
    const int nt = BAND ? 10 : 4;
    int t0 = 0; if (BAND) { t0 = 8 - 2 * j2; if (t0 < 0) t0 = 0; }
    u32x4 kA[2], vA[2], kB[2], vB[2];
#define A_GLOAD(kr, vr, t) do { const int key0_ = BAND ? 64 * (2 * j2 - 8 + (t)) : 64 * (t); \
        _Pragma("unroll") for (int i_ = 0; i_ < 2; ++i_) { const int id_ = tid + 512 * i_; \
            kr[i_] = *(const GAS u32x4*)((const GAS bf16_t*)Kh + (size_t)(key0_ + (id_ >> 4)) * ldk + (id_ & 15) * 8); \
            vr[i_] = *(const GAS u32x4*)((const GAS bf16_t*)Vth + (size_t)(id_ >> 3) * ldvt + key0_ + (id_ & 7) * 8); } } while (0)
#define A_LSTORE(kr, vr, buf) do { _Pragma("unroll") for (int i_ = 0; i_ < 2; ++i_) { const int id_ = tid + 512 * i_; \
            *(LAS u32x4*)(lds + A_KS + (buf) * A_KSZ + (id_ >> 4) * 272 + (id_ & 15) * 16) = kr[i_]; \
            *(LAS u32x4*)(lds + A_VS + (buf) * A_VSZ + (id_ >> 3) * 144 + (id_ & 7) * 16) = vr[i_]; } } while (0)
    A_GLOAD(kA, vA, t0); A_GLOAD(kB, vB, t0 + 1); A_LSTORE(kA, vA, 0); __syncthreads();
    for (int t = t0; t < nt; t += 2) {
        if (t + 2 < nt) A_GLOAD(kA, vA, t + 2);
        if (!BAND || (t >= cw && t <= cw + 8)) attn_step<BAND>(lds, 0, t, cw, w, r16, g, qf, o, m, l);
        A_LSTORE(kB, vB, 1);
        __syncthreads();
        if (t + 3 < nt) A_GLOAD(kB, vB, t + 3);
        if (!BAND || (t + 1 >= cw && t + 1 <= cw + 8)) attn_step<BAND>(lds, 1, t + 1, cw, w, r16, g, qf, o, m, l);
        if (t + 2 < nt) A_LSTORE(kA, vA, 0);
        __syncthreads();
    }
#undef A_GLOAD
#undef A_LSTORE
    l += __shfl_xor(l, 16); l += __shfl_xor(l, 32);
    const float inv = 1.0f / l;
    const size_t row = (size_t)(q_row0 + 16 * w + r16);
#pragma unroll
    for (int dvb = 0; dvb < 8; ++dvb) { const int col = 16 * dvb + 4 * g; const u32x2 z = *(const GAS u32x2*)((const GAS bf16_t*)Zh + row * ldz + col);
        const float y0 = o[dvb][0] * inv * silu_f(bflo(z.x)), y1 = o[dvb][1] * inv * silu_f(bfhi(z.x)), y2 = o[dvb][2] * inv * silu_f(bflo(z.y)), y3 = o[dvb][3] * inv * silu_f(bfhi(z.y));
        u32x2 yo; yo.x = pk2(y0, y1); yo.y = pk2(y2, y3); *(GAS u32x2*)((GAS bf16_t*)Yh + row * ldy + col) = yo; }
}


constexpr int P_HALF = 2 * A_KSZ + 2 * A_VSZ, P_BT = 2 * P_HALF;
static_assert(P_BT + 2 * 1028 <= LDS_BYTES - 64, "pair attention LDS map");
__device__ __forceinline__ void band_pair_step(LAS unsigned char* hl, const LAS float* btab, int buf, int t, int cw, int w4, int r16, int g,
                                               const bf16x8 (&qf)[2][4], f32x4 (&o)[2][8], float (&m)[2], f32x4 (&l)[2]) {
    const LAS unsigned char* kb_ = hl + buf * A_KSZ + r16 * 272 + g * 16;
    f32x4 s[2][4];
#pragma unroll
    for (int kb = 0; kb < 4; ++kb) { bf16x8 kfr[4];
#pragma unroll
        for (int ks = 0; ks < 4; ++ks) kfr[ks] = *(const LAS bf16x8*)(kb_ + kb * 16 * 272 + ks * 64);
#pragma unroll
        for (int rb = 0; rb < 2; ++rb) { s[rb][kb] = (f32x4){0.f, 0.f, 0.f, 0.f};
#pragma unroll
            for (int ks = 0; ks < 4; ++ks) s[rb][kb] = MFMA16(kfr[ks], qf[rb][ks], s[rb][kb]); } }
    const int delta = cw + 8 - t;
    bf16x8 pb[2][2];
    const bf16x8 ones = (bf16x8){16256, 16256, 16256, 16256, 16256, 16256, 16256, 16256};
#pragma unroll
    for (int rb = 0; rb < 2; ++rb) {
        float mn, alpha;
        if (delta >= 3) {
            const float bc = btab[256];
            float mt = fmaxf(fmaxf(s[rb][0][0], s[rb][0][1]), fmaxf(s[rb][0][2], s[rb][0][3]));
#pragma unroll
            for (int kb = 1; kb < 4; ++kb) mt = fmaxf(mt, fmaxf(fmaxf(s[rb][kb][0], s[rb][kb][1]), fmaxf(s[rb][kb][2], s[rb][kb][3])));
            mt = fmaxf(mt, __shfl_xor(mt, 16)); mt = fmaxf(mt, __shfl_xor(mt, 32));
            mn = fmaxf(m[rb], mt * ATT_SC + bc); alpha = __builtin_amdgcn_exp2f(m[rb] - mn); m[rb] = mn;
            const float off = bc - mn;
#pragma unroll
            for (int kb = 0; kb < 4; ++kb)
#pragma unroll
                for (int r = 0; r < 4; ++r) s[rb][kb][r] = __builtin_amdgcn_exp2f(s[rb][kb][r] * ATT_SC + off);
        } else { const int qi = 32 * (w4 & 1) + 16 * rb + r16;
#pragma unroll
            for (int kb = 0; kb < 4; ++kb)
#pragma unroll
                for (int r = 0; r < 4; ++r) { int dist = 64 * delta + qi - (16 * kb + 4 * g + r); dist = dist > 128 ? 128 : (dist < -128 ? -128 : dist);
                    s[rb][kb][r] = s[rb][kb][r] * ATT_SC + btab[dist + 128]; }
            float mt = fmaxf(fmaxf(s[rb][0][0], s[rb][0][1]), fmaxf(s[rb][0][2], s[rb][0][3]));
#pragma unroll
            for (int kb = 1; kb < 4; ++kb) mt = fmaxf(mt, fmaxf(fmaxf(s[rb][kb][0], s[rb][kb][1]), fmaxf(s[rb][kb][2], s[rb][kb][3])));
            mt = fmaxf(mt, __shfl_xor(mt, 16)); mt = fmaxf(mt, __shfl_xor(mt, 32));
            mn = fmaxf(m[rb], mt); alpha = __builtin_amdgcn_exp2f(m[rb] - mn); m[rb] = mn;
#pragma unroll
            for (int kb = 0; kb < 4; ++kb)
#pragma unroll
                for (int r = 0; r < 4; ++r) s[rb][kb][r] = __builtin_amdgcn_exp2f(s[rb][kb][r] - mn);
        }
        if (__any(alpha != 1.0f)) { l[rb] = l[rb] * alpha;
#pragma unroll
            for (int i = 0; i < 8; ++i) o[rb][i] = o[rb][i] * alpha; }
#pragma unroll
        for (int s2 = 0; s2 < 2; ++s2) { u32x4 pw; pw.x = pk2(s[rb][2 * s2][0], s[rb][2 * s2][1]); pw.y = pk2(s[rb][2 * s2][2], s[rb][2 * s2][3]);
            pw.z = pk2(s[rb][2 * s2 + 1][0], s[rb][2 * s2 + 1][1]); pw.w = pk2(s[rb][2 * s2 + 1][2], s[rb][2 * s2 + 1][3]); pb[rb][s2] = __builtin_bit_cast(bf16x8, pw);
            l[rb] = MFMA16(ones, pb[rb][s2], l[rb]); }
    }
    int voff_ = 0; asm volatile("" : "+v"(voff_), "+v"(pb[1][1]));
    const LAS unsigned char* vb_ = hl + 2 * A_KSZ + buf * A_VSZ + r16 * 144 + g * 8 + voff_;
#pragma unroll
    for (int dvb = 0; dvb < 8; ++dvb) { u32x2 vfr[4];
#pragma unroll
        for (int q = 0; q < 4; ++q) vfr[q] = *(const LAS u32x2*)(vb_ + dvb * 16 * 144 + (q >> 1) * 64 + (q & 1) * 32);
#pragma unroll
        for (int s2 = 0; s2 < 2; ++s2) { const u32x4 av = (u32x4){vfr[2 * s2].x, vfr[2 * s2].y, vfr[2 * s2 + 1].x, vfr[2 * s2 + 1].y};
#pragma unroll
            for (int rb = 0; rb < 2; ++rb) o[rb][dvb] = MFMA16(__builtin_bit_cast(bf16x8, av), pb[rb][s2], o[rb][dvb]); } }
}
__device__ __forceinline__ void band_pair_unit(LAS unsigned char* lds, const Params& p, int l, int j2, int hA) {
    int tid_ = threadIdx.x; asm volatile("" : "+v"(tid_)); const int tid = tid_, lane = tid & 63, w = __builtin_amdgcn_readfirstlane(tid >> 6), r16 = lane & 15, g = lane >> 4;
    const int half = w >> 2, w4 = w & 3, th = tid & 255, head = hA + half;
    LAS unsigned char* hl = lds + half * P_HALF;
    LAS float* btab = (LAS float*)(lds + P_BT + half * 1028);
    { const GAS float* bt = (const GAS float*)p.rel + (l * 8 + head) * 257; for (int i = th; i < 257; i += 256) btab[i] = bt[i] * LOG2E; }
    const GAS bf16_t* hm = (const GAS bf16_t*)(p.ws + WS_HM);
    const GAS bf16_t* Kh = hm + C_AK + head * 128; const GAS bf16_t* Vth = (const GAS bf16_t*)(p.ws + WS_VT) + (size_t)(head * 128) * LDV;
    const int row0 = 128 * j2 + 32 * w4 + r16;
    bf16x8 qf[2][4];
#pragma unroll
    for (int rb = 0; rb < 2; ++rb)
#pragma unroll
        for (int ks = 0; ks < 4; ++ks) qf[rb][ks] = *(const GAS bf16x8*)(hm + (size_t)(row0 + 16 * rb) * NMAIN + C_AQ + head * 128 + 32 * ks + 8 * g);
    f32x4 o[2][8];
#pragma unroll
    for (int rb = 0; rb < 2; ++rb)
#pragma unroll
        for (int i = 0; i < 8; ++i) o[rb][i] = (f32x4){0.f, 0.f, 0.f, 0.f};
    float m[2] = {-1e30f, -1e30f}; f32x4 l_[2] = {(f32x4){0.f, 0.f, 0.f, 0.f}, (f32x4){0.f, 0.f, 0.f, 0.f}};
    const int cw = w4 >> 1, nt = 10;
    int t0 = 8 - 2 * j2; if (t0 < 0) t0 = 0;
    u32x4 kr[4], vr[4];
#define P_GLOAD(t) do { const int key0_ = 64 * (2 * j2 - 8 + (t)); \
        _Pragma("unroll") for (int i_ = 0; i_ < 4; ++i_) { const int id_ = th + 256 * i_; \
            kr[i_] = *(const GAS u32x4*)(Kh + (size_t)(key0_ + (id_ >> 4)) * NMAIN + (id_ & 15) * 8); \
            vr[i_] = *(const GAS u32x4*)(Vth + (size_t)(id_ >> 3) * LDV + key0_ + (id_ & 7) * 8); } } while (0)
#define P_LSTORE(buf) do { _Pragma("unroll") for (int i_ = 0; i_ < 4; ++i_) { const int id_ = th + 256 * i_; \
            *(LAS u32x4*)(hl + (buf) * A_KSZ + (id_ >> 4) * 272 + (id_ & 15) * 16) = kr[i_]; \
            *(LAS u32x4*)(hl + 2 * A_KSZ + (buf) * A_VSZ + (id_ >> 3) * 144 + (id_ & 7) * 16) = vr[i_]; } } while (0)
    P_GLOAD(t0); P_LSTORE(0); __syncthreads();
    for (int t = t0; t < nt; ++t) {
        const int buf = (t - t0) & 1;
        if (t + 1 < nt) P_GLOAD(t + 1);
        if (t >= cw && t <= cw + 8) band_pair_step(hl, btab, buf, t, cw, w4, r16, g, qf, o, m, l_);
        if (t + 1 < nt) P_LSTORE(buf ^ 1);
        __syncthreads();
    }
#undef P_GLOAD
#undef P_LSTORE
    GAS bf16_t* Y = (GAS bf16_t*)(p.ws + WS_Y);
#pragma unroll
    for (int rb = 0; rb < 2; ++rb) { const float inv = 1.0f / l_[rb][0]; const size_t row = (size_t)(row0 + 16 * rb);
#pragma unroll
        for (int dvb = 0; dvb < 8; ++dvb) { const int col = 16 * dvb + 4 * g; const u32x2 z = *(const GAS u32x2*)(hm + row * NMAIN + C_AZ + head * 128 + col);
            const float y0 = o[rb][dvb][0] * inv * silu_f(bflo(z.x)), y1 = o[rb][dvb][1] * inv * silu_f(bfhi(z.x)), y2 = o[rb][dvb][2] * inv * silu_f(bflo(z.y)), y3 = o[rb][dvb][3] * inv * silu_f(bfhi(z.y));
            u32x2 yo; yo.x = pk2(y0, y1); yo.y = pk2(y2, y3); *(GAS u32x2*)(Y + row * DM + head * 128 + col) = yo; } }
}

constexpr int G_LR = 0, G_GW = 4096, G_GB = 8192, G_SEG = 8448, G_B = 10496, G_SSQ = 27136, G_QP = 27648, G_QM = 36864, G_KP = 46080, G_KM = 55296,
              G_KD = 64512, G_AT = 73728, G_VT = 82944, G_ST = 101376;
__device__ __forceinline__ void gla_compute_b(LAS unsigned char* lds, const bf16_t* hm_rows, const float* gw_l, const float* gb_l, int hb) {
    int tid_ = threadIdx.x; asm volatile("" : "+v"(tid_)); const int tid = tid_;
    LAS float* LR = (LAS float*)(lds + G_LR); LAS float* GW = (LAS float*)(lds + G_GW); LAS float* GB = (LAS float*)(lds + G_GB);
    LAS float* SEG = (LAS float*)(lds + G_SEG); LAS float* Bm = (LAS float*)(lds + G_B);
    if (tid < 128) { const int row = tid >> 1, half = tid & 1; const u32x4 v = *(const GAS u32x4*)((const GAS bf16_t*)hm_rows + (size_t)row * NMAIN + C_LR + 8 * half);
        LAS float* d = LR + row * 16 + 8 * half; d[0] = bflo(v.x); d[1] = bfhi(v.x); d[2] = bflo(v.y); d[3] = bfhi(v.y); d[4] = bflo(v.z); d[5] = bfhi(v.z); d[6] = bflo(v.w); d[7] = bfhi(v.w); }
    for (int i = tid; i < 1024; i += 512) GW[i] = ((const GAS float*)gw_l)[(i >> 6) * 256 + hb * 64 + (i & 63)];
    if (tid < 64) GB[tid] = ((const GAS float*)gb_l)[hb * 64 + tid];
    __syncthreads();
    const int d = tid & 63, tseg = tid >> 6;
    float gwr[16];
#pragma unroll
    for (int r = 0; r < 16; ++r) gwr[r] = GW[r * 64 + d];
    const float gbv = GB[d];
    float loc[8]; float run = 0.f;
#pragma unroll
    for (int tt = 0; tt < 8; ++tt) { const int t = 8 * tseg + tt; float x = gbv;
#pragma unroll
        for (int r = 0; r < 16; ++r) x += LR[t * 16 + r] * gwr[r];
        const float lg = (fminf(x, 0.f) - __logf(1.0f + __expf(-fabsf(x)))) * 0.0625f;
        run += lg; loc[tt] = run; }
    SEG[tseg * 64 + d] = run;
    __syncthreads();
    float off = 0.f;
#pragma unroll
    for (int s = 0; s < 8; ++s) { const float v = SEG[s * 64 + d]; off += (s < tseg) ? v : 0.f; }
#pragma unroll
    for (int tt = 0; tt < 8; ++tt) Bm[(8 * tseg + tt) * 65 + d] = off + loc[tt];
    __syncthreads();
}
__device__ __forceinline__ void gla_load_vt(LAS unsigned char* lds, const bf16_t* VTg, int hb, int c) {
    int tid_ = threadIdx.x; asm volatile("" : "+v"(tid_)); const int tid = tid_;
#pragma unroll
    for (int i = 0; i < 2; ++i) { const int id = tid + 512 * i, row = id >> 3, c8 = id & 7;
        *(LAS u32x4*)(lds + G_VT + row * 144 + c8 * 16) = *(const GAS u32x4*)((const GAS bf16_t*)VTg + (size_t)(1024 + hb * 128 + row) * LDV + 64 * c + 8 * c8); }
}
__device__ __forceinline__ void gla_part1(LAS unsigned char* lds, const Params& p, int l, int c, int hb) {
    int tid_ = threadIdx.x; asm volatile("" : "+v"(tid_)); const int tid = tid_, lane = tid & 63, w = __builtin_amdgcn_readfirstlane(tid >> 6), r16 = lane & 15, g = lane >> 4;
    const bf16_t* hm_rows = (const bf16_t*)(p.ws + WS_HM) + (size_t)(64 * c) * NMAIN;
    gla_compute_b(lds, hm_rows, p.gate_w + l * 16 * 256, p.gate_b + l * 256, hb);
    const LAS float* Bm = (const LAS float*)(lds + G_B);
    { GAS float* BG = (GAS float*)(p.ws + WS_BG) + (size_t)(64 * c) * 256 + hb * 64;
        const int t = tid >> 3, dc = tid & 7; f32x4 b0, b1;
        b0.x = Bm[t * 65 + 8 * dc + 0]; b0.y = Bm[t * 65 + 8 * dc + 1]; b0.z = Bm[t * 65 + 8 * dc + 2]; b0.w = Bm[t * 65 + 8 * dc + 3];
        b1.x = Bm[t * 65 + 8 * dc + 4]; b1.y = Bm[t * 65 + 8 * dc + 5]; b1.z = Bm[t * 65 + 8 * dc + 6]; b1.w = Bm[t * 65 + 8 * dc + 7];
        *(GAS f32x4*)(BG + (size_t)t * 256 + 8 * dc) = b0; *(GAS f32x4*)(BG + (size_t)t * 256 + 8 * dc + 4) = b1; }
    { const int t = tid >> 3, dc = tid & 7; const u32x4 kv = *(const GAS u32x4*)((const GAS bf16_t*)hm_rows + (size_t)t * NMAIN + C_BK + hb * 64 + 8 * dc);
        float kf[8] = {bflo(kv.x), bfhi(kv.x), bflo(kv.y), bfhi(kv.y), bflo(kv.z), bfhi(kv.z), bflo(kv.w), bfhi(kv.w)};
        LAS bf16_t* KD = (LAS bf16_t*)(lds + G_KD);
#pragma unroll
        for (int e = 0; e < 8; ++e) { const int d = 8 * dc + e; const float val = kf[e] * __expf(Bm[63 * 65 + d] - Bm[t * 65 + d]); KD[d * 72 + t] = (bf16_t)(pk2(val, 0.f) & 0xffffu); } }
    gla_load_vt(lds, (const bf16_t*)(p.ws + WS_VT), hb, c);
    if (tid < 64) ((GAS float*)(p.ws + WS_DCY))[(c * 4 + hb) * 64 + tid] = __expf(Bm[63 * 65 + tid]);
    __syncthreads();
    GAS bf16_t* U = (GAS bf16_t*)(p.ws + WS_U) + (size_t)(c * 4 + hb) * 8192;
    const LAS unsigned char* Ap = lds + G_VT + (16 * w + r16) * 144 + g * 16;
#pragma unroll
    for (int dkb = 0; dkb < 4; ++dkb) { const LAS unsigned char* Bp = lds + G_KD + (16 * dkb + r16) * 144 + g * 16; f32x4 acc = (f32x4){0.f, 0.f, 0.f, 0.f};
#pragma unroll
        for (int ks = 0; ks < 2; ++ks) acc = MFMA16(*(const LAS bf16x8*)(Bp + ks * 64), *(const LAS bf16x8*)(Ap + ks * 64), acc);
        u32x2 ub; ub.x = pk2(acc[0], acc[1]); ub.y = pk2(acc[2], acc[3]); *(GAS u32x2*)(U + (16 * w + r16) * 64 + 16 * dkb + 4 * g) = ub; }
    __syncthreads();
}
__device__ __forceinline__ void gla_scan(const Params& p, LAS unsigned char* lds) {
    int tid_ = threadIdx.x; asm volatile("" : "+v"(tid_)); const int tid = tid_, seg = tid >> 7, el = tid & 127;
    LAS float* CE = (LAS float*)lds;
    for (int eg = blockIdx.x; eg < 256; eg += gridDim.x) {
        const int e = eg * 128 + el, hb = e >> 13, rem = e & 8191, dk = rem & 63;
        const GAS bf16_t* U = (const GAS bf16_t*)(p.ws + WS_U) + (size_t)hb * 8192 + rem + (size_t)(seg * 32) * 32768;
        const GAS float* dcy = (const GAS float*)(p.ws + WS_DCY) + hb * 64 + dk + (seg * 32) * 256;
        GAS bf16_t* Sp = (GAS bf16_t*)(p.ws + WS_SP) + (size_t)hb * 8192 + rem + (size_t)(seg * 32) * 32768;
        float uv[32], dv[32];
#pragma unroll
        for (int j = 0; j < 32; ++j) { uv[j] = __uint_as_float(((unsigned)U[(size_t)j * 32768]) << 16); dv[j] = dcy[j * 256]; }
        float s = 0.f, pd = 1.f;
#pragma unroll
        for (int j = 0; j < 32; ++j) { const float u = uv[j], d = dv[j]; uv[j] = s; dv[j] = pd; s = d * s + u; pd *= d; }
        CE[seg * 128 + el] = s; CE[512 + seg * 128 + el] = pd;
        __syncthreads();
        float st = 0.f;
#pragma unroll
        for (int q = 0; q < 3; ++q) { const float se = CE[q * 128 + el], pe = CE[512 + q * 128 + el]; st = (q < seg) ? pe * st + se : st; }
#pragma unroll
        for (int j = 0; j < 32; ++j) Sp[(size_t)j * 32768] = (bf16_t)(pk2(uv[j] + dv[j] * st, 0.f) & 0xffffu);
        __syncthreads();
    }
}
struct Gla2Regs { u32x4 qv, kv; f32x4 b0, b1; u32x4 vt[2], st[2]; u32x2 zpre[4]; f32x4 gpre[4]; };
__device__ __forceinline__ void gla_part2_load(Gla2Regs& R, const Params& p, int l, int c, int hb, int tid, int w, int r16, int g) {
    const GAS bf16_t* hm_rows = (const GAS bf16_t*)(p.ws + WS_HM) + (size_t)(64 * c) * NMAIN;
    const int t = tid >> 3, dc = tid & 7;
    R.qv = *(const GAS u32x4*)(hm_rows + (size_t)t * NMAIN + C_BQ + hb * 64 + 8 * dc); R.kv = *(const GAS u32x4*)(hm_rows + (size_t)t * NMAIN + C_BK + hb * 64 + 8 * dc);
    const GAS float* BG = (const GAS float*)(p.ws + WS_BG) + (size_t)(64 * c + t) * 256 + hb * 64 + 8 * dc;
    R.b0 = *(const GAS f32x4*)BG; R.b1 = *(const GAS f32x4*)(BG + 4);
    const GAS bf16_t* VTg = (const GAS bf16_t*)(p.ws + WS_VT); const GAS bf16_t* Sp = (const GAS bf16_t*)(p.ws + WS_SP) + (size_t)(c * 4 + hb) * 8192;
#pragma unroll
    for (int i = 0; i < 2; ++i) { const int id = tid + 512 * i, row = id >> 3, c8 = id & 7;
        R.vt[i] = *(const GAS u32x4*)(VTg + (size_t)(1024 + hb * 128 + row) * LDV + 64 * c + 8 * c8); R.st[i] = *(const GAS u32x4*)(Sp + row * 64 + 8 * c8); }
    const int i_ = 16 * (w & 3) + r16;
#pragma unroll
    for (int q4 = 0; q4 < 4; ++q4) { const int dv0 = 16 * (4 * (w >> 2) + q4) + 4 * g;
        R.zpre[q4] = *(const GAS u32x2*)(hm_rows + (size_t)i_ * NMAIN + C_BZ + hb * 128 + dv0); R.gpre[q4] = *(const GAS f32x4*)((const GAS float*)p.norm_g + l * 128 + dv0); }
}
__device__ __forceinline__ void gla_part2(LAS unsigned char* lds, const Params& p, int l, int c, int hb, const Gla2Regs& R, int tid, int w, int r16, int g) {
    const bf16_t* hm_rows = (const bf16_t*)(p.ws + WS_HM) + (size_t)(64 * c) * NMAIN;
    u32x2 zpre[4]; f32x4 gpre[4];
#pragma unroll
    for (int q4 = 0; q4 < 4; ++q4) { zpre[q4] = R.zpre[q4]; gpre[q4] = R.gpre[q4]; }
    {
        const int t = tid >> 3, dc = tid & 7;
        const u32x4 qv = R.qv, kv = R.kv; const f32x4 b0 = R.b0, b1 = R.b1;
        u32x4 vt[2] = {R.vt[0], R.vt[1]}, st[2] = {R.st[0], R.st[1]};
        float qf[8] = {bflo(qv.x), bfhi(qv.x), bflo(qv.y), bfhi(qv.y), bflo(qv.z), bfhi(qv.z), bflo(qv.w), bfhi(qv.w)};
        float kf[8] = {bflo(kv.x), bfhi(kv.x), bflo(kv.y), bfhi(kv.y), bflo(kv.z), bfhi(kv.z), bflo(kv.w), bfhi(kv.w)};
        float bb[8] = {b0.x, b0.y, b0.z, b0.w, b1.x, b1.y, b1.z, b1.w};
        float qpv[8], qmv[8], kpv[8], kmv[8];
#pragma unroll
        for (int e = 0; e < 8; ++e) { const float ep = __expf(bb[e]), em = __expf(-bb[e]), q8 = qf[e] * 0.125f;
            qpv[e] = q8 * ep; qmv[e] = q8 * em; kpv[e] = kf[e] * ep; kmv[e] = kf[e] * em; }
        const int o = t * 144 + dc * 16;
        *(LAS u32x4*)(lds + G_QP + o) = (u32x4){pk2(qpv[0], qpv[1]), pk2(qpv[2], qpv[3]), pk2(qpv[4], qpv[5]), pk2(qpv[6], qpv[7])};
        *(LAS u32x4*)(lds + G_QM + o) = (u32x4){pk2(qmv[0], qmv[1]), pk2(qmv[2], qmv[3]), pk2(qmv[4], qmv[5]), pk2(qmv[6], qmv[7])};
        *(LAS u32x4*)(lds + G_KP + o) = (u32x4){pk2(kpv[0], kpv[1]), pk2(kpv[2], kpv[3]), pk2(kpv[4], kpv[5]), pk2(kpv[6], kpv[7])};
        *(LAS u32x4*)(lds + G_KM + o) = (u32x4){pk2(kmv[0], kmv[1]), pk2(kmv[2], kmv[3]), pk2(kmv[4], kmv[5]), pk2(kmv[6], kmv[7])};
#pragma unroll
        for (int i = 0; i < 2; ++i) { const int id = tid + 512 * i, row = id >> 3, c8 = id & 7;
            *(LAS u32x4*)(lds + G_VT + row * 144 + c8 * 16) = vt[i]; *(LAS u32x4*)(lds + G_ST + row * 144 + c8 * 16) = st[i]; }
    }
    __syncthreads();
    { const int ib = w >> 1; LAS bf16_t* AT = (LAS bf16_t*)(lds + G_AT);
        const LAS unsigned char* qpA = lds + G_QP + (16 * ib + r16) * 144 + g * 16; const LAS unsigned char* qmA = lds + G_QM + (16 * ib + r16) * 144 + g * 16;
#pragma unroll
        for (int jj = 0; jj < 2; ++jj) { const int jb = 2 * (w & 1) + jj;
            const LAS unsigned char* kmB = lds + G_KM + (16 * jb + r16) * 144 + g * 16; const LAS unsigned char* kpB = lds + G_KP + (16 * jb + r16) * 144 + g * 16;
            f32x4 lo = (f32x4){0.f, 0.f, 0.f, 0.f}, hi = lo;
#pragma unroll
            for (int ks = 0; ks < 2; ++ks) { lo = MFMA16(*(const LAS bf16x8*)(qpA + ks * 64), *(const LAS bf16x8*)(kmB + ks * 64), lo);
                hi = MFMA16(*(const LAS bf16x8*)(qmA + ks * 64), *(const LAS bf16x8*)(kpB + ks * 64), hi); }
#pragma unroll
            for (int r = 0; r < 4; ++r) { const int i = 16 * ib + 4 * g + r, j = 16 * jb + r16; const float v = (j <= i) ? lo[r] : hi[r]; AT[i * 72 + j] = (bf16_t)(pk2(v, 0.f) & 0xffffu); } } }
    __syncthreads();
    const int ib = w & 3, dvh = w >> 2;
    f32x4 oacc[4];
    { const LAS unsigned char* atA = lds + G_AT + (16 * ib + r16) * 144 + g * 16; const LAS unsigned char* qpA = lds + G_QP + (16 * ib + r16) * 144 + g * 16;
#pragma unroll
        for (int q4 = 0; q4 < 4; ++q4) { const int dvb = 4 * dvh + q4;
            const LAS unsigned char* vtB = lds + G_VT + (16 * dvb + r16) * 144 + g * 16; const LAS unsigned char* stB = lds + G_ST + (16 * dvb + r16) * 144 + g * 16;
            f32x4 acc = (f32x4){0.f, 0.f, 0.f, 0.f};
#pragma unroll
            for (int ks = 0; ks < 2; ++ks) { acc = MFMA16(*(const LAS bf16x8*)(vtB + ks * 64), *(const LAS bf16x8*)(atA + ks * 64), acc);
                acc = MFMA16(*(const LAS bf16x8*)(stB + ks * 64), *(const LAS bf16x8*)(qpA + ks * 64), acc); }
            oacc[q4] = acc; } }
    LAS float* SSQ = (LAS float*)(lds + G_SSQ);
    { float pr = 0.f;
#pragma unroll
        for (int q4 = 0; q4 < 4; ++q4) pr += (oacc[q4][0] * oacc[q4][0] + oacc[q4][1] * oacc[q4][1]) + (oacc[q4][2] * oacc[q4][2] + oacc[q4][3] * oacc[q4][3]);
        pr += __shfl_xor(pr, 16); pr += __shfl_xor(pr, 32);
        if (g == 0) SSQ[dvh * 64 + 16 * ib + r16] = pr; }
    __syncthreads();
    { const int i = 16 * ib + r16; const float rinv = rsqrtf((SSQ[i] + SSQ[64 + i]) * (1.0f / 128.0f) + RMS_EPS);
        GAS bf16_t* Yr = (GAS bf16_t*)(p.ws + WS_Y) + (size_t)(64 * c + i) * DM + 1024 + hb * 128;
#pragma unroll
        for (int q4 = 0; q4 < 4; ++q4) { const int dv0 = 16 * (4 * dvh + q4) + 4 * g; const u32x2 z = zpre[q4]; const f32x4 gg = gpre[q4];
            const float y0 = oacc[q4][0] * rinv * gg.x * silu_f(bflo(z.x)), y1 = oacc[q4][1] * rinv * gg.y * silu_f(bfhi(z.x)), y2 = oacc[q4][2] * rinv * gg.z * silu_f(bflo(z.y)), y3 = oacc[q4][3] * rinv * gg.w * silu_f(bfhi(z.y));
            u32x2 yo; yo.x = pk2(y0, y1); yo.y = pk2(y2, y3); *(GAS u32x2*)(Yr + dv0) = yo; } }
    __syncthreads();
}

__device__ __forceinline__ void ln_phase(const Params& p, int l, const float* tin, float* fout) {
    int tid_ = threadIdx.x; asm volatile("" : "+v"(tid_)); const int tid = tid_, lane = tid & 63, wave = tid >> 6;
    const int gw = blockIdx.x * 8 + wave, NGW = gridDim.x * 8;
    const float* lg = p.ln_g + l * DM; const float* lb = p.ln_b + l * DM; bf16_t* xb = (bf16_t*)(p.ws + WS_XB);
    for (int row = gw; row < SEQ; row += NGW) {
        const f32x4* xr = (const f32x4*)(tin + (size_t)row * DM) + lane;
        f32x4 v[8]; float s = 0.f;
#pragma unroll
        for (int j = 0; j < 8; ++j) { v[j] = xr[64 * j]; s += (v[j].x + v[j].y) + (v[j].z + v[j].w); }
#pragma unroll
        for (int o = 1; o < 64; o <<= 1) s += __shfl_xor(s, o);
        const float mean = s * (1.0f / DM); float s2 = 0.f;
#pragma unroll
        for (int j = 0; j < 8; ++j) { v[j] = v[j] - mean; s2 += (v[j].x * v[j].x + v[j].y * v[j].y) + (v[j].z * v[j].z + v[j].w * v[j].w); }
#pragma unroll
        for (int o = 1; o < 64; o <<= 1) s2 += __shfl_xor(s2, o);
        const float rstd = rsqrtf(s2 * (1.0f / DM) + LN_EPS);
        f32x4* orow = (f32x4*)(fout + (size_t)row * DM) + lane; u32x2* brow = (u32x2*)(xb + (size_t)row * DM) + lane;
#pragma unroll
        for (int j = 0; j < 8; ++j) { const f32x4 gg = ((const f32x4*)lg)[lane + 64 * j], bb = ((const f32x4*)lb)[lane + 64 * j];
            const f32x4 y = v[j] * rstd * gg + bb; orow[64 * j] = y; u32x2 o2; o2.x = pk2(y.x, y.y); o2.y = pk2(y.z, y.w); brow[64 * j] = o2; }
    }
}

#define XB_TMO      128
#define XB_XCNT(j)  (256  + 64 * (j))
#define XB_XSUB(j)  (1280 + 64 * (j))
#define XB_XGEN(j)  (2304 + 64 * (j))
#define XB_TOP      3328
#define XB_TOPGEN   3392
#define XCD_BAR_WORDS 3456
#define XB_SPIN_CAP (1u << 18)

__device__ __forceinline__ unsigned xb_ld(unsigned* p)              { return __hip_atomic_load(p, __ATOMIC_RELAXED, __HIP_MEMORY_SCOPE_AGENT); }
__device__ __forceinline__ unsigned xb_add(unsigned* p, unsigned v) { return __hip_atomic_fetch_add(p, v, __ATOMIC_RELAXED, __HIP_MEMORY_SCOPE_AGENT); }
__device__ __forceinline__ unsigned xb_xcc_id() { return (unsigned)__builtin_amdgcn_s_getreg((3 << 11) | 20) & 0xFu; }
#define XB_SPIN(cond, bar) do { unsigned _sp = 0; while (cond) { __builtin_amdgcn_s_sleep(1); \
    if ((++_sp & 255u) == 0u) { if (xb_ld(&(bar)[XB_TMO])) break; if (_sp > XB_SPIN_CAP) { atomicAdd(&(bar)[XB_TMO], 1u); break; } } } } while (0)

struct XcdBarrier {
    unsigned* bar; unsigned x;
    volatile LAS unsigned* st;
};

__device__ __forceinline__ XcdBarrier xcd_barrier_post(unsigned* bar, volatile LAS unsigned* st) {
    XcdBarrier b; b.bar = bar; b.x = xb_xcc_id(); b.st = st;
    if (threadIdx.x == 0) (void)xb_add(&bar[XB_XCNT(b.x)], 1u);
    return b;
}
__device__ __forceinline__ void xcd_barrier_complete(unsigned* bar, unsigned x, unsigned& nloc, unsigned& nx) {
    const unsigned G = gridDim.x * gridDim.y * gridDim.z;
    unsigned sum, cnt, mine, sp = 0u;
    for (;;) {
        sum = 0u; cnt = 0u; mine = 0u;
#pragma unroll
        for (unsigned j = 0; j < 16; ++j) { const unsigned c = xb_ld(&bar[XB_XCNT(j)]); sum += c; cnt += (c > 0u) ? 1u : 0u; mine = (j == x) ? c : mine; }
        if (sum == G) break;
        __builtin_amdgcn_s_sleep(1);
        if ((++sp & 255u) == 0u) { if (xb_ld(&bar[XB_TMO])) break; if (sp > XB_SPIN_CAP) { atomicAdd(&bar[XB_TMO], 1u); break; } }
    }
    nloc = mine > 0u ? mine : 1u; nx = cnt > 0u ? cnt : 1u;
}

__device__ __forceinline__ void xcd_barrier(const XcdBarrier& b) {
    asm volatile("s_waitcnt vmcnt(0)" ::: "memory");
    __syncthreads();
    if (threadIdx.x == 0) {
        unsigned* bar = b.bar;
        __builtin_amdgcn_s_waitcnt(0);
        unsigned nloc = b.st[0], nx = b.st[1];
        if (nloc == 0u) { xcd_barrier_complete(bar, b.x, nloc, nx); b.st[0] = nloc; b.st[1] = nx; }
        const unsigned old = xb_add(&bar[XB_XSUB(b.x)], 1u);
        const unsigned gen = old / nloc;
        if (old + 1u == (gen + 1u) * nloc) {
            __builtin_amdgcn_fence(__ATOMIC_RELEASE, "agent");
            asm volatile("s_waitcnt vmcnt(0)" ::: "memory");
            const unsigned og = xb_add(&bar[XB_TOP], 1u);
            const unsigned tg = og / nx;
            if (og + 1u == (tg + 1u) * nx) xb_add(&bar[XB_TOPGEN], 1u);
            else XB_SPIN(xb_ld(&bar[XB_TOPGEN]) == tg, bar);
            __builtin_amdgcn_fence(__ATOMIC_ACQUIRE, "agent");
            xb_add(&bar[XB_XGEN(b.x)], 1u);
            asm volatile("s_waitcnt vmcnt(0)" ::: "memory");
        } else {
            XB_SPIN(xb_ld(&bar[XB_XGEN(b.x)]) == gen, bar);
            __builtin_amdgcn_fence(__ATOMIC_ACQUIRE, "agent");
            asm volatile("s_waitcnt vmcnt(0)" ::: "memory");
        }
    }
    __syncthreads();
}

constexpr int NPH = 1 + 6 * DEPTH;
__global__ void __launch_bounds__(512, 2) mega(Params p_in) {
    extern __shared__ __attribute__((aligned(16))) unsigned char lds_raw[];
    LAS unsigned char* lds = (LAS unsigned char*)lds_raw;
    cg::grid_group grid = cg::this_grid();
    const int bid = blockIdx.x, G = gridDim.x;
    volatile LAS unsigned* misc = (volatile LAS unsigned*)(lds + LDS_BYTES - 64);
    if (threadIdx.x < 16) misc[threadIdx.x] = 0u;
    __syncthreads();
    const XcdBarrier bar = xcd_barrier_post((unsigned*)(p_in.ws + WS_CTL), misc);
    if (p_in.ph_hi - p_in.ph_lo > 1) grid.sync();
    const Params& p0 = p_in;
    for (int ph = p0.ph_lo; ph < p0.ph_hi; ++ph) {
        Params p = p0; asm volatile("" : "+s"(p.ws));
        bf16_t* xb = (bf16_t*)(p.ws + WS_XB); float* xf = (float*)(p.ws + WS_XF);
        bf16_t* hm = (bf16_t*)(p.ws + WS_HM); bf16_t* VT = (bf16_t*)(p.ws + WS_VT); bf16_t* Y = (bf16_t*)(p.ws + WS_Y);
        if (ph == 0) phase0(p, lds);
        else {
            const int l = (ph - 1) / 6, k = (ph - 1) % 6;
            const bf16_t* win = (const bf16_t*)(p.ws + WS_WIN + l * WIN_L);
            if (k == 0) {
                for (int gi = 0; gi < 4; ++gi) {
                    pg8::Gemm g; bf16_t* O; int ldc, c;
                    if (gi == 0) { g.A = xb; g.Bt = win; g.M = SEQ; g.N = NMAIN; O = hm; ldc = NMAIN; c = bid; }
                    else if (gi == 1) { g.A = win + (size_t)NMAIN * DM; g.Bt = xb; g.M = NVT; g.N = SEQ; O = VT; ldc = LDV; c = G - 1 - bid; }
                    else if (gi == 2) { g.A = (const bf16_t*)(p.ws + WS_MEMB); g.Bt = (const bf16_t*)(p.ws + WS_WMK) + (size_t)l * 512 * DM; g.M = NMEM; g.N = 512; O = (bf16_t*)(p.ws + WS_MK) + l * 512; ldc = 2048;
                        c = (bid >= G - 16 && bid < G - 14) ? bid - (G - 16) : (1 << 24); }
                    else { g.A = (const bf16_t*)(p.ws + WS_WMV) + (size_t)l * 512 * DM; g.Bt = (const bf16_t*)(p.ws + WS_MEMB); g.M = 512; g.N = NMEM; O = (bf16_t*)(p.ws + WS_MVT) + (size_t)l * 512 * NMEM; ldc = NMEM;
                        c = (bid >= G - 14 && bid < G - 12) ? bid - (G - 14) : (1 << 24); }
                    g.K = DM;
                    pg8::StaticOrder S; S.init(g.M, g.N, G, c);
                    pg8::EpiBf16<0> E{O, ldc, nullptr, 0, 0, 1.f};
                    pg8::gemm_phase<pg8::EpiBf16<0>, pg8::StaticOrder, true, true>(lds, g, S, E);
                }
                if (l + 1 < DEPTH) {
                    int wkb = bid, nwb = G;
                    if (G == 256) { nwb = 144; wkb = bid < 64 ? bid : (bid >= 160 && bid < 240 ? bid - 96 : -1); }
                    if (wkb >= 0) { int t2_ = threadIdx.x; asm volatile("" : "+v"(t2_)); convert_layer(p, l + 1, lds, wkb * 8 + (t2_ >> 6), nwb * 8); }
                }
            } else if (k == 1) {
                for (int u = bid; u < 256; u += G) band_pair_unit(lds, p, l, u >> 2, 2 * (u & 3));
                for (int u = bid; u < 256; u += G) { const int head = u & 3, qb = u >> 2;
                    attn_unit<false>(lds, 128 * qb, hm + C_MQ + head * 128, NMAIN, (const bf16_t*)(p.ws + WS_MK) + l * 512 + head * 128, 2048,
                                     (const bf16_t*)(p.ws + WS_MVT) + (size_t)(l * 512 + head * 128) * NMEM, NMEM, hm + C_MZ + head * 128, NMAIN, Y + 1536 + head * 128, DM, nullptr, 0); }
                for (int u = bid; u < 512; u += G) gla_part1(lds, p, l, u >> 2, u & 3);
            } else if (k == 2) gla_scan(p, lds);
            else if (k == 3) {
                int t3_ = threadIdx.x; asm volatile("" : "+v"(t3_)); const int tid3 = t3_, w3 = __builtin_amdgcn_readfirstlane(tid3 >> 6), r3 = tid3 & 15, g3 = (tid3 & 63) >> 4;
                if (G == 256) {
                    Gla2Regs RA, RB; const int u = bid, u2 = bid + 256;
                    gla_part2_load(RA, p, l, u >> 2, u & 3, tid3, w3, r3, g3);
                    gla_part2_load(RB, p, l, u2 >> 2, u2 & 3, tid3, w3, r3, g3);
                    gla_part2(lds, p, l, u >> 2, u & 3, RA, tid3, w3, r3, g3);
                    gla_part2(lds, p, l, u2 >> 2, u2 & 3, RB, tid3, w3, r3, g3);
                } else {
                    for (int u = bid; u < 512; u += G) { Gla2Regs RA; gla_part2_load(RA, p, l, u >> 2, u & 3, tid3, w3, r3, g3); gla_part2(lds, p, l, u >> 2, u & 3, RA, tid3, w3, r3, g3); }
                }
            }
            else if (k == 4) {
                pg8::Gemm g; g.A = Y; g.Bt = (const bf16_t*)(p.ws + WS_WOUT + l * WOUT_L); g.M = SEQ; g.N = DM; g.K = DM;
                pg8::StaticOrder S; S.init(SEQ, DM, G, bid);
                if (G == 256) {
                    pg8::EpiResLn E{l == 0 ? p.x : (const float*)nullptr, l == DEPTH - 1 ? p.out : (float*)nullptr, xb, (bf16_t*)(p.ws + WS_XL), p.ln_g + l * DM, p.ln_b + l * DM, (unsigned long long*)(p.ws + WS_XCH),
                                    (unsigned*)(p.ws + WS_CTL) + CW_CNT + l * 2048, 1.6817928305074292f, LN_EPS};
                    pg8::gemm_phase<pg8::EpiResLn, pg8::StaticOrder, false, true>(lds, g, S, E);
                } else {
                    pg8::EpiResid E{l == 0 ? p.x : xf, xf, DM, 1.6817928305074292f};
                    pg8::gemm_phase<pg8::EpiResid, pg8::StaticOrder, true, true>(lds, g, S, E);
                }
            } else if (G != 256) ln_phase(p, l, xf, l == DEPTH - 1 ? p.out : xf);
        }
        if (ph + 1 < p0.ph_hi && !(G == 256 && ph > 0 && (ph - 1) % 6 == 4)) xcd_barrier(bar);
    }
}

extern "C" void kernel_launch(void* const* d_in, const int* in_sizes, int n_in, void* d_out, int out_size, void* d_ws, size_t ws_size, hipStream_t stream) {
    static int grid = 0;
    if (grid == 0) {
        if (n_in != 11 || ws_size < WS_END) { fprintf(stderr, "kernel_launch: unexpected inputs (n_in %d, ws %zu)\n", n_in, ws_size); grid = -1; return; }
        int dev = 0, cus = 0, per_cu = 0;
        hipGetDevice(&dev); hipDeviceGetAttribute(&cus, hipDeviceAttributeMultiprocessorCount, dev);
        hipFuncSetAttribute((const void*)mega, hipFuncAttributeMaxDynamicSharedMemorySize, LDS_BYTES);
        hipOccupancyMaxActiveBlocksPerMultiprocessor(&per_cu, (const void*)mega, 512, LDS_BYTES);
        if (per_cu < 1) per_cu = 1;
        (void)hipGetLastError();
        grid = cus * per_cu;
    }
    if (grid < 0) return;
    Params p{};
    p.x = (const float*)d_in[0]; p.mem = (const float*)d_in[1]; p.w_in = (const float*)d_in[2]; p.rel = (const float*)d_in[3]; p.gate_w = (const float*)d_in[4];
    p.gate_b = (const float*)d_in[5]; p.norm_g = (const float*)d_in[6]; p.w_mkv = (const float*)d_in[7]; p.w_out = (const float*)d_in[8]; p.ln_g = (const float*)d_in[9]; p.ln_b = (const float*)d_in[10];
    p.out = (float*)d_out; p.ws = (unsigned char*)d_ws;
    if (hipMemsetAsync((char*)d_ws + WS_CTL, 0, CTL_BYTES, stream) != hipSuccess) { fprintf(stderr, "memset failed\n"); return; }
#if defined(MK_MULTI)
    for (int ph = 0; ph < NPH; ++ph) { p.ph_lo = ph; p.ph_hi = ph + 1; hipLaunchKernelGGL(mega, dim3(grid), dim3(512), LDS_BYTES, stream, p); }
#else
    p.ph_lo = 0; p.ph_hi = NPH;
    void* args[] = {&p};
    hipError_t e = hipLaunchCooperativeKernel((const void*)mega, dim3(grid), dim3(512), args, LDS_BYTES, stream);
    if (e != hipSuccess) fprintf(stderr, "cooperative launch failed: %s (grid %d)\n", hipGetErrorString(e), grid);
#endif
}
```

```cpp
#include <hip/hip_runtime.h>
#include <hip/hip_cooperative_groups.h>
#include <cstdio>
#include <cstdint>
namespace cg = cooperative_groups;
namespace pg8 {
#define PG8_LAS __attribute__((address_space(3)))
typedef unsigned short bf16_t;
typedef short bf16x8 __attribute__((ext_vector_type(8)));
typedef float f32x4 __attribute__((ext_vector_type(4)));
typedef unsigned u32x4 __attribute__((ext_vector_type(4)));
constexpr int BM = 256, BK = 64, HALF = 128, HTB = HALF * BK * 2  , STAGE_BYTES = 8 * HTB, NXCD = 8, WGM = 8;

__host__ __device__ __forceinline__ int lds_byte(int r, int c) { const int st = (r >> 4) * 2 + (c >> 5), rr = r & 15, cc = c & 31, ob = rr * 64 + cc * 2; return st * 1024 + (ob ^ (((ob >> 9) & 1) << 5)); }
__host__ __device__ __forceinline__ void stage_rc(int b, int& R, int& C) { const int st = b / 1024, sb = b % 1024, swz = sb ^ (((sb >> 9) & 1) << 5); R = (st >> 1) * 16 + swz / 64; C = (st & 1) * 32 + (swz % 64) / 2; }
__host__ __device__ __forceinline__ int perm32(int rho) { const int n = rho >> 4, i = rho & 15; return 8 * (i >> 2) + 4 * n + (i & 3); }

struct Unit { int pm, pn; };
struct Gemm { const bf16_t* A; const bf16_t* Bt; int M, N, K; };

struct StaticOrder {
    int nM, nN, nwg, G, c;
    __host__ __device__ void init(int M, int N, int G_, int c_) { nM = M / BM; nN = N / BM; nwg = nM * nN; G = G_; c = c_; }
    __host__ __device__ bool next(int i, Unit& u) const {
        const long L = (long)i * G + c; if (L >= nwg) return false;
        int wgid = (int)L; { const int q = nwg / NXCD, r = nwg % NXCD, xcd = wgid % NXCD, off = wgid / NXCD; wgid = (xcd < r ? xcd * (q + 1) : r * (q + 1) + (xcd - r) * q) + off; }
        const int nig = WGM * nN, gid = wgid / nig, fm = gid * WGM, gsz = (nM - fm) < WGM ? (nM - fm) : WGM;
        u.pm = fm + ((wgid % nig) % gsz); u.pn = (wgid % nig) / gsz; return true;
    }
    __device__ __forceinline__ void a_ready(const Unit&) const {}
    __device__ __forceinline__ void done(const Unit&) const {}
};

__device__ __forceinline__ unsigned cvt_pk_bf16(float lo, float hi) { unsigned r; asm volatile("v_cvt_pk_bf16_f32 %0, %1, %2" : "=v"(r) : "v"(lo), "v"(hi)); return r; }
typedef float f32x2 __attribute__((ext_vector_type(2)));
__device__ __forceinline__ f32x2 gelu_pk(f32x2 v) {
    const f32x2 av = __builtin_elementwise_abs(v), d = av * 0.2316418882f + 1.0f;
    f32x2 t; t.x = __builtin_amdgcn_rcpf(d.x); t.y = __builtin_amdgcn_rcpf(d.y);
    f32x2 q = t * 0.5307027145f + (-0.7265760135f); q = q * t + 0.7107068705f; q = q * t + (-0.142248368f); q = q * t + 0.127414796f; q = q * t;
    const f32x2 s = (v * v) * (-0.72134752044f);
    f32x2 e; e.x = __builtin_amdgcn_exp2f(s.x); e.y = __builtin_amdgcn_exp2f(s.y);
    const f32x2 m = v * (q * e), r = v - m;
    f32x2 o; o.x = v.x < 0.f ? m.x : r.x; o.y = v.y < 0.f ? m.y : r.y; return o;
}

template <int ACT  > struct EpiBf16 {
    static constexpr bool PERM = true, AFTER_DRAIN = false; static_assert(ACT == 0 || ACT == 1, "EpiBf16: ACT is 0 (none) or 1 (gelu_pk)");
    bf16_t* O; int ldc; const float* bias; int split_cols; size_t split_stride; float scale0;
    __device__ __forceinline__ void operator()(const f32x4 (&acc)[2][2][4][2], const Unit& u, int wr, int wc, int fr, int fq) const {
        const int row0 = u.pm * BM + wr * 64 + fr; int colt = u.pn * BM; bf16_t* base = O;
        float sc = 1.f; if (split_cols) { const int t = colt / split_cols; base += (size_t)t * split_stride; colt -= t * split_cols; if (t == 0) sc = scale0; }
        const int col0 = colt + wc * 32 + 8 * fq, bcol0 = u.pn * BM + wc * 32 + 8 * fq;
        f32x4 bv[2][2];
#pragma unroll
        for (int bj = 0; bj < 2; ++bj)
#pragma unroll
            for (int n = 0; n < 2; ++n) bv[bj][n] = bias ? *(const f32x4*)(bias + bcol0 + bj * HALF + 4 * n) : (f32x4){0.f, 0.f, 0.f, 0.f};
#pragma unroll
        for (int ai = 0; ai < 2; ++ai)
#pragma unroll
            for (int m = 0; m < 4; ++m) { bf16_t* rowp = base + (size_t)(row0 + ai * HALF + m * 16) * ldc + col0;
#pragma unroll
                for (int bj = 0; bj < 2; ++bj) { f32x4 v0 = acc[ai][bj][m][0] + bv[bj][0], v1 = acc[ai][bj][m][1] + bv[bj][1];
                    if (ACT == 1) { f32x2 a = gelu_pk((f32x2){v0[0], v0[1]}), b = gelu_pk((f32x2){v0[2], v0[3]}), c = gelu_pk((f32x2){v1[0], v1[1]}), d = gelu_pk((f32x2){v1[2], v1[3]});
                        v0 = (f32x4){a.x, a.y, b.x, b.y}; v1 = (f32x4){c.x, c.y, d.x, d.y}; }
                    v0 = v0 * sc; v1 = v1 * sc; u32x4 w; w.x = cvt_pk_bf16(v0[0], v0[1]); w.y = cvt_pk_bf16(v0[2], v0[3]); w.z = cvt_pk_bf16(v1[0], v1[1]); w.w = cvt_pk_bf16(v1[2], v1[3]);
                    *(u32x4*)(rowp + bj * HALF) = w; } }
    }
};
template <class Epi, class Sched, bool ALIGN_EPI = false, bool SP2 = false>
__device__ __forceinline__ void gemm_phase(PG8_LAS unsigned char* lds, const Gemm g, const Sched& S, const Epi& E) {
    int tid_ = threadIdx.x; asm volatile("" : "+v"(tid_)); const int tid = tid_, wid = __builtin_amdgcn_readfirstlane(tid >> 6), lane = tid & 63, wr = wid >> 2, wc = wid & 3, fr = lane & 15, fq = lane >> 4;
    const int K = g.K, nt = K / BK;
    unsigned voffA[2], voffB[2];
#pragma unroll
    for (int i = 0; i < 2; ++i) { int R, C; stage_rc(tid * 16 + i * 8192, R, C); const int Rb = Epi::PERM ? ((R & ~31) + perm32(R & 31)) : R;
        voffA[i] = (unsigned)(R * K + C) * 2u; voffB[i] = (unsigned)(Rb * K + C) * 2u; }
    const size_t kstep = (size_t)(BK * 2);
    const size_t hstep = (size_t)HALF * K * 2;
    const size_t tstep = 2 * hstep;
    const unsigned ldsw = (unsigned)wid * 1024u;
    const int aoff = lds_byte(wr * 64 + fr, fq * 8), boff = lds_byte(wc * 32 + fr, fq * 8);
#define PG8_SA(b, h) (((b) * 2 + (h)) * HTB)
#define PG8_SB(b, h) ((4 + (b) * 2 + (h)) * HTB)
#define PG8_STAGE(bufoff, gbase, voff) do { _Pragma("unroll") for (int _i = 0; _i < 2; ++_i) \
        __builtin_amdgcn_global_load_lds((const unsigned*)((const char*)(gbase) + (voff)[_i]), (PG8_LAS unsigned*)(lds + (bufoff) + ldsw + _i * 8192), 16, 0, 0); } while (0)
#define PG8_LDA(dst, b, h) do { _Pragma("unroll") for (int m = 0; m < 4; ++m) _Pragma("unroll") for (int k = 0; k < 2; ++k) dst[m][k] = *(const PG8_LAS bf16x8*)(lds + PG8_SA(b, h) + aoff + m * 2048 + k * 1024); } while (0)
#define PG8_LDB(dst, b, h) do { _Pragma("unroll") for (int n = 0; n < 2; ++n) _Pragma("unroll") for (int k = 0; k < 2; ++k) dst[n][k] = *(const PG8_LAS bf16x8*)(lds + PG8_SB(b, h) + boff + n * 2048 + k * 1024); } while (0)
#define PG8_MMA(ai, bj, At, Bt) do { __builtin_amdgcn_s_setprio(1); _Pragma("unroll") for (int m = 0; m < 4; ++m) _Pragma("unroll") for (int n = 0; n < 2; ++n) _Pragma("unroll") for (int k = 0; k < 2; ++k) \
        acc[ai][bj][m][n] = __builtin_amdgcn_mfma_f32_16x16x32_bf16(Bt[n][k], At[m][k], acc[ai][bj][m][n], 0, 0, 0); __builtin_amdgcn_s_setprio(0); } while (0)
#define PG8_WAIT_V(n) asm volatile("s_waitcnt vmcnt(" #n ")" ::: "memory")
#define PG8_WAIT_L(n) asm volatile("s_waitcnt lgkmcnt(" #n ")" ::: "memory")
#define PG8_BAR __builtin_amdgcn_s_barrier()
#define PG8_SCHED __builtin_amdgcn_sched_barrier(0)
    Unit cur, nxt; int ui = 0;
    if (!S.next(0, cur)) return;
    f32x4 acc[2][2][4][2];
#pragma unroll
    for (int a = 0; a < 2; ++a)
#pragma unroll
        for (int b = 0; b < 2; ++b)
#pragma unroll
            for (int m = 0; m < 4; ++m)
#pragma unroll
                for (int n = 0; n < 2; ++n) acc[a][b][m][n] = (f32x4){0.f, 0.f, 0.f, 0.f};
    bf16x8 At[4][2], B0[2][2], B1[2][2];
    const char* cA = (const char*)g.A + (size_t)cur.pm * tstep; const char* cB = (const char*)g.Bt + (size_t)cur.pn * tstep;
    S.a_ready(cur);
    if constexpr (SP2) {
        PG8_STAGE(PG8_SB(0, 0), cB, voffB); PG8_STAGE(PG8_SB(0, 1), cB + hstep, voffB); PG8_STAGE(PG8_SA(0, 0), cA, voffA); PG8_STAGE(PG8_SA(0, 1), cA + hstep, voffA);
        if (wr == 1) PG8_BAR;
        PG8_WAIT_V(2); PG8_BAR;
        PG8_STAGE(PG8_SB(1, 0), cB + kstep, voffB); PG8_STAGE(PG8_SA(1, 0), cA + kstep, voffA); PG8_STAGE(PG8_SB(1, 1), cB + hstep + kstep, voffB);
        PG8_WAIT_V(6); PG8_BAR;
    } else {
        PG8_STAGE(PG8_SB(0, 0), cB, voffB); PG8_STAGE(PG8_SA(0, 0), cA, voffA); PG8_STAGE(PG8_SB(0, 1), cB + hstep, voffB); PG8_STAGE(PG8_SA(0, 1), cA + hstep, voffA);
        if (wr == 1) PG8_BAR;
        PG8_WAIT_V(4); PG8_BAR;
        PG8_STAGE(PG8_SB(1, 0), cB + kstep, voffB); PG8_STAGE(PG8_SA(1, 0), cA + kstep, voffA); PG8_STAGE(PG8_SB(1, 1), cB + hstep + kstep, voffB);
        PG8_WAIT_V(6); PG8_BAR;
    }
    for (;;) {
        const bool has_next = S.next(ui + 1, nxt);
        const char* nA = has_next ? (const char*)g.A + (size_t)nxt.pm * tstep : cA; const char* nB = has_next ? (const char*)g.Bt + (size_t)nxt.pn * tstep : cB;
        for (int t = 0; t < nt; t += 2) {
            const bool last = (t == nt - 2);
            const char* a1 = cA + (size_t)(t + 1) * kstep;
            const char* a2 = last ? nA : cA + (size_t)(t + 2) * kstep; const char* b2 = last ? nB : cB + (size_t)(t + 2) * kstep;
            const char* a3 = a2 + kstep; const char* b3 = b2 + kstep;
            if (last && has_next) S.a_ready(nxt);
            if constexpr (SP2) {
            PG8_LDB(B0, 0, 0); PG8_LDB(B1, 0, 1); PG8_SCHED; PG8_LDA(At, 0, 0); PG8_STAGE(PG8_SA(1, 1), a1 + hstep, voffA);
            PG8_WAIT_V(8); PG8_WAIT_L(0); PG8_BAR; PG8_MMA(0, 0, At, B0); PG8_MMA(0, 1, At, B1); PG8_BAR; PG8_SCHED;
            PG8_LDA(At, 0, 1); PG8_STAGE(PG8_SB(0, 0), b2, voffB); PG8_STAGE(PG8_SB(0, 1), b2 + hstep, voffB); PG8_STAGE(PG8_SA(0, 0), a2, voffA);
            PG8_WAIT_V(8); PG8_WAIT_L(0); PG8_BAR; PG8_MMA(1, 0, At, B0); PG8_MMA(1, 1, At, B1); PG8_BAR; PG8_SCHED;
            PG8_LDB(B0, 1, 0); PG8_LDB(B1, 1, 1); PG8_SCHED; PG8_LDA(At, 1, 0); PG8_STAGE(PG8_SA(0, 1), a2 + hstep, voffA);
            PG8_WAIT_V(8); PG8_WAIT_L(0); PG8_BAR; PG8_MMA(0, 0, At, B0); PG8_MMA(0, 1, At, B1); PG8_BAR; PG8_SCHED;
            PG8_LDA(At, 1, 1); PG8_STAGE(PG8_SB(1, 0), b3, voffB); PG8_STAGE(PG8_SB(1, 1), b3 + hstep, voffB); PG8_STAGE(PG8_SA(1, 0), a3, voffA);
            PG8_WAIT_V(8); PG8_WAIT_L(0); PG8_BAR; PG8_MMA(1, 0, At, B0); PG8_MMA(1, 1, At, B1); PG8_BAR; PG8_SCHED;
            } else {
            PG8_LDB(B0, 0, 0); PG8_SCHED; PG8_LDA(At, 0, 0); PG8_STAGE(PG8_SA(1, 1), a1 + hstep, voffA);
            PG8_WAIT_L(8); PG8_BAR; PG8_WAIT_L(0); PG8_MMA(0, 0, At, B0); PG8_BAR; PG8_SCHED;
            PG8_LDB(B1, 0, 1); PG8_STAGE(PG8_SB(0, 0), b2, voffB);
            PG8_BAR; PG8_WAIT_L(0); PG8_MMA(0, 1, At, B1); PG8_BAR;
            PG8_LDA(At, 0, 1); PG8_STAGE(PG8_SA(0, 0), a2, voffA);
            PG8_BAR; PG8_WAIT_L(0); PG8_MMA(1, 0, At, B0); PG8_BAR; PG8_SCHED;
            PG8_STAGE(PG8_SB(0, 1), b2 + hstep, voffB);
            PG8_WAIT_V(6); PG8_BAR; PG8_MMA(1, 1, At, B1); PG8_BAR;
            PG8_LDB(B0, 1, 0); PG8_SCHED; PG8_LDA(At, 1, 0); PG8_STAGE(PG8_SA(0, 1), a2 + hstep, voffA);
            PG8_WAIT_L(8); PG8_BAR; PG8_WAIT_L(0); PG8_MMA(0, 0, At, B0); PG8_BAR; PG8_SCHED;
            PG8_LDB(B1, 1, 1); PG8_STAGE(PG8_SB(1, 0), b3, voffB);
            PG8_BAR; PG8_WAIT_L(0); PG8_MMA(0, 1, At, B1); PG8_BAR;
            PG8_LDA(At, 1, 1); PG8_STAGE(PG8_SA(1, 0), a3, voffA);
            PG8_BAR; PG8_WAIT_L(0); PG8_MMA(1, 0, At, B0); PG8_BAR; PG8_SCHED;
            PG8_STAGE(PG8_SB(1, 1), b3 + hstep, voffB);
            PG8_WAIT_V(6); PG8_BAR; PG8_MMA(1, 1, At, B1); PG8_BAR;
            }
        }
        if constexpr (ALIGN_EPI) { if (wr == 0) PG8_BAR; }
        if constexpr (!Epi::AFTER_DRAIN) { E(acc, cur, wr, wc, fr, fq); S.done(cur); }
        if (!has_next) break;
#pragma unroll
        for (int a = 0; a < 2; ++a)
#pragma unroll
            for (int b = 0; b < 2; ++b)
#pragma unroll
                for (int m = 0; m < 4; ++m)
#pragma unroll
                    for (int n = 0; n < 2; ++n) acc[a][b][m][n] = (f32x4){0.f, 0.f, 0.f, 0.f};
        cur = nxt; cA = nA; cB = nB; ++ui;
        if constexpr (ALIGN_EPI) { if (wr == 1) PG8_BAR; }
    }
    PG8_WAIT_V(0);
    if constexpr (!ALIGN_EPI) { if (wr == 0) PG8_BAR; }
    PG8_BAR;
    if constexpr (Epi::AFTER_DRAIN) { E.fused(acc, cur, wr, wc, fr, fq, lds, wid, lane); S.done(cur); }
#undef PG8_SA
#undef PG8_SB
#undef PG8_STAGE
#undef PG8_LDA
#undef PG8_LDB
#undef PG8_MMA
#undef PG8_WAIT_V
#undef PG8_WAIT_L
#undef PG8_BAR
#undef PG8_SCHED
}
}

namespace pg8 {
struct EpiResid {
    static constexpr bool PERM = false, AFTER_DRAIN = false;
    const float* base; float* out; int ldc; float alpha;
    __device__ __forceinline__ void operator()(const f32x4 (&acc)[2][2][4][2], const Unit& u, int wr, int wc, int fr, int fq) const {
        const int col0 = u.pn * BM + wc * 32 + 4 * fq;
#pragma unroll
        for (int ai = 0; ai < 2; ++ai)
#pragma unroll
            for (int m = 0; m < 4; ++m) { const int r = ai * HALF + wr * 64 + m * 16 + fr; const size_t off = (size_t)(u.pm * BM + r) * ldc + col0;
#pragma unroll
                for (int bj = 0; bj < 2; ++bj)
#pragma unroll
                    for (int n = 0; n < 2; ++n) { const f32x4 bs = *(const f32x4*)(base + off + bj * HALF + n * 16);
                        const f32x4 o = bs * alpha + acc[ai][bj][m][n]; *(f32x4*)(out + off + bj * HALF + n * 16) = o; }
                if (m & 1) asm volatile("" ::: "memory"); }
    }
};

struct EpiResLn {
    static constexpr bool PERM = false, AFTER_DRAIN = true;
    const float* base; float* out; bf16_t* xn; bf16_t* xl; const float* lg; const float* lb; unsigned long long* xbuf; unsigned* cnt; float alpha, eps;
    __device__ __forceinline__ void fused(f32x4 (&acc)[2][2][4][2], const Unit& u, int wr, int wc, int fr, int fq, PG8_LAS unsigned char* lds, int wid, int lane) const {
        typedef float f32x2v __attribute__((ext_vector_type(2))); typedef unsigned u32x2v __attribute__((ext_vector_type(2)));
        PG8_LAS f32x2v* P = (PG8_LAS f32x2v*)lds;
        PG8_LAS f32x2v* S = (PG8_LAS f32x2v*)(lds + 8192);
        const int col0 = u.pn * BM + wc * 32 + 4 * fq;
        const int tid_ = wid * 64 + lane; bf16_t* xl_t = xl + (size_t)(u.pm * 8 + u.pn) * 65536;
#pragma unroll
        for (int ai = 0; ai < 2; ++ai)
#pragma unroll
            for (int m = 0; m < 4; ++m) { const size_t off = (size_t)(u.pm * BM + ai * HALF + wr * 64 + m * 16 + fr) * 2048 + col0;
#pragma unroll
                for (int bj = 0; bj < 2; ++bj) { u32x4 lo16 = (u32x4){0u, 0u, 0u, 0u};
                    if (!base) lo16 = *(const u32x4*)(xl_t + ((size_t)(((ai * 4 + m) * 2 + bj) * 512 + tid_) * 8));
#pragma unroll
                    for (int n = 0; n < 2; ++n) { f32x4 bs;
                        if (base) bs = *(const f32x4*)(base + off + bj * HALF + n * 16);
                        else { const u32x2v h = *(const u32x2v*)(xn + off + bj * HALF + n * 16); const unsigned qx = n ? lo16.z : lo16.x, qy = n ? lo16.w : lo16.y;
                            bs[0] = __uint_as_float(h.x << 16) + __uint_as_float(qx << 16); bs[1] = __uint_as_float(h.x & 0xffff0000u) + __uint_as_float(qx & 0xffff0000u);
                            bs[2] = __uint_as_float(h.y << 16) + __uint_as_float(qy << 16); bs[3] = __uint_as_float(h.y & 0xffff0000u) + __uint_as_float(qy & 0xffff0000u); }
                        acc[ai][bj][m][n] = bs * alpha + acc[ai][bj][m][n]; } }
                asm volatile("" : "+v"(acc[ai][0][m][0]), "+v"(acc[ai][0][m][1]), "+v"(acc[ai][1][m][0]), "+v"(acc[ai][1][m][1]));
                if (m == 3) asm volatile("" ::: "memory"); }
#pragma unroll
        for (int ai = 0; ai < 2; ++ai)
#pragma unroll
            for (int m = 0; m < 4; ++m) {
                float s = 0.f;
#pragma unroll
                for (int bj = 0; bj < 2; ++bj)
#pragma unroll
                    for (int n = 0; n < 2; ++n) { const f32x4 x = acc[ai][bj][m][n]; s += (x[0] + x[1]) + (x[2] + x[3]); }
                s += __shfl_xor(s, 16); s += __shfl_xor(s, 32);
                const float mw = s * (1.0f / 64.0f); float q = 0.f;
#pragma unroll
                for (int bj = 0; bj < 2; ++bj)
#pragma unroll
                    for (int n = 0; n < 2; ++n) { const f32x4 d = acc[ai][bj][m][n] - mw; q += (d[0] * d[0] + d[1] * d[1]) + (d[2] * d[2] + d[3] * d[3]); }
                q += __shfl_xor(q, 16); q += __shfl_xor(q, 32);
                if (fq == 0) P[(ai * HALF + wr * 64 + m * 16 + fr) * 4 + wc] = (f32x2v){mw, q};
            }
        asm volatile("s_waitcnt lgkmcnt(0)" ::: "memory"); __builtin_amdgcn_s_barrier(); asm volatile("" ::: "memory");
        const int row = wid * 32 + (lane & 31);
        if (lane < 32) {
            const f32x2v a = P[row * 4 + 0], b = P[row * 4 + 1], c = P[row * 4 + 2], d = P[row * 4 + 3];
            const float mt = (a.x + b.x + c.x + d.x) * 0.25f;
            const float da = a.x - mt, db = b.x - mt, dc = c.x - mt, dd = d.x - mt;
            const float m2 = (a.y + b.y) + (c.y + d.y) + 64.0f * ((da * da + db * db) + (dc * dc + dd * dd));
            unsigned long long* slot = xbuf + ((size_t)(u.pm * BM + row) * 8 + u.pn);
            __hip_atomic_store(slot, ((unsigned long long)__float_as_uint(m2) << 32) | __float_as_uint(mt), __ATOMIC_RELAXED, __HIP_MEMORY_SCOPE_AGENT);
        }
        asm volatile("s_waitcnt vmcnt(0)" ::: "memory");
        if (lane == 0) __hip_atomic_fetch_add(cnt + 64 * u.pm, 1u, __ATOMIC_RELAXED, __HIP_MEMORY_SCOPE_AGENT);
        if (wid == 0) {
            unsigned sp = 0;
            while ((unsigned)__builtin_amdgcn_readfirstlane(__hip_atomic_load(cnt + 64 * u.pm, __ATOMIC_RELAXED, __HIP_MEMORY_SCOPE_AGENT)) < 64u) { __builtin_amdgcn_s_sleep(2); if (++sp > (1u << 22)) break; }
        }
        asm volatile("s_waitcnt vmcnt(0) lgkmcnt(0)" ::: "memory"); __builtin_amdgcn_s_barrier(); asm volatile("" ::: "memory");
        if (lane < 32) {
            const unsigned long long* slot = xbuf + (size_t)(u.pm * BM + row) * 8; float mt[8], m2[8]; float ms = 0.f;
#pragma unroll
            for (int t = 0; t < 8; ++t) { const unsigned long long w = __hip_atomic_load(slot + t, __ATOMIC_RELAXED, __HIP_MEMORY_SCOPE_AGENT); mt[t] = __uint_as_float((unsigned)w); m2[t] = __uint_as_float((unsigned)(w >> 32)); ms += mt[t]; }
            const float mean = ms * 0.125f; float q = 0.f;
#pragma unroll
            for (int t = 0; t < 8; ++t) { const float dm = mt[t] - mean; q += m2[t] + 256.0f * dm * dm; }
            S[row] = (f32x2v){mean, 1.0f / sqrtf(q * (1.0f / 2048.0f) + eps)};
        }
        asm volatile("s_waitcnt lgkmcnt(0)" ::: "memory"); __builtin_amdgcn_s_barrier(); asm volatile("" ::: "memory");
#pragma unroll
        for (int bj = 0; bj < 2; ++bj) { f32x4 gg[2], bb[2];
#pragma unroll
            for (int n = 0; n < 2; ++n) { gg[n] = *(const f32x4*)(lg + col0 + bj * HALF + n * 16); bb[n] = *(const f32x4*)(lb + col0 + bj * HALF + n * 16); }
#pragma unroll
            for (int ai = 0; ai < 2; ++ai)
#pragma unroll
                for (int m = 0; m < 4; ++m) { const int r = ai * HALF + wr * 64 + m * 16 + fr; const f32x2v sr = S[r]; u32x4 lo16;
#pragma unroll
                    for (int n = 0; n < 2; ++n) { const size_t off = (size_t)(u.pm * BM + r) * 2048 + col0 + bj * HALF + n * 16;
                        const f32x4 y = (acc[ai][bj][m][n] - sr.x) * sr.y * gg[n] + bb[n];
                        if (out) *(f32x4*)(out + off) = y;
                        else { u32x2v w; w.x = cvt_pk_bf16(y[0], y[1]); w.y = cvt_pk_bf16(y[2], y[3]); *(u32x2v*)(xn + off) = w;
                            const unsigned q0 = cvt_pk_bf16(y[0] - __uint_as_float(w.x << 16), y[1] - __uint_as_float(w.x & 0xffff0000u)), q1 = cvt_pk_bf16(y[2] - __uint_as_float(w.y << 16), y[3] - __uint_as_float(w.y & 0xffff0000u));
                            if (n == 0) { lo16.x = q0; lo16.y = q1; } else { lo16.z = q0; lo16.w = q1; } } }
                    if (!out) *(u32x4*)(xl_t + ((size_t)(((ai * 4 + m) * 2 + bj) * 512 + tid_) * 8)) = lo16; } }
    }
};
}

#define LAS __attribute__((address_space(3)))
#define GAS __attribute__((address_space(1)))
typedef unsigned short bf16_t;
typedef short bf16x8 __attribute__((ext_vector_type(8)));
typedef short bf16x4 __attribute__((ext_vector_type(4)));
typedef float f32x4 __attribute__((ext_vector_type(4)));
typedef unsigned u32x4 __attribute__((ext_vector_type(4)));
typedef unsigned u32x2 __attribute__((ext_vector_type(2)));

constexpr int SEQ = 8192, DM = 2048, DEPTH = 4, INW = 6672, NMEM = 256;
constexpr int NMAIN = 5376, NVT = 1536, NWT = NMAIN + NVT;
constexpr int C_AQ = 0, C_AK = 1024, C_AZ = 2048, C_BQ = 3072, C_BK = 3328, C_BZ = 3584, C_MQ = 4096, C_MZ = 4608, C_LR = 5120;
constexpr int NCH = SEQ / 64;
constexpr float LN_EPS = 1e-5f, RMS_EPS = 1e-6f;
constexpr float LOG2E = 1.4426950408889634f;
constexpr float ATT_SC = 0.08838834764831845f * LOG2E;
constexpr int LDS_BYTES = 147456;

constexpr size_t MiB = 1u << 20;
constexpr size_t WS_WIN = 0, WIN_L = (size_t)NWT * DM * 2;
constexpr size_t WS_WOUT = 112 * MiB, WOUT_L = (size_t)DM * DM * 2;
constexpr size_t WS_WMK = 144 * MiB, WS_WMV = 152 * MiB;
constexpr size_t WS_MEMB = 160 * MiB, WS_MK = 161 * MiB, WS_MVT = 162 * MiB;
constexpr size_t WS_XB = 164 * MiB, WS_XF = 196 * MiB, WS_HM = 260 * MiB, WS_Y = 368 * MiB;
constexpr int LDV = SEQ + 64;
constexpr size_t WS_U = 400 * MiB, WS_SP = 416 * MiB, WS_DCY = 424 * MiB, WS_CTL = 426 * MiB, CTL_BYTES = 65536, WS_XCH = 427 * MiB, WS_VT = 428 * MiB, WS_BG = 454 * MiB, WS_XL = 462 * MiB, WS_END = 494 * MiB;
constexpr int CW_CNT = 4096;
static_assert(WS_WIN + 4 * WIN_L <= WS_WOUT, "ws map");
static_assert(WS_HM + (size_t)SEQ * NMAIN * 2 <= WS_Y, "ws map");

struct Params {
    const float *x, *mem, *w_in, *rel, *gate_w, *gate_b, *norm_g, *w_mkv, *w_out, *ln_g, *ln_b;
    float* out; unsigned char* ws; int ph_lo, ph_hi;
};

typedef float f32x2_t __attribute__((ext_vector_type(2))); typedef __bf16 bf16x2_t __attribute__((ext_vector_type(2)));
__device__ __forceinline__ unsigned pk2(float lo, float hi) { const f32x2_t v = {lo, hi}; const bf16x2_t b = __builtin_convertvector(v, bf16x2_t); return __builtin_bit_cast(unsigned, b); }
__device__ __forceinline__ float bflo(unsigned w) { return __uint_as_float(w << 16); }
__device__ __forceinline__ float bfhi(unsigned w) { return __uint_as_float(w & 0xffff0000u); }
__device__ __forceinline__ float silu_f(float z) { return z / (1.0f + __expf(-z)); }
#define MFMA16(a, b, c) __builtin_amdgcn_mfma_f32_16x16x32_bf16((a), (b), (c), 0, 0, 0)

struct ConvItem { const GAS float* src; GAS bf16_t* dst; int ldw; bool ok; };
__device__ __forceinline__ void conv_load(const ConvItem& d, f32x4 (&v)[8]) {
#pragma unroll
    for (int i = 0; i < 8; ++i) v[i] = d.ok ? *(const GAS f32x4*)(d.src + (size_t)(8 * i) * d.ldw) : (f32x4){0.f, 0.f, 0.f, 0.f};
}
__device__ __forceinline__ void conv_store(const ConvItem& d, const f32x4 (&v)[8], LAS float* scr, int lane) {
    const int n4 = 4 * (lane & 7), kr = lane >> 3;
#pragma unroll
    for (int i = 0; i < 8; ++i) { LAS float* q = scr + (8 * i + kr) * 33 + n4; q[0] = v[i].x; q[1] = v[i].y; q[2] = v[i].z; q[3] = v[i].w; }
    asm volatile("s_waitcnt lgkmcnt(0)" ::: "memory");
    const int c = lane & 7;
#pragma unroll
    for (int j = 0; j < 4; ++j) { const int n = (lane >> 3) + 8 * j; const LAS float* s = scr + (8 * c) * 33 + n;
        u32x4 o; o.x = pk2(s[0 * 33], s[1 * 33]); o.y = pk2(s[2 * 33], s[3 * 33]); o.z = pk2(s[4 * 33], s[5 * 33]); o.w = pk2(s[6 * 33], s[7 * 33]);
        *(GAS u32x4*)(d.dst + (size_t)n * DM + 8 * c) = o; }
    asm volatile("s_waitcnt lgkmcnt(0)" ::: "memory");
}
__device__ __forceinline__ void in_seg(int drow, int& src_col, int& nvalid) {
    nvalid = 32;
    if (drow < 2048) src_col = drow;
    else if (drow < 3072) src_col = 3072 + (drow - 2048);
    else if (drow < 3328) src_col = 4096 + (drow - 3072);
    else if (drow < 3584) src_col = 4352 + (drow - 3328);
    else if (drow < 4096) src_col = 5120 + (drow - 3584);
    else if (drow < 4608) src_col = 5648 + (drow - 4096);
    else if (drow < 5120) src_col = 6160 + (drow - 4608);
    else if (drow < 5376) { src_col = 5632; nvalid = (drow == 5120) ? 16 : 0; }
    else if (drow < 6400) src_col = 2048 + (drow - 5376);
    else src_col = 4608 + (drow - 6400);
}
__device__ __forceinline__ ConvItem conv_decode(const Params& p, int l, int it, int lane) {
    constexpr int I_IN = 32 * (NWT / 32), I_OUT = 32 * (DM / 32);
    const int n4 = 4 * (lane & 7), kr = lane >> 3;
    ConvItem d; int r = it;
    if (r < I_IN) { const int g_ = r >> 5, nb = 8 * (g_ % 27) + (r & 7), k0 = 64 * (4 * (g_ / 27) + ((r >> 3) & 3)); int sc, nv; in_seg(32 * nb, sc, nv);
        d.ldw = INW; d.ok = n4 < nv; d.src = (const GAS float*)p.w_in + (size_t)l * DM * INW + (size_t)(k0 + kr) * INW + sc + n4;
        d.dst = (GAS bf16_t*)(p.ws + WS_WIN + l * WIN_L) + (size_t)(32 * nb) * DM + k0; return d; }
    r -= I_IN;
    if (r < I_OUT) { const int g_ = r >> 5, nb = 8 * (g_ % 8) + (r & 7), k0 = 64 * (4 * (g_ / 8) + ((r >> 3) & 3));
        d.ldw = DM; d.ok = true; d.src = (const GAS float*)p.w_out + (size_t)l * DM * DM + (size_t)(k0 + kr) * DM + 32 * nb + n4;
        d.dst = (GAS bf16_t*)(p.ws + WS_WOUT + l * WOUT_L) + (size_t)(32 * nb) * DM + k0; return d; }
    r -= I_OUT;
    { const int g_ = r >> 5, nb = 8 * (g_ % 4) + (r & 7), k0 = 64 * (4 * (g_ / 4) + ((r >> 3) & 3));
        d.ldw = 1024; d.ok = true; d.src = (const GAS float*)p.w_mkv + (size_t)l * DM * 1024 + (size_t)(k0 + kr) * 1024 + 32 * nb + n4;
        d.dst = (GAS bf16_t*)(p.ws + (nb < 16 ? WS_WMK : WS_WMV)) + (size_t)(l * 512 + 32 * (nb & 15)) * DM + k0; return d; }
}
__device__ __forceinline__ void convert_layer(const Params& p, int l, LAS unsigned char* lds, int wk, int nwk) {
    int tid_ = threadIdx.x; asm volatile("" : "+v"(tid_)); const int tid = tid_, lane = tid & 63, wave = tid >> 6;
    LAS float* scr = (LAS float*)(lds + wave * 8704);
    constexpr int I_L = 32 * (NWT / 32) + 32 * (DM / 32) + 32 * 32;
    if (wk >= I_L) return;
    ConvItem cur = conv_decode(p, l, wk, lane); f32x4 v[8]; conv_load(cur, v);
    for (int it = wk; it < I_L; it += nwk) {
        const int nx = it + nwk; ConvItem nxt = cur; f32x4 v2[8];
        if (nx < I_L) { nxt = conv_decode(p, l, nx, lane); conv_load(nxt, v2); }
        conv_store(cur, v, scr, lane);
        if (nx < I_L) { cur = nxt;
#pragma unroll
            for (int i = 0; i < 8; ++i) v[i] = v2[i]; }
    }
}
__device__ __forceinline__ void phase0(const Params& p, LAS unsigned char* lds) {
    int tid_ = threadIdx.x; asm volatile("" : "+v"(tid_)); const int tid = tid_, wave = tid >> 6;
    convert_layer(p, 0, lds, blockIdx.x * 8 + wave, gridDim.x * 8);
    const size_t gt = (size_t)blockIdx.x * 512 + tid, NT = (size_t)gridDim.x * 512;
    GAS bf16_t* xb = (GAS bf16_t*)(p.ws + WS_XB); const GAS f32x4* xs = (const GAS f32x4*)p.x;
    for (size_t i = gt; i < (size_t)SEQ * DM / 8; i += NT) { const f32x4 a = xs[2 * i], b = xs[2 * i + 1];
        u32x4 o; o.x = pk2(a.x, a.y); o.y = pk2(a.z, a.w); o.z = pk2(b.x, b.y); o.w = pk2(b.z, b.w); ((GAS u32x4*)xb)[i] = o; }
    GAS bf16_t* mb = (GAS bf16_t*)(p.ws + WS_MEMB); const GAS f32x4* ms = (const GAS f32x4*)p.mem;
    for (size_t i = gt; i < (size_t)NMEM * DM / 8; i += NT) { const f32x4 a = ms[2 * i], b = ms[2 * i + 1];
        u32x4 o; o.x = pk2(a.x, a.y); o.y = pk2(a.z, a.w); o.z = pk2(b.x, b.y); o.w = pk2(b.z, b.w); ((GAS u32x4*)mb)[i] = o; }
}

constexpr int A_KS = 0, A_KSZ = 64 * 272, A_VS = 2 * A_KSZ, A_VSZ = 128 * 144, A_BT = A_VS + 2 * A_VSZ;
template <bool BAND>
__device__ __forceinline__ void attn_step(LAS unsigned char* lds, int buf, int t, int cw, int w, int r16, int g, const bf16x8 (&qf)[4], f32x4 (&o)[8], float& m, float& l) {
    const LAS float* btab = (const LAS float*)(lds + A_BT);
    const LAS unsigned char* kb_ = lds + A_KS + buf * A_KSZ + r16 * 272 + g * 16;
    f32x4 s[4];
#pragma unroll
    for (int kb = 0; kb < 4; ++kb) { s[kb] = (f32x4){0.f, 0.f, 0.f, 0.f}; bf16x8 kfr[4];
#pragma unroll
        for (int ks = 0; ks < 4; ++ks) kfr[ks] = *(const LAS bf16x8*)(kb_ + kb * 16 * 272 + ks * 64);
#pragma unroll
        for (int ks = 0; ks < 4; ++ks) s[kb] = MFMA16(kfr[ks], qf[ks], s[kb]); }
    if (BAND) {
        const int delta = cw + 8 - t;
        if (delta >= 3) { const float bc = btab[256];
#pragma unroll
            for (int kb = 0; kb < 4; ++kb) s[kb] = s[kb] * ATT_SC + bc;
        } else { const int qi = 16 * (w & 3) + r16;
#pragma unroll
            for (int kb = 0; kb < 4; ++kb)
#pragma unroll
                for (int r = 0; r < 4; ++r) { int dist = 64 * delta + qi - (16 * kb + 4 * g + r); dist = dist > 128 ? 128 : (dist < -128 ? -128 : dist);
                    s[kb][r] = s[kb][r] * ATT_SC + btab[dist + 128]; }
        }
    } else {
#pragma unroll
        for (int kb = 0; kb < 4; ++kb) s[kb] = s[kb] * ATT_SC;
    }
    float mt = fmaxf(fmaxf(s[0][0], s[0][1]), fmaxf(s[0][2], s[0][3]));
#pragma unroll
    for (int kb = 1; kb < 4; ++kb) mt = fmaxf(mt, fmaxf(fmaxf(s[kb][0], s[kb][1]), fmaxf(s[kb][2], s[kb][3])));
    mt = fmaxf(mt, __shfl_xor(mt, 16)); mt = fmaxf(mt, __shfl_xor(mt, 32));
    const float mn = fmaxf(m, mt), alpha = __builtin_amdgcn_exp2f(m - mn); m = mn;
    float rs = 0.f;
#pragma unroll
    for (int kb = 0; kb < 4; ++kb)
#pragma unroll
        for (int r = 0; r < 4; ++r) { const float pv = __builtin_amdgcn_exp2f(s[kb][r] - mn); s[kb][r] = pv; rs += pv; }
    l = l * alpha + rs;
    if (__any(alpha != 1.0f)) {
#pragma unroll
        for (int i = 0; i < 8; ++i) o[i] = o[i] * alpha; }
    bf16x8 pb[2];
#pragma unroll
    for (int s2 = 0; s2 < 2; ++s2) { u32x4 pw; pw.x = pk2(s[2 * s2][0], s[2 * s2][1]); pw.y = pk2(s[2 * s2][2], s[2 * s2][3]);
        pw.z = pk2(s[2 * s2 + 1][0], s[2 * s2 + 1][1]); pw.w = pk2(s[2 * s2 + 1][2], s[2 * s2 + 1][3]); pb[s2] = __builtin_bit_cast(bf16x8, pw); }
    int voff_ = 0; asm volatile("" : "+v"(voff_), "+v"(pb[1]));
    const LAS unsigned char* vb_ = lds + A_VS + buf * A_VSZ + r16 * 144 + g * 8 + voff_;
    u32x2 vfr[2][4];
#pragma unroll
    for (int q = 0; q < 4; ++q) vfr[0][q] = *(const LAS u32x2*)(vb_ + (q >> 1) * 64 + (q & 1) * 32);
#pragma unroll
    for (int dvb = 0; dvb < 8; ++dvb) {
        if (dvb < 7) {
#pragma unroll
            for (int q = 0; q < 4; ++q) vfr[(dvb + 1) & 1][q] = *(const LAS u32x2*)(vb_ + (dvb + 1) * 16 * 144 + (q >> 1) * 64 + (q & 1) * 32); }
#pragma unroll
        for (int s2 = 0; s2 < 2; ++s2) { const u32x2 lo = vfr[dvb & 1][2 * s2], hi = vfr[dvb & 1][2 * s2 + 1];
            const u32x4 av = (u32x4){lo.x, lo.y, hi.x, hi.y}; o[dvb] = MFMA16(__builtin_bit_cast(bf16x8, av), pb[s2], o[dvb]); } }
}
template <bool BAND>
__device__ __forceinline__ void attn_unit(LAS unsigned char* lds, int q_row0, const bf16_t* Qh, int ldq, const bf16_t* Kh, int ldk, const bf16_t* Vth, int ldvt,
                                          const bf16_t* Zh, int ldz, bf16_t* Yh, int ldy, const float* bias_tab, int j2) {
    int tid_ = threadIdx.x; asm volatile("" : "+v"(tid_)); const int tid = tid_, lane = tid & 63, w = __builtin_amdgcn_readfirstlane(tid >> 6), r16 = lane & 15, g = lane >> 4;
    LAS float* btab = (LAS float*)(lds + A_BT);
    if (BAND) { for (int i = tid; i < 257; i += 512) btab[i] = ((const GAS float*)bias_tab)[i] * LOG2E; }
    const GAS bf16_t* qp = (const GAS bf16_t*)Qh + (size_t)(q_row0 + 16 * w + r16) * ldq + 8 * g;
    bf16x8 qf[4];
#pragma unroll
    for (int ks = 0; ks < 4; ++ks) qf[ks] = *(const GAS bf16x8*)(qp + 32 * ks);
    f32x4 o[8];
#pragma unroll
    for (int i = 0; i < 8; ++i) o[i] = (f32x4){0.f, 0.f, 0.f, 0.f};
    float m = -1e30f, l = 0.f;
    const int cw = BAND ? (w >> 2) : 0;
    const int nt = BAND ? 10 : 4;
    int t0 = 0; if (BAND) { t0 = 8 - 2 * j2; if (t0 < 0) t0 = 0; }
    u32x4 kA[2], vA[2], kB[2], vB[2];
#define A_GLOAD(kr, vr, t) do { const int key0_ = BAND ? 64 * (2 * j2 - 8 + (t)) : 64 * (t); \
        _Pragma("unroll") for (int i_ = 0; i_ < 2; ++i_) { const int id_ = tid + 512 * i_; \
            kr[i_] = *(const GAS u32x4*)((const GAS bf16_t*)Kh + (size_t)(key0_ + (id_ >> 4)) * ldk + (id_ & 15) * 8); \
            vr[i_] = *(const GAS u32x4*)((const GAS bf16_t*)Vth + (size_t)(id_ >> 3) * ldvt + key0_ + (id_ & 7) * 8); } } while (0)
#define A_LSTORE(kr, vr, buf) do { _Pragma("unroll") for (int i_ = 0; i_ < 2; ++i_) { const int id_ = tid + 512 * i_; \
            *(LAS u32x4*)(lds + A_KS + (buf) * A_KSZ + (id_ >> 4) * 272 + (id_ & 15) * 16) = kr[i_]; \
            *(LAS u32x4*)(lds + A_VS + (buf) * A_VSZ + (id_ >> 3) * 144 + (id_ & 7) * 16) = vr[i_]; } } while (0)
    A_GLOAD(kA, vA, t0); A_GLOAD(kB, vB, t0 + 1); A_LSTORE(kA, vA, 0); __syncthreads();
    for (int t = t0; t < nt; t += 2) {
        if (t + 2 < nt) A_GLOAD(kA, vA, t + 2);
        if (!BAND || (t >= cw && t <= cw + 8)) attn_step<BAND>(lds, 0, t, cw, w, r16, g, qf, o, m, l);
        A_LSTORE(kB, vB, 1);
        __syncthreads();
        if (t + 3 < nt) A_GLOAD(kB, vB, t + 3);
        if (!BAND || (t + 1 >= cw && t + 1 <= cw + 8)) attn_step<BAND>(lds, 1, t + 1, cw, w, r16, g, qf, o, m, l);
        if (t + 2 < nt) A_LSTORE(kA, vA, 0);
        __syncthreads();
    }
#undef A_GLOAD
#undef A_LSTORE
    l += __shfl_xor(l, 16); l += __shfl_xor(l, 32);
    const float inv = 1.0f / l;
    const size_t row = (size_t)(q_row0 + 16 * w + r16);
#pragma unroll
    for (int dvb = 0; dvb < 8; ++dvb) { const int col = 16 * dvb + 4 * g; const u32x2 z = *(const GAS u32x2*)((const GAS bf16_t*)Zh + row * ldz + col);
        const float y0 = o[dvb][0] * inv * silu_f(bflo(z.x)), y1 = o[dvb][1] * inv * silu_f(bfhi(z.x)), y2 = o[dvb][2] * inv * silu_f(bflo(z.y)), y3 = o[dvb][3] * inv * silu_f(bfhi(z.y));
        u32x2 yo; yo.x = pk2(y0, y1); yo.y = pk2(y2, y3); *(GAS u32x2*)((GAS bf16_t*)Yh + row * ldy + col) = yo; }
}


constexpr int P_HALF = 2 * A_KSZ + 2 * A_VSZ, P_BT = 2 * P_HALF;
static_assert(P_BT + 2 * 1028 <= LDS_BYTES - 64, "pair attention LDS map");
__device__ __forceinline__ void band_pair_step(LAS unsigned char* hl, const LAS float* btab, int buf, int t, int cw, int w4, int r16, int g,
                                               const bf16x8 (&qf)[2][4], f32x4 (&o)[2][8], float (&m)[2], f32x4 (&l)[2]) {
    const LAS unsigned char* kb_ = hl + buf * A_KSZ + r16 * 272 + g * 16;
    f32x4 s[2][4];
#pragma unroll
    for (int kb = 0; kb < 4; ++kb) { bf16x8 kfr[4];
#pragma unroll
        for (int ks = 0; ks < 4; ++ks) kfr[ks] = *(const LAS bf16x8*)(kb_ + kb * 16 * 272 + ks * 64);
#pragma unroll
        for (int rb = 0; rb < 2; ++rb) { s[rb][kb] = (f32x4){0.f, 0.f, 0.f, 0.f};
#pragma unroll
            for (int ks = 0; ks < 4; ++ks) s[rb][kb] = MFMA16(kfr[ks], qf[rb][ks], s[rb][kb]); } }
    const int delta = cw + 8 - t;
    bf16x8 pb[2][2];
    const bf16x8 ones = (bf16x8){16256, 16256, 16256, 16256, 16256, 16256, 16256, 16256};
#pragma unroll
    for (int rb = 0; rb < 2; ++rb) {
        float mn, alpha;
        if (delta >= 3) {
            const float bc = btab[256];
            float mt = fmaxf(fmaxf(s[rb][0][0], s[rb][0][1]), fmaxf(s[rb][0][2], s[rb][0][3]));
#pragma unroll
            for (int kb = 1; kb < 4; ++kb) mt = fmaxf(mt, fmaxf(fmaxf(s[rb][kb][0], s[rb][kb][1]), fmaxf(s[rb][kb][2], s[rb][kb][3])));
            mt = fmaxf(mt, __shfl_xor(mt, 16)); mt = fmaxf(mt, __shfl_xor(mt, 32));
            mn = fmaxf(m[rb], mt * ATT_SC + bc); alpha = __builtin_amdgcn_exp2f(m[rb] - mn); m[rb] = mn;
            const float off = bc - mn;
#pragma unroll
            for (int kb = 0; kb < 4; ++kb)
#pragma unroll
                for (int r = 0; r < 4; ++r) s[rb][kb][r] = __builtin_amdgcn_exp2f(s[rb][kb][r] * ATT_SC + off);
        } else { const int qi = 32 * (w4 & 1) + 16 * rb + r16;
#pragma unroll
            for (int kb = 0; kb < 4; ++kb)
#pragma unroll
                for (int r = 0; r < 4; ++r) { int dist = 64 * delta + qi - (16 * kb + 4 * g + r); dist = dist > 128 ? 128 : (dist < -128 ? -128 : dist);
                    s[rb][kb][r] = s[rb][kb][r] * ATT_SC + btab[dist + 128]; }
            float mt = fmaxf(fmaxf(s[rb][0][0], s[rb][0][1]), fmaxf(s[rb][0][2], s[rb][0][3]));
#pragma unroll
            for (int kb = 1; kb < 4; ++kb) mt = fmaxf(mt, fmaxf(fmaxf(s[rb][kb][0], s[rb][kb][1]), fmaxf(s[rb][kb][2], s[rb][kb][3])));
            mt = fmaxf(mt, __shfl_xor(mt, 16)); mt = fmaxf(mt, __shfl_xor(mt, 32));
            mn = fmaxf(m[rb], mt); alpha = __builtin_amdgcn_exp2f(m[rb] - mn); m[rb] = mn;
#pragma unroll
            for (int kb = 0; kb < 4; ++kb)
#pragma unroll
                for (int r = 0; r < 4; ++r) s[rb][kb][r] = __builtin_amdgcn_exp2f(s[rb][kb][r] - mn);
        }
        if (__any(alpha != 1.0f)) { l[rb] = l[rb] * alpha;
#pragma unroll
            for (int i = 0; i < 8; ++i) o[rb][i] = o[rb][i] * alpha; }
#pragma unroll
        for (int s2 = 0; s2 < 2; ++s2) { u32x4 pw; pw.x = pk2(s[rb][2 * s2][0], s[rb][2 * s2][1]); pw.y = pk2(s[rb][2 * s2][2], s[rb][2 * s2][3]);
            pw.z = pk2(s[rb][2 * s2 + 1][0], s[rb][2 * s2 + 1][1]); pw.w = pk2(s[rb][2 * s2 + 1][2], s[rb][2 * s2 + 1][3]); pb[rb][s2] = __builtin_bit_cast(bf16x8, pw);
            l[rb] = MFMA16(ones, pb[rb][s2], l[rb]); }
    }
    int voff_ = 0; asm volatile("" : "+v"(voff_), "+v"(pb[1][1]));
    const LAS unsigned char* vb_ = hl + 2 * A_KSZ + buf * A_VSZ + r16 * 144 + g * 8 + voff_;
#pragma unroll
    for (int dvb = 0; dvb < 8; ++dvb) { u32x2 vfr[4];
#pragma unroll
        for (int q = 0; q < 4; ++q) vfr[q] = *(const LAS u32x2*)(vb_ + dvb * 16 * 144 + (q >> 1) * 64 + (q & 1) * 32);
#pragma unroll
        for (int s2 = 0; s2 < 2; ++s2) { const u32x4 av = (u32x4){vfr[2 * s2].x, vfr[2 * s2].y, vfr[2 * s2 + 1].x, vfr[2 * s2 + 1].y};
#pragma unroll
            for (int rb = 0; rb < 2; ++rb) o[rb][dvb] = MFMA16(__builtin_bit_cast(bf16x8, av), pb[rb][s2], o[rb][dvb]); } }
}
__device__ __forceinline__ void band_pair_unit(LAS unsigned char* lds, const Params& p, int l, int j2, int hA) {
    int tid_ = threadIdx.x; asm volatile("" : "+v"(tid_)); const int tid = tid_, lane = tid & 63, w = __builtin_amdgcn_readfirstlane(tid >> 6), r16 = lane & 15, g = lane >> 4;
    const int half = w >> 2, w4 = w & 3, th = tid & 255, head = hA + half;
    LAS unsigned char* hl = lds + half * P_HALF;
    LAS float* btab = (LAS float*)(lds + P_BT + half * 1028);
    { const GAS float* bt = (const GAS float*)p.rel + (l * 8 + head) * 257; for (int i = th; i < 257; i += 256) btab[i] = bt[i] * LOG2E; }
    const GAS bf16_t* hm = (const GAS bf16_t*)(p.ws + WS_HM);
    const GAS bf16_t* Kh = hm + C_AK + head * 128; const GAS bf16_t* Vth = (const GAS bf16_t*)(p.ws + WS_VT) + (size_t)(head * 128) * LDV;
    const int row0 = 128 * j2 + 32 * w4 + r16;
    bf16x8 qf[2][4];
#pragma unroll
    for (int rb = 0; rb < 2; ++rb)
#pragma unroll
        for (int ks = 0; ks < 4; ++ks) qf[rb][ks] = *(const GAS bf16x8*)(hm + (size_t)(row0 + 16 * rb) * NMAIN + C_AQ + head * 128 + 32 * ks + 8 * g);
    f32x4 o[2][8];
#pragma unroll
    for (int rb = 0; rb < 2; ++rb)
#pragma unroll
        for (int i = 0; i < 8; ++i) o[rb][i] = (f32x4){0.f, 0.f, 0.f, 0.f};
    float m[2] = {-1e30f, -1e30f}; f32x4 l_[2] = {(f32x4){0.f, 0.f, 0.f, 0.f}, (f32x4){0.f, 0.f, 0.f, 0.f}};
    const int cw = w4 >> 1, nt = 10;
    int t0 = 8 - 2 * j2; if (t0 < 0) t0 = 0;
    u32x4 kr[4], vr[4];
#define P_GLOAD(t) do { const int key0_ = 64 * (2 * j2 - 8 + (t)); \
        _Pragma("unroll") for (int i_ = 0; i_ < 4; ++i_) { const int id_ = th + 256 * i_; \
            kr[i_] = *(const GAS u32x4*)(Kh + (size_t)(key0_ + (id_ >> 4)) * NMAIN + (id_ & 15) * 8); \
            vr[i_] = *(const GAS u32x4*)(Vth + (size_t)(id_ >> 3) * LDV + key0_ + (id_ & 7) * 8); } } while (0)
#define P_LSTORE(buf) do { _Pragma("unroll") for (int i_ = 0; i_ < 4; ++i_) { const int id_ = th + 256 * i_; \
            *(LAS u32x4*)(hl + (buf) * A_KSZ + (id_ >> 4) * 272 + (id_ & 15) * 16) = kr[i_]; \
            *(LAS u32x4*)(hl + 2 * A_KSZ + (buf) * A_VSZ + (id_ >> 3) * 144 + (id_ & 7) * 16) = vr[i_]; } } while (0)
    P_GLOAD(t0); P_LSTORE(0); __syncthreads();
    for (int t = t0; t < nt; ++t) {
        const int buf = (t - t0) & 1;
        if (t + 1 < nt) P_GLOAD(t + 1);
        if (t >= cw && t <= cw + 8) band_pair_step(hl, btab, buf, t, cw, w4, r16, g, qf, o, m, l_);
        if (t + 1 < nt) P_LSTORE(buf ^ 1);
        __syncthreads();
    }
#undef P_GLOAD
#undef P_LSTORE
    GAS bf16_t* Y = (GAS bf16_t*)(p.ws + WS_Y);
#pragma unroll
    for (int rb = 0; rb < 2; ++rb) { const float inv = 1.0f / l_[rb][0]; const size_t row = (size_t)(row0 + 16 * rb);
#pragma unroll
        for (int dvb = 0; dvb < 8; ++dvb) { const int col = 16 * dvb + 4 * g; const u32x2 z = *(const GAS u32x2*)(hm + row * NMAIN + C_AZ + head * 128 + col);
            const float y0 = o[rb][dvb][0] * inv * silu_f(bflo(z.x)), y1 = o[rb][dvb][1] * inv * silu_f(bfhi(z.x)), y2 = o[rb][dvb][2] * inv * silu_f(bflo(z.y)), y3 = o[rb][dvb][3] * inv * silu_f(bfhi(z.y));
            u32x2 yo; yo.x = pk2(y0, y1); yo.y = pk2(y2, y3); *(GAS u32x2*)(Y + row * DM + head * 128 + col) = yo; } }
}

constexpr int G_LR = 0, G_GW = 4096, G_GB = 8192, G_SEG = 8448, G_B = 10496, G_SSQ = 27136, G_QP = 27648, G_QM = 36864, G_KP = 46080, G_KM = 55296,
              G_KD = 64512, G_AT = 73728, G_VT = 82944, G_ST = 101376;
__device__ __forceinline__ void gla_compute_b(LAS unsigned char* lds, const bf16_t* hm_rows, const float* gw_l, const float* gb_l, int hb) {
    int tid_ = threadIdx.x; asm volatile("" : "+v"(tid_)); const int tid = tid_;
    LAS float* LR = (LAS float*)(lds + G_LR); LAS float* GW = (LAS float*)(lds + G_GW); LAS float* GB = (LAS float*)(lds + G_GB);
    LAS float* SEG = (LAS float*)(lds + G_SEG); LAS float* Bm = (LAS float*)(lds + G_B);
    if (tid < 128) { const int row = tid >> 1, half = tid & 1; const u32x4 v = *(const GAS u32x4*)((const GAS bf16_t*)hm_rows + (size_t)row * NMAIN + C_LR + 8 * half);
        LAS float* d = LR + row * 16 + 8 * half; d[0] = bflo(v.x); d[1] = bfhi(v.x); d[2] = bflo(v.y); d[3] = bfhi(v.y); d[4] = bflo(v.z); d[5] = bfhi(v.z); d[6] = bflo(v.w); d[7] = bfhi(v.w); }
    for (int i = tid; i < 1024; i += 512) GW[i] = ((const GAS float*)gw_l)[(i >> 6) * 256 + hb * 64 + (i & 63)];
    if (tid < 64) GB[tid] = ((const GAS float*)gb_l)[hb * 64 + tid];
    __syncthreads();
    const int d = tid & 63, tseg = tid >> 6;
    float gwr[16];
#pragma unroll
    for (int r = 0; r < 16; ++r) gwr[r] = GW[r * 64 + d];
    const float gbv = GB[d];
    float loc[8]; float run = 0.f;
#pragma unroll
    for (int tt = 0; tt < 8; ++tt) { const int t = 8 * tseg + tt; float x = gbv;
#pragma unroll
        for (int r = 0; r < 16; ++r) x += LR[t * 16 + r] * gwr[r];
        const float lg = (fminf(x, 0.f) - __logf(1.0f + __expf(-fabsf(x)))) * 0.0625f;
        run += lg; loc[tt] = run; }
    SEG[tseg * 64 + d] = run;
    __syncthreads();
    float off = 0.f;
#pragma unroll
    for (int s = 0; s < 8; ++s) { const float v = SEG[s * 64 + d]; off += (s < tseg) ? v : 0.f; }
#pragma unroll
    for (int tt = 0; tt < 8; ++tt) Bm[(8 * tseg + tt) * 65 + d] = off + loc[tt];
    __syncthreads();
}
__device__ __forceinline__ void gla_load_vt(LAS unsigned char* lds, const bf16_t* VTg, int hb, int c) {
    int tid_ = threadIdx.x; asm volatile("" : "+v"(tid_)); const int tid = tid_;
#pragma unroll
    for (int i = 0; i < 2; ++i) { const int id = tid + 512 * i, row = id >> 3, c8 = id & 7;
        *(LAS u32x4*)(lds + G_VT + row * 144 + c8 * 16) = *(const GAS u32x4*)((const GAS bf16_t*)VTg + (size_t)(1024 + hb * 128 + row) * LDV + 64 * c + 8 * c8); }
}
__device__ __forceinline__ void gla_part1(LAS unsigned char* lds, const Params& p, int l, int c, int hb) {
    int tid_ = threadIdx.x; asm volatile("" : "+v"(tid_)); const int tid = tid_, lane = tid & 63, w = __builtin_amdgcn_readfirstlane(tid >> 6), r16 = lane & 15, g = lane >> 4;
    const bf16_t* hm_rows = (const bf16_t*)(p.ws + WS_HM) + (size_t)(64 * c) * NMAIN;
    gla_compute_b(lds, hm_rows, p.gate_w + l * 16 * 256, p.gate_b + l * 256, hb);
    const LAS float* Bm = (const LAS float*)(lds + G_B);
    { GAS float* BG = (GAS float*)(p.ws + WS_BG) + (size_t)(64 * c) * 256 + hb * 64;
        const int t = tid >> 3, dc = tid & 7; f32x4 b0, b1;
        b0.x = Bm[t * 65 + 8 * dc + 0]; b0.y = Bm[t * 65 + 8 * dc + 1]; b0.z = Bm[t * 65 + 8 * dc + 2]; b0.w = Bm[t * 65 + 8 * dc + 3];
        b1.x = Bm[t * 65 + 8 * dc + 4]; b1.y = Bm[t * 65 + 8 * dc + 5]; b1.z = Bm[t * 65 + 8 * dc + 6]; b1.w = Bm[t * 65 + 8 * dc + 7];
        *(GAS f32x4*)(BG + (size_t)t * 256 + 8 * dc) = b0; *(GAS f32x4*)(BG + (size_t)t * 256 + 8 * dc + 4) = b1; }
    { const int t = tid >> 3, dc = tid & 7; const u32x4 kv = *(const GAS u32x4*)((const GAS bf16_t*)hm_rows + (size_t)t * NMAIN + C_BK + hb * 64 + 8 * dc);
        float kf[8] = {bflo(kv.x), bfhi(kv.x), bflo(kv.y), bfhi(kv.y), bflo(kv.z), bfhi(kv.z), bflo(kv.w), bfhi(kv.w)};
        LAS bf16_t* KD = (LAS bf16_t*)(lds + G_KD);
#pragma unroll
        for (int e = 0; e < 8; ++e) { const int d = 8 * dc + e; const float val = kf[e] * __expf(Bm[63 * 65 + d] - Bm[t * 65 + d]); KD[d * 72 + t] = (bf16_t)(pk2(val, 0.f) & 0xffffu); } }
    gla_load_vt(lds, (const bf16_t*)(p.ws + WS_VT), hb, c);
    if (tid < 64) ((GAS float*)(p.ws + WS_DCY))[(c * 4 + hb) * 64 + tid] = __expf(Bm[63 * 65 + tid]);
    __syncthreads();
    GAS bf16_t* U = (GAS bf16_t*)(p.ws + WS_U) + (size_t)(c * 4 + hb) * 8192;
    const LAS unsigned char* Ap = lds + G_VT + (16 * w + r16) * 144 + g * 16;
#pragma unroll
    for (int dkb = 0; dkb < 4; ++dkb) { const LAS unsigned char* Bp = lds + G_KD + (16 * dkb + r16) * 144 + g * 16; f32x4 acc = (f32x4){0.f, 0.f, 0.f, 0.f};
#pragma unroll
        for (int ks = 0; ks < 2; ++ks) acc = MFMA16(*(const LAS bf16x8*)(Bp + ks * 64), *(const LAS bf16x8*)(Ap + ks * 64), acc);
        u32x2 ub; ub.x = pk2(acc[0], acc[1]); ub.y = pk2(acc[2], acc[3]); *(GAS u32x2*)(U + (16 * w + r16) * 64 + 16 * dkb + 4 * g) = ub; }
    __syncthreads();
}
__device__ __forceinline__ void gla_scan(const Params& p, LAS unsigned char* lds) {
    int tid_ = threadIdx.x; asm volatile("" : "+v"(tid_)); const int tid = tid_, seg = tid >> 7, el = tid & 127;
    LAS float* CE = (LAS float*)lds;
    for (int eg = blockIdx.x; eg < 256; eg += gridDim.x) {
        const int e = eg * 128 + el, hb = e >> 13, rem = e & 8191, dk = rem & 63;
        const GAS bf16_t* U = (const GAS bf16_t*)(p.ws + WS_U) + (size_t)hb * 8192 + rem + (size_t)(seg * 32) * 32768;
        const GAS float* dcy = (const GAS float*)(p.ws + WS_DCY) + hb * 64 + dk + (seg * 32) * 256;
        GAS bf16_t* Sp = (GAS bf16_t*)(p.ws + WS_SP) + (size_t)hb * 8192 + rem + (size_t)(seg * 32) * 32768;
        float uv[32], dv[32];
#pragma unroll
        for (int j = 0; j < 32; ++j) { uv[j] = __uint_as_float(((unsigned)U[(size_t)j * 32768]) << 16); dv[j] = dcy[j * 256]; }
        float s = 0.f, pd = 1.f;
#pragma unroll
        for (int j = 0; j < 32; ++j) { const float u = uv[j], d = dv[j]; uv[j] = s; dv[j] = pd; s = d * s + u; pd *= d; }
        CE[seg * 128 + el] = s; CE[512 + seg * 128 + el] = pd;
        __syncthreads();
        float st = 0.f;
#pragma unroll
        for (int q = 0; q < 3; ++q) { const float se = CE[q * 128 + el], pe = CE[512 + q * 128 + el]; st = (q < seg) ? pe * st + se : st; }
#pragma unroll
        for (int j = 0; j < 32; ++j) Sp[(size_t)j * 32768] = (bf16_t)(pk2(uv[j] + dv[j] * st, 0.f) & 0xffffu);
        __syncthreads();
    }
}
struct Gla2Regs { u32x4 qv, kv; f32x4 b0, b1; u32x4 vt[2], st[2]; u32x2 zpre[4]; f32x4 gpre[4]; };
__device__ __forceinline__ void gla_part2_load(Gla2Regs& R, const Params& p, int l, int c, int hb, int tid, int w, int r16, int g) {
    const GAS bf16_t* hm_rows = (const GAS bf16_t*)(p.ws + WS_HM) + (size_t)(64 * c) * NMAIN;
    const int t = tid >> 3, dc = tid & 7;
    R.qv = *(const GAS u32x4*)(hm_rows + (size_t)t * NMAIN + C_BQ + hb * 64 + 8 * dc); R.kv = *(const GAS u32x4*)(hm_rows + (size_t)t * NMAIN + C_BK + hb * 64 + 8 * dc);
    const GAS float* BG = (const GAS float*)(p.ws + WS_BG) + (size_t)(64 * c + t) * 256 + hb * 64 + 8 * dc;
    R.b0 = *(const GAS f32x4*)BG; R.b1 = *(const GAS f32x4*)(BG + 4);
    const GAS bf16_t* VTg = (const GAS bf16_t*)(p.ws + WS_VT); const GAS bf16_t* Sp = (const GAS bf16_t*)(p.ws + WS_SP) + (size_t)(c * 4 + hb) * 8192;
#pragma unroll
    for (int i = 0; i < 2; ++i) { const int id = tid + 512 * i, row = id >> 3, c8 = id & 7;
        R.vt[i] = *(const GAS u32x4*)(VTg + (size_t)(1024 + hb * 128 + row) * LDV + 64 * c + 8 * c8); R.st[i] = *(const GAS u32x4*)(Sp + row * 64 + 8 * c8); }
    const int i_ = 16 * (w & 3) + r16;
#pragma unroll
    for (int q4 = 0; q4 < 4; ++q4) { const int dv0 = 16 * (4 * (w >> 2) + q4) + 4 * g;
        R.zpre[q4] = *(const GAS u32x2*)(hm_rows + (size_t)i_ * NMAIN + C_BZ + hb * 128 + dv0); R.gpre[q4] = *(const GAS f32x4*)((const GAS float*)p.norm_g + l * 128 + dv0); }
}
__device__ __forceinline__ void gla_part2(LAS unsigned char* lds, const Params& p, int l, int c, int hb, const Gla2Regs& R, int tid, int w, int r16, int g) {
    const bf16_t* hm_rows = (const bf16_t*)(p.ws + WS_HM) + (size_t)(64 * c) * NMAIN;
    u32x2 zpre[4]; f32x4 gpre[4];
#pragma unroll
    for (int q4 = 0; q4 < 4; ++q4) { zpre[q4] = R.zpre[q4]; gpre[q4] = R.gpre[q4]; }
    {
        const int t = tid >> 3, dc = tid & 7;
        const u32x4 qv = R.qv, kv = R.kv; const f32x4 b0 = R.b0, b1 = R.b1;
        u32x4 vt[2] = {R.vt[0], R.vt[1]}, st[2] = {R.st[0], R.st[1]};
        float qf[8] = {bflo(qv.x), bfhi(qv.x), bflo(qv.y), bfhi(qv.y), bflo(qv.z), bfhi(qv.z), bflo(qv.w), bfhi(qv.w)};
        float kf[8] = {bflo(kv.x), bfhi(kv.x), bflo(kv.y), bfhi(kv.y), bflo(kv.z), bfhi(kv.z), bflo(kv.w), bfhi(kv.w)};
        float bb[8] = {b0.x, b0.y, b0.z, b0.w, b1.x, b1.y, b1.z, b1.w};
        float qpv[8], qmv[8], kpv[8], kmv[8];
#pragma unroll
        for (int e = 0; e < 8; ++e) { const float ep = __expf(bb[e]), em = __expf(-bb[e]), q8 = qf[e] * 0.125f;
            qpv[e] = q8 * ep; qmv[e] = q8 * em; kpv[e] = kf[e] * ep; kmv[e] = kf[e] * em; }
        const int o = t * 144 + dc * 16;
        *(LAS u32x4*)(lds + G_QP + o) = (u32x4){pk2(qpv[0], qpv[1]), pk2(qpv[2], qpv[3]), pk2(qpv[4], qpv[5]), pk2(qpv[6], qpv[7])};
        *(LAS u32x4*)(lds + G_QM + o) = (u32x4){pk2(qmv[0], qmv[1]), pk2(qmv[2], qmv[3]), pk2(qmv[4], qmv[5]), pk2(qmv[6], qmv[7])};
        *(LAS u32x4*)(lds + G_KP + o) = (u32x4){pk2(kpv[0], kpv[1]), pk2(kpv[2], kpv[3]), pk2(kpv[4], kpv[5]), pk2(kpv[6], kpv[7])};
        *(LAS u32x4*)(lds + G_KM + o) = (u32x4){pk2(kmv[0], kmv[1]), pk2(kmv[2], kmv[3]), pk2(kmv[4], kmv[5]), pk2(kmv[6], kmv[7])};
#pragma unroll
        for (int i = 0; i < 2; ++i) { const int id = tid + 512 * i, row = id >> 3, c8 = id & 7;
            *(LAS u32x4*)(lds + G_VT + row * 144 + c8 * 16) = vt[i]; *(LAS u32x4*)(lds + G_ST + row * 144 + c8 * 16) = st[i]; }
    }
    __syncthreads();
    { const int ib = w >> 1; LAS bf16_t* AT = (LAS bf16_t*)(lds + G_AT);
        const LAS unsigned char* qpA = lds + G_QP + (16 * ib + r16) * 144 + g * 16; const LAS unsigned char* qmA = lds + G_QM + (16 * ib + r16) * 144 + g * 16;
#pragma unroll
        for (int jj = 0; jj < 2; ++jj) { const int jb = 2 * (w & 1) + jj;
            const LAS unsigned char* kmB = lds + G_KM + (16 * jb + r16) * 144 + g * 16; const LAS unsigned char* kpB = lds + G_KP + (16 * jb + r16) * 144 + g * 16;
            f32x4 lo = (f32x4){0.f, 0.f, 0.f, 0.f}, hi = lo;
#pragma unroll
            for (int ks = 0; ks < 2; ++ks) { lo = MFMA16(*(const LAS bf16x8*)(qpA + ks * 64), *(const LAS bf16x8*)(kmB + ks * 64), lo);
                hi = MFMA16(*(const LAS bf16x8*)(qmA + ks * 64), *(const LAS bf16x8*)(kpB + ks * 64), hi); }
#pragma unroll
            for (int r = 0; r < 4; ++r) { const int i = 16 * ib + 4 * g + r, j = 16 * jb + r16; const float v = (j <= i) ? lo[r] : hi[r]; AT[i * 72 + j] = (bf16_t)(pk2(v, 0.f) & 0xffffu); } } }
    __syncthreads();
    const int ib = w & 3, dvh = w >> 2;
    f32x4 oacc[4];
    { const LAS unsigned char* atA = lds + G_AT + (16 * ib + r16) * 144 + g * 16; const LAS unsigned char* qpA = lds + G_QP + (16 * ib + r16) * 144 + g * 16;
#pragma unroll
        for (int q4 = 0; q4 < 4; ++q4) { const int dvb = 4 * dvh + q4;
            const LAS unsigned char* vtB = lds + G_VT + (16 * dvb + r16) * 144 + g * 16; const LAS unsigned char* stB = lds + G_ST + (16 * dvb + r16) * 144 + g * 16;
            f32x4 acc = (f32x4){0.f, 0.f, 0.f, 0.f};
#pragma unroll
            for (int ks = 0; ks < 2; ++ks) { acc = MFMA16(*(const LAS bf16x8*)(vtB + ks * 64), *(const LAS bf16x8*)(atA + ks * 64), acc);
                acc = MFMA16(*(const LAS bf16x8*)(stB + ks * 64), *(const LAS bf16x8*)(qpA + ks * 64), acc); }
            oacc[q4] = acc; } }
    LAS float* SSQ = (LAS float*)(lds + G_SSQ);
    { float pr = 0.f;
#pragma unroll
        for (int q4 = 0; q4 < 4; ++q4) pr += (oacc[q4][0] * oacc[q4][0] + oacc[q4][1] * oacc[q4][1]) + (oacc[q4][2] * oacc[q4][2] + oacc[q4][3] * oacc[q4][3]);
        pr += __shfl_xor(pr, 16); pr += __shfl_xor(pr, 32);
        if (g == 0) SSQ[dvh * 64 + 16 * ib + r16] = pr; }
    __syncthreads();
    { const int i = 16 * ib + r16; const float rinv = rsqrtf((SSQ[i] + SSQ[64 + i]) * (1.0f / 128.0f) + RMS_EPS);
        GAS bf16_t* Yr = (GAS bf16_t*)(p.ws + WS_Y) + (size_t)(64 * c + i) * DM + 1024 + hb * 128;
#pragma unroll
        for (int q4 = 0; q4 < 4; ++q4) { const int dv0 = 16 * (4 * dvh + q4) + 4 * g; const u32x2 z = zpre[q4]; const f32x4 gg = gpre[q4];
            const float y0 = oacc[q4][0] * rinv * gg.x * silu_f(bflo(z.x)), y1 = oacc[q4][1] * rinv * gg.y * silu_f(bfhi(z.x)), y2 = oacc[q4][2] * rinv * gg.z * silu_f(bflo(z.y)), y3 = oacc[q4][3] * rinv * gg.w * silu_f(bfhi(z.y));
            u32x2 yo; yo.x = pk2(y0, y1); yo.y = pk2(y2, y3); *(GAS u32x2*)(Yr + dv0) = yo; } }
    __syncthreads();
}

__device__ __forceinline__ void ln_phase(const Params& p, int l, const float* tin, float* fout) {
    int tid_ = threadIdx.x; asm volatile("" : "+v"(tid_)); const int tid = tid_, lane = tid & 63, wave = tid >> 6;
    const int gw = blockIdx.x * 8 + wave, NGW = gridDim.x * 8;
    const float* lg = p.ln_g + l * DM; const float* lb = p.ln_b + l * DM; bf16_t* xb = (bf16_t*)(p.ws + WS_XB);
    for (int row = gw; row < SEQ; row += NGW) {
        const f32x4* xr = (const f32x4*)(tin + (size_t)row * DM) + lane;
        f32x4 v[8]; float s = 0.f;
#pragma unroll
        for (int j = 0; j < 8; ++j) { v[j] = xr[64 * j]; s += (v[j].x + v[j].y) + (v[j].z + v[j].w); }
#pragma unroll
        for (int o = 1; o < 64; o <<= 1) s += __shfl_xor(s, o);
        const float mean = s * (1.0f / DM); float s2 = 0.f;
#pragma unroll
        for (int j = 0; j < 8; ++j) { v[j] = v[j] - mean; s2 += (v[j].x * v[j].x + v[j].y * v[j].y) + (v[j].z * v[j].z + v[j].w * v[j].w); }
#pragma unroll
        for (int o = 1; o < 64; o <<= 1) s2 += __shfl_xor(s2, o);
        const float rstd = rsqrtf(s2 * (1.0f / DM) + LN_EPS);
        f32x4* orow = (f32x4*)(fout + (size_t)row * DM) + lane; u32x2* brow = (u32x2*)(xb + (size_t)row * DM) + lane;
#pragma unroll
        for (int j = 0; j < 8; ++j) { const f32x4 gg = ((const f32x4*)lg)[lane + 64 * j], bb = ((const f32x4*)lb)[lane + 64 * j];
            const f32x4 y = v[j] * rstd * gg + bb; orow[64 * j] = y; u32x2 o2; o2.x = pk2(y.x, y.y); o2.y = pk2(y.z, y.w); brow[64 * j] = o2; }
    }
}

#define XB_TMO      128
#define XB_XCNT(j)  (256  + 64 * (j))
#define XB_XSUB(j)  (1280 + 64 * (j))
#define XB_XGEN(j)  (2304 + 64 * (j))
#define XB_TOP      3328
#define XB_TOPGEN   3392
#define XCD_BAR_WORDS 3456
#define XB_SPIN_CAP (1u << 18)

__device__ __forceinline__ unsigned xb_ld(unsigned* p)              { return __hip_atomic_load(p, __ATOMIC_RELAXED, __HIP_MEMORY_SCOPE_AGENT); }
__device__ __forceinline__ unsigned xb_add(unsigned* p, unsigned v) { return __hip_atomic_fetch_add(p, v, __ATOMIC_RELAXED, __HIP_MEMORY_SCOPE_AGENT); }
__device__ __forceinline__ unsigned xb_xcc_id() { return (unsigned)__builtin_amdgcn_s_getreg((3 << 11) | 20) & 0xFu; }
#define XB_SPIN(cond, bar) do { unsigned _sp = 0; while (cond) { __builtin_amdgcn_s_sleep(1); \
    if ((++_sp & 255u) == 0u) { if (xb_ld(&(bar)[XB_TMO])) break; if (_sp > XB_SPIN_CAP) { atomicAdd(&(bar)[XB_TMO], 1u); break; } } } } while (0)

struct XcdBarrier {
    unsigned* bar; unsigned x;
    volatile LAS unsigned* st;
};

__device__ __forceinline__ XcdBarrier xcd_barrier_post(unsigned* bar, volatile LAS unsigned* st) {
    XcdBarrier b; b.bar = bar; b.x = xb_xcc_id(); b.st = st;
    if (threadIdx.x == 0) (void)xb_add(&bar[XB_XCNT(b.x)], 1u);
    return b;
}
__device__ __forceinline__ void xcd_barrier_complete(unsigned* bar, unsigned x, unsigned& nloc, unsigned& nx) {
    const unsigned G = gridDim.x * gridDim.y * gridDim.z;
    unsigned sum, cnt, mine, sp = 0u;
    for (;;) {
        sum = 0u; cnt = 0u; mine = 0u;
#pragma unroll
        for (unsigned j = 0; j < 16; ++j) { const unsigned c = xb_ld(&bar[XB_XCNT(j)]); sum += c; cnt += (c > 0u) ? 1u : 0u; mine = (j == x) ? c : mine; }
        if (sum == G) break;
        __builtin_amdgcn_s_sleep(1);
        if ((++sp & 255u) == 0u) { if (xb_ld(&bar[XB_TMO])) break; if (sp > XB_SPIN_CAP) { atomicAdd(&bar[XB_TMO], 1u); break; } }
    }
    nloc = mine > 0u ? mine : 1u; nx = cnt > 0u ? cnt : 1u;
}

__device__ __forceinline__ void xcd_barrier(const XcdBarrier& b) {
    asm volatile("s_waitcnt vmcnt(0)" ::: "memory");
    __syncthreads();
    if (threadIdx.x == 0) {
        unsigned* bar = b.bar;
        __builtin_amdgcn_s_waitcnt(0);
        unsigned nloc = b.st[0], nx = b.st[1];
        if (nloc == 0u) { xcd_barrier_complete(bar, b.x, nloc, nx); b.st[0] = nloc; b.st[1] = nx; }
        const unsigned old = xb_add(&bar[XB_XSUB(b.x)], 1u);
        const unsigned gen = old / nloc;
        if (old + 1u == (gen + 1u) * nloc) {
            __builtin_amdgcn_fence(__ATOMIC_RELEASE, "agent");
            asm volatile("s_waitcnt vmcnt(0)" ::: "memory");
            const unsigned og = xb_add(&bar[XB_TOP], 1u);
            const unsigned tg = og / nx;
            if (og + 1u == (tg + 1u) * nx) xb_add(&bar[XB_TOPGEN], 1u);
            else XB_SPIN(xb_ld(&bar[XB_TOPGEN]) == tg, bar);
            __builtin_amdgcn_fence(__ATOMIC_ACQUIRE, "agent");
            xb_add(&bar[XB_XGEN(b.x)], 1u);
            asm volatile("s_waitcnt vmcnt(0)" ::: "memory");
        } else {
            XB_SPIN(xb_ld(&bar[XB_XGEN(b.x)]) == gen, bar);
            __builtin_amdgcn_fence(__ATOMIC_ACQUIRE, "agent");
            asm volatile("s_waitcnt vmcnt(0)" ::: "memory");
        }
    }
    __syncthreads();
}

constexpr int NPH = 1 + 6 * DEPTH;
__global__ void __launch_bounds__(512, 2) mega(Params p_in) {
    extern __shared__ __attribute__((aligned(16))) unsigned char lds_raw[];
    LAS unsigned char* lds = (LAS unsigned char*)lds_raw;
    cg::grid_group grid = cg::this_grid();
    const int bid = blockIdx.x, G = gridDim.x;
    volatile LAS unsigned* misc = (volatile LAS unsigned*)(lds + LDS_BYTES - 64);
    if (threadIdx.x < 16) misc[threadIdx.x] = 0u;
    __syncthreads();
    const XcdBarrier bar = xcd_barrier_post((unsigned*)(p_in.ws + WS_CTL), misc);
    if (p_in.ph_hi - p_in.ph_lo > 1) grid.sync();
    const Params& p0 = p_in;
    for (int ph = p0.ph_lo; ph < p0.ph_hi; ++ph) {
        Params p = p0; asm volatile("" : "+s"(p.ws));
        bf16_t* xb = (bf16_t*)(p.ws + WS_XB); float* xf = (float*)(p.ws + WS_XF);
        bf16_t* hm = (bf16_t*)(p.ws + WS_HM); bf16_t* VT = (bf16_t*)(p.ws + WS_VT); bf16_t* Y = (bf16_t*)(p.ws + WS_Y);
        if (ph == 0) phase0(p, lds);
        else {
            const int l = (ph - 1) / 6, k = (ph - 1) % 6;
            const bf16_t* win = (const bf16_t*)(p.ws + WS_WIN + l * WIN_L);
            if (k == 0) {
                for (int gi = 0; gi < 4; ++gi) {
                    pg8::Gemm g; bf16_t* O; int ldc, c;
                    if (gi == 0) { g.A = xb; g.Bt = win; g.M = SEQ; g.N = NMAIN; O = hm; ldc = NMAIN; c = bid; }
                    else if (gi == 1) { g.A = win + (size_t)NMAIN * DM; g.Bt = xb; g.M = NVT; g.N = SEQ; O = VT; ldc = LDV; c = G - 1 - bid; }
                    else if (gi == 2) { g.A = (const bf16_t*)(p.ws + WS_MEMB); g.Bt = (const bf16_t*)(p.ws + WS_WMK) + (size_t)l * 512 * DM; g.M = NMEM; g.N = 512; O = (bf16_t*)(p.ws + WS_MK) + l * 512; ldc = 2048;
                        c = (bid >= G - 16 && bid < G - 14) ? bid - (G - 16) : (1 << 24); }
                    else { g.A = (const bf16_t*)(p.ws + WS_WMV) + (size_t)l * 512 * DM; g.Bt = (const bf16_t*)(p.ws + WS_MEMB); g.M = 512; g.N = NMEM; O = (bf16_t*)(p.ws + WS_MVT) + (size_t)l * 512 * NMEM; ldc = NMEM;
                        c = (bid >= G - 14 && bid < G - 12) ? bid - (G - 14) : (1 << 24); }
                    g.K = DM;
                    pg8::StaticOrder S; S.init(g.M, g.N, G, c);
                    pg8::EpiBf16<0> E{O, ldc, nullptr, 0, 0, 1.f};
                    pg8::gemm_phase<pg8::EpiBf16<0>, pg8::StaticOrder, true, true>(lds, g, S, E);
                }
                if (l + 1 < DEPTH) {
                    int wkb = bid, nwb = G;
                    if (G == 256) { nwb = 144; wkb = bid < 64 ? bid : (bid >= 160 && bid < 240 ? bid - 96 : -1); }
                    if (wkb >= 0) { int t2_ = threadIdx.x; asm volatile("" : "+v"(t2_)); convert_layer(p, l + 1, lds, wkb * 8 + (t2_ >> 6), nwb * 8); }
                }
            } else if (k == 1) {
                for (int u = bid; u < 256; u += G) band_pair_unit(lds, p, l, u >> 2, 2 * (u & 3));
                for (int u = bid; u < 256; u += G) { const int head = u & 3, qb = u >> 2;
                    attn_unit<false>(lds, 128 * qb, hm + C_MQ + head * 128, NMAIN, (const bf16_t*)(p.ws + WS_MK) + l * 512 + head * 128, 2048,
                                     (const bf16_t*)(p.ws + WS_MVT) + (size_t)(l * 512 + head * 128) * NMEM, NMEM, hm + C_MZ + head * 128, NMAIN, Y + 1536 + head * 128, DM, nullptr, 0); }
                for (int u = bid; u < 512; u += G) gla_part1(lds, p, l, u >> 2, u & 3);
            } else if (k == 2) gla_scan(p, lds);
            else if (k == 3) {
                int t3_ = threadIdx.x; asm volatile("" : "+v"(t3_)); const int tid3 = t3_, w3 = __builtin_amdgcn_readfirstlane(tid3 >> 6), r3 = tid3 & 15, g3 = (tid3 & 63) >> 4;
                if (G == 256) {
                    Gla2Regs RA, RB; const int u = bid, u2 = bid + 256;
                    gla_part2_load(RA, p, l, u >> 2, u & 3, tid3, w3, r3, g3);
                    gla_part2_load(RB, p, l, u2 >> 2, u2 & 3, tid3, w3, r3, g3);
                    gla_part2(lds, p, l, u >> 2, u & 3, RA, tid3, w3, r3, g3);
                    gla_part2(lds, p, l, u2 >> 2, u2 & 3, RB, tid3, w3, r3, g3);
                } else {
                    for (int u = bid; u < 512; u += G) { Gla2Regs RA; gla_part2_load(RA, p, l, u >> 2, u & 3, tid3, w3, r3, g3); gla_part2(lds, p, l, u >> 2, u & 3, RA, tid3, w3, r3, g3); }
                }
            }
            else if (k == 4) {
                pg8::Gemm g; g.A = Y; g.Bt = (const bf16_t*)(p.ws + WS_WOUT + l * WOUT_L); g.M = SEQ; g.N = DM; g.K = DM;
                pg8::StaticOrder S; S.init(SEQ, DM, G, bid);
                if (G == 256) {
                    pg8::EpiResLn E{l == 0 ? p.x : (const float*)nullptr, l == DEPTH - 1 ? p.out : (float*)nullptr, xb, (bf16_t*)(p.ws + WS_XL), p.ln_g + l * DM, p.ln_b + l * DM, (unsigned long long*)(p.ws + WS_XCH),
                                    (unsigned*)(p.ws + WS_CTL) + CW_CNT + l * 2048, 1.6817928305074292f, LN_EPS};
                    pg8::gemm_phase<pg8::EpiResLn, pg8::StaticOrder, false, true>(lds, g, S, E);
                } else {
                    pg8::EpiResid E{l == 0 ? p.x : xf, xf, DM, 1.6817928305074292f};
                    pg8::gemm_phase<pg8::EpiResid, pg8::StaticOrder, true, true>(lds, g, S, E);
                }
            } else if (G != 256) ln_phase(p, l, xf, l == DEPTH - 1 ? p.out : xf);
        }
        if (ph + 1 < p0.ph_hi && !(G == 256 && ph > 0 && (ph - 1) % 6 == 4)) xcd_barrier(bar);
    }
}

extern "C" void kernel_launch(void* const* d_in, const int* in_sizes, int n_in, void* d_out, int out_size, void* d_ws, size_t ws_size, hipStream_t stream) {
    static int grid = 0;
    if (grid == 0) {
        if (n_in != 11 || ws_size < WS_END) { fprintf(stderr, "kernel_launch: unexpected inputs (n_in %d, ws %zu)\n", n_in, ws_size); grid = -1; return; }
        int dev = 0, cus = 0, per_cu = 0;
        hipGetDevice(&dev); hipDeviceGetAttribute(&cus, hipDeviceAttributeMultiprocessorCount, dev);
        hipFuncSetAttribute((const void*)mega, hipFuncAttributeMaxDynamicSharedMemorySize, LDS_BYTES);
        hipOccupancyMaxActiveBlocksPerMultiprocessor(&per_cu, (const void*)mega, 512, LDS_BYTES);
        if (per_cu < 1) per_cu = 1;
        (void)hipGetLastError();
        grid = cus * per_cu;
    }
    if (grid < 0) return;
    Params p{};
    p.x = (const float*)d_in[0]; p.mem = (const float*)d_in[1]; p.w_in = (const float*)d_in[2]; p.rel = (const float*)d_in[3]; p.gate_w = (const float*)d_in[4];
    p.gate_b = (const float*)d_in[5]; p.norm_g = (const float*)d_in[6]; p.w_mkv = (const float*)d_in[7]; p.w_out = (const float*)d_in[8]; p.ln_g = (const float*)d_in[9]; p.ln_b = (const float*)d_in[10];
    p.out = (float*)d_out; p.ws = (unsigned char*)d_ws;
    if (hipMemsetAsync((char*)d_ws + WS_CTL, 0, CTL_BYTES, stream) != hipSuccess) { fprintf(stderr, "memset failed\n"); return; }
#if defined(MK_MULTI)
    for (int ph = 0; ph < NPH; ++ph) { p.ph_lo = ph; p.ph_hi = ph + 1; hipLaunchKernelGGL(mega, dim3(grid), dim3(512), LDS_BYTES, stream, p); }
#else
    p.ph_lo = 0; p.ph_hi = NPH;
    void* args[] = {&p};
    hipError_t e = hipLaunchCooperativeKernel((const void*)mega, dim3(grid), dim3(512), args, LDS_BYTES, stream);
    if (e != hipSuccess) fprintf(stderr, "cooperative launch failed: %s (grid %d)\n", hipGetErrorString(e), grid);
#endif
}
```

```cpp
#include <hip/hip_runtime.h>
#include <hip/hip_cooperative_groups.h>
#include <cstdio>
#include <cstdint>
namespace cg = cooperative_groups;
namespace pg8 {
#define PG8_LAS __attribute__((address_space(3)))
typedef unsigned short bf16_t;
typedef short bf16x8 __attribute__((ext_vector_type(8)));
typedef float f32x4 __attribute__((ext_vector_type(4)));
typedef unsigned u32x4 __attribute__((ext_vector_type(4)));
constexpr int BM = 256, BK = 64, HALF = 128, HTB = HALF * BK * 2  , STAGE_BYTES = 8 * HTB, NXCD = 8, WGM = 8;

__host__ __device__ __forceinline__ int lds_byte(int r, int c) { const int st = (r >> 4) * 2 + (c >> 5), rr = r & 15, cc = c & 31, ob = rr * 64 + cc * 2; return st * 1024 + (ob ^ (((ob >> 9) & 1) << 5)); }
__host__ __device__ __forceinline__ void stage_rc(int b, int& R, int& C) { const int st = b / 1024, sb = b % 1024, swz = sb ^ (((sb >> 9) & 1) << 5); R = (st >> 1) * 16 + swz / 64; C = (st & 1) * 32 + (swz % 64) / 2; }
__host__ __device__ __forceinline__ int perm32(int rho) { const int n = rho >> 4, i = rho & 15; return 8 * (i >> 2) + 4 * n + (i & 3); }

struct Unit { int pm, pn; };
struct Gemm { const bf16_t* A; const bf16_t* Bt; int M, N, K; };

struct StaticOrder {
    int nM, nN, nwg, G, c;
    __host__ __device__ void init(int M, int N, int G_, int c_) { nM = M / BM; nN = N / BM; nwg = nM * nN; G = G_; c = c_; }
    __host__ __device__ bool next(int i, Unit& u) const {
        const long L = (long)i * G + c; if (L >= nwg) return false;
        int wgid = (int)L; { const int q = nwg / NXCD, r = nwg % NXCD, xcd = wgid % NXCD, off = wgid / NXCD; wgid = (xcd < r ? xcd * (q + 1) : r * (q + 1) + (xcd - r) * q) + off; }
        const int nig = WGM * nN, gid = wgid / nig, fm = gid * WGM, gsz = (nM - fm) < WGM ? (nM - fm) : WGM;
        u.pm = fm + ((wgid % nig) % gsz); u.pn = (wgid % nig) / gsz; return true;
    }
    __device__ __forceinline__ void a_ready(const Unit&) const {}
    __device__ __forceinline__ void done(const Unit&) const {}
};

__device__ __forceinline__ unsigned cvt_pk_bf16(float lo, float hi) { unsigned r; asm volatile("v_cvt_pk_bf16_f32 %0, %1, %2" : "=v"(r) : "v"(lo), "v"(hi)); return r; }
typedef float f32x2 __attribute__((ext_vector_type(2)));
__device__ __forceinline__ f32x2 gelu_pk(f32x2 v) {
    const f32x2 av = __builtin_elementwise_abs(v), d = av * 0.2316418882f + 1.0f;
    f32x2 t; t.x = __builtin_amdgcn_rcpf(d.x); t.y = __builtin_amdgcn_rcpf(d.y);
    f32x2 q = t * 0.5307027145f + (-0.7265760135f); q = q * t + 0.7107068705f; q = q * t + (-0.142248368f); q = q * t + 0.127414796f; q = q * t;
    const f32x2 s = (v * v) * (-0.72134752044f);
    f32x2 e; e.x = __builtin_amdgcn_exp2f(s.x); e.y = __builtin_amdgcn_exp2f(s.y);
    const f32x2 m = v * (q * e), r = v - m;
    f32x2 o; o.x = v.x < 0.f ? m.x : r.x; o.y = v.y < 0.f ? m.y : r.y; return o;
}

template <int ACT  > struct EpiBf16 {
    static constexpr bool PERM = true, AFTER_DRAIN = false; static_assert(ACT == 0 || ACT == 1, "EpiBf16: ACT is 0 (none) or 1 (gelu_pk)");
    bf16_t* O; int ldc; const float* bias; int split_cols; size_t split_stride; float scale0;
    __device__ __forceinline__ void operator()(const f32x4 (&acc)[2][2][4][2], const Unit& u, int wr, int wc, int fr, int fq) const {
        const int row0 = u.pm * BM + wr * 64 + fr; int colt = u.pn * BM; bf16_t* base = O;
        float sc = 1.f; if (split_cols) { const int t = colt / split_cols; base += (size_t)t * split_stride; colt -= t * split_cols; if (t == 0) sc = scale0; }
        const int col0 = colt + wc * 32 + 8 * fq, bcol0 = u.pn * BM + wc * 32 + 8 * fq;
        f32x4 bv[2][2];
#pragma unroll
        for (int bj = 0; bj < 2; ++bj)
#pragma unroll
            for (int n = 0; n < 2; ++n) bv[bj][n] = bias ? *(const f32x4*)(bias + bcol0 + bj * HALF + 4 * n) : (f32x4){0.f, 0.f, 0.f, 0.f};
#pragma unroll
        for (int ai = 0; ai < 2; ++ai)
#pragma unroll
            for (int m = 0; m < 4; ++m) { bf16_t* rowp = base + (size_t)(row0 + ai * HALF + m * 16) * ldc + col0;
#pragma unroll
                for (int bj = 0; bj < 2; ++bj) { f32x4 v0 = acc[ai][bj][m][0] + bv[bj][0], v1 = acc[ai][bj][m][1] + bv[bj][1];
                    if (ACT == 1) { f32x2 a = gelu_pk((f32x2){v0[0], v0[1]}), b = gelu_pk((f32x2){v0[2], v0[3]}), c = gelu_pk((f32x2){v1[0], v1[1]}), d = gelu_pk((f32x2){v1[2], v1[3]});
                        v0 = (f32x4){a.x, a.y, b.x, b.y}; v1 = (f32x4){c.x, c.y, d.x, d.y}; }
                    v0 = v0 * sc; v1 = v1 * sc; u32x4 w; w.x = cvt_pk_bf16(v0[0], v0[1]); w.y = cvt_pk_bf16(v0[2], v0[3]); w.z = cvt_pk_bf16(v1[0], v1[1]); w.w = cvt_pk_bf16(v1[2], v1[3]);
                    *(u32x4*)(rowp + bj * HALF) = w; } }
    }
};
template <class Epi, class Sched, bool ALIGN_EPI = false, bool SP2 = false>
__device__ __forceinline__ void gemm_phase(PG8_LAS unsigned char* lds, const Gemm g, const Sched& S, const Epi& E) {
    int tid_ = threadIdx.x; asm volatile("" : "+v"(tid_)); const int tid = tid_, wid = __builtin_amdgcn_readfirstlane(tid >> 6), lane = tid & 63, wr = wid >> 2, wc = wid & 3, fr = lane & 15, fq = lane >> 4;
    const int K = g.K, nt = K / BK;
    unsigned voffA[2], voffB[2];
#pragma unroll
    for (int i = 0; i < 2; ++i) { int R, C; stage_rc(tid * 16 + i * 8192, R, C); const int Rb = Epi::PERM ? ((R & ~31) + perm32(R & 31)) : R;
        voffA[i] = (unsigned)(R * K + C) * 2u; voffB[i] = (unsigned)(Rb * K + C) * 2u; }
    const size_t kstep = (size_t)(BK * 2);
    const size_t hstep = (size_t)HALF * K * 2;
    const size_t tstep = 2 * hstep;
    const unsigned ldsw = (unsigned)wid * 1024u;
    const int aoff = lds_byte(wr * 64 + fr, fq * 8), boff = lds_byte(wc * 32 + fr, fq * 8);
#define PG8_SA(b, h) (((b) * 2 + (h)) * HTB)
#define PG8_SB(b, h) ((4 + (b) * 2 + (h)) * HTB)
#define PG8_STAGE(bufoff, gbase, voff) do { _Pragma("unroll") for (int _i = 0; _i < 2; ++_i) \
        __builtin_amdgcn_global_load_lds((const unsigned*)((const char*)(gbase) + (voff)[_i]), (PG8_LAS unsigned*)(lds + (bufoff) + ldsw + _i * 8192), 16, 0, 0); } while (0)
#define PG8_LDA(dst, b, h) do { _Pragma("unroll") for (int m = 0; m < 4; ++m) _Pragma("unroll") for (int k = 0; k < 2; ++k) dst[m][k] = *(const PG8_LAS bf16x8*)(lds + PG8_SA(b, h) + aoff + m * 2048 + k * 1024); } while (0)
#define PG8_LDB(dst, b, h) do { _Pragma("unroll") for (int n = 0; n < 2; ++n) _Pragma("unroll") for (int k = 0; k < 2; ++k) dst[n][k] = *(const PG8_LAS bf16x8*)(lds + PG8_SB(b, h) + boff + n * 2048 + k * 1024); } while (0)
#define PG8_MMA(ai, bj, At, Bt) do { __builtin_amdgcn_s_setprio(1); _Pragma("unroll") for (int m = 0; m < 4; ++m) _Pragma("unroll") for (int n = 0; n < 2; ++n) _Pragma("unroll") for (int k = 0; k < 2; ++k) \
        acc[ai][bj][m][n] = __builtin_amdgcn_mfma_f32_16x16x32_bf16(Bt[n][k], At[m][k], acc[ai][bj][m][n], 0, 0, 0); __builtin_amdgcn_s_setprio(0); } while (0)
#define PG8_WAIT_V(n) asm volatile("s_waitcnt vmcnt(" #n ")" ::: "memory")
#define PG8_WAIT_L(n) asm volatile("s_waitcnt lgkmcnt(" #n ")" ::: "memory")
#define PG8_BAR __builtin_amdgcn_s_barrier()
#define PG8_SCHED __builtin_amdgcn_sched_barrier(0)
    Unit cur, nxt; int ui = 0;
    if (!S.next(0, cur)) return;
    f32x4 acc[2][2][4][2];
#pragma unroll
    for (int a = 0; a < 2; ++a)
#pragma unroll
        for (int b = 0; b < 2; ++b)
#pragma unroll
            for (int m = 0; m < 4; ++m)
#pragma unroll
                for (int n = 0; n < 2; ++n) acc[a][b][m][n] = (f32x4){0.f, 0.f, 0.f, 0.f};
    bf16x8 At[4][2], B0[2][2], B1[2][2];
    const char* cA = (const char*)g.A + (size_t)cur.pm * tstep; const char* cB = (const char*)g.Bt + (size_t)cur.pn * tstep;
    S.a_ready(cur);
    if constexpr (SP2) {
        PG8_STAGE(PG8_SB(0, 0), cB, voffB); PG8_STAGE(PG8_SB(0, 1), cB + hstep, voffB); PG8_STAGE(PG8_SA(0, 0), cA, voffA); PG8_STAGE(PG8_SA(0, 1), cA + hstep, voffA);
        if (wr == 1) PG8_BAR;
        PG8_WAIT_V(2); PG8_BAR;
        PG8_STAGE(PG8_SB(1, 0), cB + kstep, voffB); PG8_STAGE(PG8_SA(1, 0), cA + kstep, voffA); PG8_STAGE(PG8_SB(1, 1), cB + hstep + kstep, voffB);
        PG8_WAIT_V(6); PG8_BAR;
    } else {
        PG8_STAGE(PG8_SB(0, 0), cB, voffB); PG8_STAGE(PG8_SA(0, 0), cA, voffA); PG8_STAGE(PG8_SB(0, 1), cB + hstep, voffB); PG8_STAGE(PG8_SA(0, 1), cA + hstep, voffA);
        if (wr == 1) PG8_BAR;
        PG8_WAIT_V(4); PG8_BAR;
        PG8_STAGE(PG8_SB(1, 0), cB + kstep, voffB); PG8_STAGE(PG8_SA(1, 0), cA + kstep, voffA); PG8_STAGE(PG8_SB(1, 1), cB + hstep + kstep, voffB);
        PG8_WAIT_V(6); PG8_BAR;
    }
    for (;;) {
        const bool has_next = S.next(ui + 1, nxt);
        const char* nA = has_next ? (const char*)g.A + (size_t)nxt.pm * tstep : cA; const char* nB = has_next ? (const char*)g.Bt + (size_t)nxt.pn * tstep : cB;
        for (int t = 0; t < nt; t += 2) {
            const bool last = (t == nt - 2);
            const char* a1 = cA + (size_t)(t + 1) * kstep;
            const char* a2 = last ? nA : cA + (size_t)(t + 2) * kstep; const char* b2 = last ? nB : cB + (size_t)(t + 2) * kstep;
            const char* a3 = a2 + kstep; const char* b3 = b2 + kstep;
            if (last && has_next) S.a_ready(nxt);
            if constexpr (SP2) {
            PG8_LDB(B0, 0, 0); PG8_LDB(B1, 0, 1); PG8_SCHED; PG8_LDA(At, 0, 0); PG8_STAGE(PG8_SA(1, 1), a1 + hstep, voffA);
            PG8_WAIT_V(8); PG8_WAIT_L(0); PG8_BAR; PG8_MMA(0, 0, At, B0); PG8_MMA(0, 1, At, B1); PG8_BAR; PG8_SCHED;
            PG8_LDA(At, 0, 1); PG8_STAGE(PG8_SB(0, 0), b2, voffB); PG8_STAGE(PG8_SB(0, 1), b2 + hstep, voffB); PG8_STAGE(PG8_SA(0, 0), a2, voffA);
            PG8_WAIT_V(8); PG8_WAIT_L(0); PG8_BAR; PG8_MMA(1, 0, At, B0); PG8_MMA(1, 1, At, B1); PG8_BAR; PG8_SCHED;
            PG8_LDB(B0, 1, 0); PG8_LDB(B1, 1, 1); PG8_SCHED; PG8_LDA(At, 1, 0); PG8_STAGE(PG8_SA(0, 1), a2 + hstep, voffA);
            PG8_WAIT_V(8); PG8_WAIT_L(0); PG8_BAR; PG8_MMA(0, 0, At, B0); PG8_MMA(0, 1, At, B1); PG8_BAR; PG8_SCHED;
            PG8_LDA(At, 1, 1); PG8_STAGE(PG8_SB(1, 0), b3, voffB); PG8_STAGE(PG8_SB(1, 1), b3 + hstep, voffB); PG8_STAGE(PG8_SA(1, 0), a3, voffA);
            PG8_WAIT_V(8); PG8_WAIT_L(0); PG8_BAR; PG8_MMA(1, 0, At, B0); PG8_MMA(1, 1, At, B1); PG8_BAR; PG8_SCHED;
            } else {
            PG8_LDB(B0, 0, 0); PG8_SCHED; PG8_LDA(At, 0, 0); PG8_STAGE(PG8_SA(1, 1), a1 + hstep, voffA);
            PG8_WAIT_L(8); PG8_BAR; PG8_WAIT_L(0); PG8_MMA(0, 0, At, B0); PG8_BAR; PG8_SCHED;
            PG8_LDB(B1, 0, 1); PG8_STAGE(PG8_SB(0, 0), b2, voffB);
            PG8_BAR; PG8_WAIT_L(0); PG8_MMA(0, 1, At, B1); PG8_BAR;
            PG8_LDA(At, 0, 1); PG8_STAGE(PG8_SA(0, 0), a2, voffA);
            PG8_BAR; PG8_WAIT_L(0); PG8_MMA(1, 0, At, B0); PG8_BAR; PG8_SCHED;
            PG8_STAGE(PG8_SB(0, 1), b2 + hstep, voffB);
            PG8_WAIT_V(6); PG8_BAR; PG8_MMA(1, 1, At, B1); PG8_BAR;
            PG8_LDB(B0, 1, 0); PG8_SCHED; PG8_LDA(At, 1, 0); PG8_STAGE(PG8_SA(0, 1), a2 + hstep, voffA);
            PG8_WAIT_L(8); PG8_BAR; PG8_WAIT_L(0); PG8_MMA(0, 0, At, B0); PG8_BAR; PG8_SCHED;
            PG8_LDB(B1, 1, 1); PG8_STAGE(PG8_SB(1, 0), b3, voffB);
            PG8_BAR; PG8_WAIT_L(0); PG8_MMA(0, 1, At, B1); PG8_BAR;
            PG8_LDA(At, 1, 1); PG8_STAGE(PG8_SA(1, 0), a3, voffA);
            PG8_BAR; PG8_WAIT_L(0); PG8_MMA(1, 0, At, B0); PG8_BAR; PG8_SCHED;
            PG8_STAGE(PG8_SB(1, 1), b3 + hstep, voffB);
            PG8_WAIT_V(6); PG8_BAR; PG8_MMA(1, 1, At, B1); PG8_BAR;
            }
        }
        if constexpr (ALIGN_EPI) { if (wr == 0) PG8_BAR; }
        if constexpr (!Epi::AFTER_DRAIN) { E(acc, cur, wr, wc, fr, fq); S.done(cur); }
        if (!has_next) break;
#pragma unroll
        for (int a = 0; a < 2; ++a)
#pragma unroll
            for (int b = 0; b < 2; ++b)
#pragma unroll
                for (int m = 0; m < 4; ++m)
#pragma unroll
                    for (int n = 0; n < 2; ++n) acc[a][b][m][n] = (f32x4){0.f, 0.f, 0.f, 0.f};
        cur = nxt; cA = nA; cB = nB; ++ui;
        if constexpr (ALIGN_EPI) { if (wr == 1) PG8_BAR; }
    }
    PG8_WAIT_V(0);
    if constexpr (!ALIGN_EPI) { if (wr == 0) PG8_BAR; }
    PG8_BAR;
    if constexpr (Epi::AFTER_DRAIN) { E.fused(acc, cur, wr, wc, fr, fq, lds, wid, lane); S.done(cur); }
#undef PG8_SA
#undef PG8_SB
#undef PG8_STAGE
#undef PG8_LDA
#undef PG8_LDB
#undef PG8_MMA
#undef PG8_WAIT_V
#undef PG8_WAIT_L
#undef PG8_BAR
#undef PG8_SCHED
}
}

namespace pg8 {
struct EpiResid {
    static constexpr bool PERM = false, AFTER_DRAIN = false;
    const float* base; float* out; int ldc; float alpha;
    __device__ __forceinline__ void operator()(const f32x4 (&acc)[2][2][4][2], const Unit& u, int wr, int wc, int fr, int fq) const {
        const int col0 = u.pn * BM + wc * 32 + 4 * fq;
#pragma unroll
        for (int ai = 0; ai < 2; ++ai)
#pragma unroll
            for (int m = 0; m < 4; ++m) { const int r = ai * HALF + wr * 64 + m * 16 + fr; const size_t off = (size_t)(u.pm * BM + r) * ldc + col0;
#pragma unroll
                for (int bj = 0; bj < 2; ++bj)
#pragma unroll
                    for (int n = 0; n < 2; ++n) { const f32x4 bs = *(const f32x4*)(base + off + bj * HALF + n * 16);
                        const f32x4 o = bs * alpha + acc[ai][bj][m][n]; *(f32x4*)(out + off + bj * HALF + n * 16) = o; }
                if (m & 1) asm volatile("" ::: "memory"); }
    }
};

struct EpiResLn {
    static constexpr bool PERM = false, AFTER_DRAIN = true;
    const float* base; float* out; bf16_t* xn; bf16_t* xl; const float* lg; const float* lb; unsigned long long* xbuf; unsigned* cnt; float alpha, eps;
    __device__ __forceinline__ void fused(f32x4 (&acc)[2][2][4][2], const Unit& u, int wr, int wc, int fr, int fq, PG8_LAS unsigned char* lds, int wid, int lane) const {
        typedef float f32x2v __attribute__((ext_vector_type(2))); typedef unsigned u32x2v __attribute__((ext_vector_type(2)));
        PG8_LAS f32x2v* P = (PG8_LAS f32x2v*)lds;
        PG8_LAS f32x2v* S = (PG8_LAS f32x2v*)(lds + 8192);
        const int col0 = u.pn * BM + wc * 32 + 4 * fq;
        const int tid_ = wid * 64 + lane; bf16_t* xl_t = xl + (size_t)(u.pm * 8 + u.pn) * 65536;
#pragma unroll
        for (int ai = 0; ai < 2; ++ai)
#pragma unroll
            for (int m = 0; m < 4; ++m) { const size_t off = (size_t)(u.pm * BM + ai * HALF + wr * 64 + m * 16 + fr) * 2048 + col0;
#pragma unroll
                for (int bj = 0; bj < 2; ++bj) { u32x4 lo16 = (u32x4){0u, 0u, 0u, 0u};
                    if (!base) lo16 = *(const u32x4*)(xl_t + ((size_t)(((ai * 4 + m) * 2 + bj) * 512 + tid_) * 8));
#pragma unroll
                    for (int n = 0; n < 2; ++n) { f32x4 bs;
                        if (base) bs = *(const f32x4*)(base + off + bj * HALF + n * 16);
                        else { const u32x2v h = *(const u32x2v*)(xn + off + bj * HALF + n * 16); const unsigned qx = n ? lo16.z : lo16.x, qy = n ? lo16.w : lo16.y;
                            bs[0] = __uint_as_float(h.x << 16) + __uint_as_float(qx << 16); bs[1] = __uint_as_float(h.x & 0xffff0000u) + __uint_as_float(qx & 0xffff0000u);
                            bs[2] = __uint_as_float(h.y << 16) + __uint_as_float(qy << 16); bs[3] = __uint_as_float(h.y & 0xffff0000u) + __uint_as_float(qy & 0xffff0000u); }
                        acc[ai][bj][m][n] = bs * alpha + acc[ai][bj][m][n]; } }
                asm volatile("" : "+v"(acc[ai][0][m][0]), "+v"(acc[ai][0][m][1]), "+v"(acc[ai][1][m][0]), "+v"(acc[ai][1][m][1]));
                if (m == 3) asm volatile("" ::: "memory"); }
#pragma unroll
        for (int ai = 0; ai < 2; ++ai)
#pragma unroll
            for (int m = 0; m < 4; ++m) {
                float s = 0.f;
#pragma unroll
                for (int bj = 0; bj < 2; ++bj)
#pragma unroll
                    for (int n = 0; n < 2; ++n) { const f32x4 x = acc[ai][bj][m][n]; s += (x[0] + x[1]) + (x[2] + x[3]); }
                s += __shfl_xor(s, 16); s += __shfl_xor(s, 32);
                const float mw = s * (1.0f / 64.0f); float q = 0.f;
#pragma unroll
                for (int bj = 0; bj < 2; ++bj)
#pragma unroll
                    for (int n = 0; n < 2; ++n) { const f32x4 d = acc[ai][bj][m][n] - mw; q += (d[0] * d[0] + d[1] * d[1]) + (d[2] * d[2] + d[3] * d[3]); }
                q += __shfl_xor(q, 16); q += __shfl_xor(q, 32);
                if (fq == 0) P[(ai * HALF + wr * 64 + m * 16 + fr) * 4 + wc] = (f32x2v){mw, q};
            }
        asm volatile("s_waitcnt lgkmcnt(0)" ::: "memory"); __builtin_amdgcn_s_barrier(); asm volatile("" ::: "memory");
        const int row = wid * 32 + (lane & 31);
        if (lane < 32) {
            const f32x2v a = P[row * 4 + 0], b = P[row * 4 + 1], c = P[row * 4 + 2], d = P[row * 4 + 3];
            const float mt = (a.x + b.x + c.x + d.x) * 0.25f;
            const float da = a.x - mt, db = b.x - mt, dc = c.x - mt, dd = d.x - mt;
            const float m2 = (a.y + b.y) + (c.y + d.y) + 64.0f * ((da * da + db * db) + (dc * dc + dd * dd));
            unsigned long long* slot = xbuf + ((size_t)(u.pm * BM + row) * 8 + u.pn);
            __hip_atomic_store(slot, ((unsigned long long)__float_as_uint(m2) << 32) | __float_as_uint(mt), __ATOMIC_RELAXED, __HIP_MEMORY_SCOPE_AGENT);
        }
        asm volatile("s_waitcnt vmcnt(0)" ::: "memory");
        if (lane == 0) __hip_atomic_fetch_add(cnt + 64 * u.pm, 1u, __ATOMIC_RELAXED, __HIP_MEMORY_SCOPE_AGENT);
        if (wid == 0) {
            unsigned sp = 0;
            while ((unsigned)__builtin_amdgcn_readfirstlane(__hip_atomic_load(cnt + 64 * u.pm, __ATOMIC_RELAXED, __HIP_MEMORY_SCOPE_AGENT)) < 64u) { __builtin_amdgcn_s_sleep(2); if (++sp > (1u << 22)) break; }
        }
        asm volatile("s_waitcnt vmcnt(0) lgkmcnt(0)" ::: "memory"); __builtin_amdgcn_s_barrier(); asm volatile("" ::: "memory");
        if (lane < 32) {
            const unsigned long long* slot = xbuf + (size_t)(u.pm * BM + row) * 8; float mt[8], m2[8]; float ms = 0.f;
#pragma unroll
            for (int t = 0; t < 8; ++t) { const unsigned long long w = __hip_atomic_load(slot + t, __ATOMIC_RELAXED, __HIP_MEMORY_SCOPE_AGENT); mt[t] = __uint_as_float((unsigned)w); m2[t] = __uint_as_float((unsigned)(w >> 32)); ms += mt[t]; }
            const float mean = ms * 0.125f; float q = 0.f;
#pragma unroll
            for (int t = 0; t < 8; ++t) { const float dm = mt[t] - mean; q += m2[t] + 256.0f * dm * dm; }
            S[row] = (f32x2v){mean, 1.0f / sqrtf(q * (1.0f / 2048.0f) + eps)};
        }
        asm volatile("s_waitcnt lgkmcnt(0)" ::: "memory"); __builtin_amdgcn_s_barrier(); asm volatile("" ::: "memory");
#pragma unroll
        for (int bj = 0; bj < 2; ++bj) { f32x4 gg[2], bb[2];
#pragma unroll
            for (int n = 0; n < 2; ++n) { gg[n] = *(const f32x4*)(lg + col0 + bj * HALF + n * 16); bb[n] = *(const f32x4*)(lb + col0 + bj * HALF + n * 16); }
#pragma unroll
            for (int ai = 0; ai < 2; ++ai)
#pragma unroll
                for (int m = 0; m < 4; ++m) { const int r = ai * HALF + wr * 64 + m * 16 + fr; const f32x2v sr = S[r]; u32x4 lo16;
#pragma unroll
                    for (int n = 0; n < 2; ++n) { const size_t off = (size_t)(u.pm * BM + r) * 2048 + col0 + bj * HALF + n * 16;
                        const f32x4 y = (acc[ai][bj][m][n] - sr.x) * sr.y * gg[n] + bb[n];
                        if (out) *(f32x4*)(out + off) = y;
                        else { u32x2v w; w.x = cvt_pk_bf16(y[0], y[1]); w.y = cvt_pk_bf16(y[2], y[3]); *(u32x2v*)(xn + off) = w;
                            const unsigned q0 = cvt_pk_bf16(y[0] - __uint_as_float(w.x << 16), y[1] - __uint_as_float(w.x & 0xffff0000u)), q1 = cvt_pk_bf16(y[2] - __uint_as_float(w.y << 16), y[3] - __uint_as_float(w.y & 0xffff0000u));
                            if (n == 0) { lo16.x = q0; lo16.y = q1; } else { lo16.z = q0; lo16.w = q1; } } }
                    if (!out) *(u32x4*)(xl_t + ((size_t)(((ai * 4 + m) * 2 + bj) * 512 + tid_) * 8)) = lo16; } }
    }
};
}

#define LAS __attribute__((address_space(3)))
#define GAS __attribute__((address_space(1)))
typedef unsigned short bf16_t;
typedef short bf16x8 __attribute__((ext_vector_type(8)));
typedef short bf16x4 __attribute__((ext_vector_type(4)));
typedef float f32x4 __attribute__((ext_vector_type(4)));
typedef unsigned u32x4 __attribute__((ext_vector_type(4)));
typedef unsigned u32x2 __attribute__((ext_vector_type(2)));

constexpr int SEQ = 8192, DM = 2048, DEPTH = 4, INW = 6672, NMEM = 256;
constexpr int NMAIN = 5376, NVT = 1536, NWT = NMAIN + NVT;
constexpr int C_AQ = 0, C_AK = 1024, C_AZ = 2048, C_BQ = 3072, C_BK = 3328, C_BZ = 3584, C_MQ = 4096, C_MZ = 4608, C_LR = 5120;
constexpr int NCH = SEQ / 64;
constexpr float LN_EPS = 1e-5f, RMS_EPS = 1e-6f;
constexpr float LOG2E = 1.4426950408889634f;
constexpr float ATT_SC = 0.08838834764831845f * LOG2E;
constexpr int LDS_BYTES = 147456;

constexpr size_t MiB = 1u << 20;
constexpr size_t WS_WIN = 0, WIN_L = (size_t)NWT * DM * 2;
constexpr size_t WS_WOUT = 112 * MiB, WOUT_L = (size_t)DM * DM * 2;
constexpr size_t WS_WMK = 144 * MiB, WS_WMV = 152 * MiB;
constexpr size_t WS_MEMB = 160 * MiB, WS_MK = 161 * MiB, WS_MVT = 162 * MiB;
constexpr size_t WS_XB = 164 * MiB, WS_XF = 196 * MiB, WS_HM = 260 * MiB, WS_Y = 368 * MiB;
constexpr int LDV = SEQ + 64;
constexpr size_t WS_U = 400 * MiB, WS_SP = 416 * MiB, WS_DCY = 424 * MiB, WS_CTL = 426 * MiB, CTL_BYTES = 65536, WS_XCH = 427 * MiB, WS_VT = 428 * MiB, WS_BG = 454 * MiB, WS_XL = 462 * MiB, WS_END = 494 * MiB;
constexpr int CW_CNT = 4096;
static_assert(WS_WIN + 4 * WIN_L <= WS_WOUT, "ws map");
static_assert(WS_HM + (size_t)SEQ * NMAIN * 2 <= WS_Y, "ws map");

struct Params {
    const float *x, *mem, *w_in, *rel, *gate_w, *gate_b, *norm_g, *w_mkv, *w_out, *ln_g, *ln_b;
    float* out; unsigned char* ws; int ph_lo, ph_hi;
};

typedef float f32x2_t __attribute__((ext_vector_type(2))); typedef __bf16 bf16x2_t __attribute__((ext_vector_type(2)));
__device__ __forceinline__ unsigned pk2(float lo, float hi) { const f32x2_t v = {lo, hi}; const bf16x2_t b = __builtin_convertvector(v, bf16x2_t); return __builtin_bit_cast(unsigned, b); }
__device__ __forceinline__ float bflo(unsigned w) { return __uint_as_float(w << 16); }
__device__ __forceinline__ float bfhi(unsigned w) { return __uint_as_float(w & 0xffff0000u); }
__device__ __forceinline__ float silu_f(float z) { return z / (1.0f + __expf(-z)); }
#define MFMA16(a, b, c) __builtin_amdgcn_mfma_f32_16x16x32_bf16((a), (b), (c), 0, 0, 0)

struct ConvItem { const GAS float* src; GAS bf16_t* dst; int ldw; bool ok; };
__device__ __forceinline__ void conv_load(const ConvItem& d, f32x4 (&v)[8]) {
#pragma unroll
    for (int i = 0; i < 8; ++i) v[i] = d.ok ? *(const GAS f32x4*)(d.src + (size_t)(8 * i) * d.ldw) : (f32x4){0.f, 0.f, 0.f, 0.f};
}
__device__ __forceinline__ void conv_store(const ConvItem& d, const f32x4 (&v)[8], LAS float* scr, int lane) {
    const int n4 = 4 * (lane & 7), kr = lane >> 3;
#pragma unroll
    for (int i = 0; i < 8; ++i) { LAS float* q = scr + (8 * i + kr) * 33 + n4; q[0] = v[i].x; q[1] = v[i].y; q[2] = v[i].z; q[3] = v[i].w; }
    asm volatile("s_waitcnt lgkmcnt(0)" ::: "memory");
    const int c = lane & 7;
#pragma unroll
    for (int j = 0; j < 4; ++j) { const int n = (lane >> 3) + 8 * j; const LAS float* s = scr + (8 * c) * 33 + n;
        u32x4 o; o.x = pk2(s[0 * 33], s[1 * 33]); o.y = pk2(s[2 * 33], s[3 * 33]); o.z = pk2(s[4 * 33], s[5 * 33]); o.w = pk2(s[6 * 33], s[7 * 33]);
        *(GAS u32x4*)(d.dst + (size_t)n * DM + 8 * c) = o; }
    asm volatile("s_waitcnt lgkmcnt(0)" ::: "memory");
}
__device__ __forceinline__ void in_seg(int drow, int& src_col, int& nvalid) {
    nvalid = 32;
    if (drow < 2048) src_col = drow;
    else if (drow < 3072) src_col = 3072 + (drow - 2048);
    else if (drow < 3328) src_col = 4096 + (drow - 3072);
    else if (drow < 3584) src_col = 4352 + (drow - 3328);
    else if (drow < 4096) src_col = 5120 + (drow - 3584);
    else if (drow < 4608) src_col = 5648 + (drow - 4096);
    else if (drow < 5120) src_col = 6160 + (drow - 4608);
    else if (drow < 5376) { src_col = 5632; nvalid = (drow == 5120) ? 16 : 0; }
    else if (drow < 6400) src_col = 2048 + (drow - 5376);
    else src_col = 4608 + (drow - 6400);
}
__device__ __forceinline__ ConvItem conv_decode(const Params& p, int l, int it, int lane) {
    constexpr int I_IN = 32 * (NWT / 32), I_OUT = 32 * (DM / 32);
    const int n4 = 4 * (lane & 7), kr = lane >> 3;
    ConvItem d; int r = it;
    if (r < I_IN) { const int g_ = r >> 5, nb = 8 * (g_ % 27) + (r & 7), k0 = 64 * (4 * (g_ / 27) + ((r >> 3) & 3)); int sc, nv; in_seg(32 * nb, sc, nv);
        d.ldw = INW; d.ok = n4 < nv; d.src = (const GAS float*)p.w_in + (size_t)l * DM * INW + (size_t)(k0 + kr) * INW + sc + n4;
        d.dst = (GAS bf16_t*)(p.ws + WS_WIN + l * WIN_L) + (size_t)(32 * nb) * DM + k0; return d; }
    r -= I_IN;
    if (r < I_OUT) { const int g_ = r >> 5, nb = 8 * (g_ % 8) + (r & 7), k0 = 64 * (4 * (g_ / 8) + ((r >> 3) & 3));
        d.ldw = DM; d.ok = true; d.src = (const GAS float*)p.w_out + (size_t)l * DM * DM + (size_t)(k0 + kr) * DM + 32 * nb + n4;
        d.dst = (GAS bf16_t*)(p.ws + WS_WOUT + l * WOUT_L) + (size_t)(32 * nb) * DM + k0; return d; }
    r -= I_OUT;
    { const int g_ = r >> 5, nb = 8 * (g_ % 4) + (r & 7), k0 = 64 * (4 * (g_ / 4) + ((r >> 3) & 3));
        d.ldw = 1024; d.ok = true; d.src = (const GAS float*)p.w_mkv + (size_t)l * DM * 1024 + (size_t)(k0 + kr) * 1024 + 32 * nb + n4;
        d.dst = (GAS bf16_t*)(p.ws + (nb < 16 ? WS_WMK : WS_WMV)) + (size_t)(l * 512 + 32 * (nb & 15)) * DM + k0; return d; }
}
__device__ __forceinline__ void convert_layer(const Params& p, int l, LAS unsigned char* lds, int wk, int nwk) {
    int tid_ = threadIdx.x; asm volatile("" : "+v"(tid_)); const int tid = tid_, lane = tid & 63, wave = tid >> 6;
    LAS float* scr = (LAS float*)(lds + wave * 8704);
    constexpr int I_L = 32 * (NWT / 32) + 32 * (DM / 32) + 32 * 32;
    if (wk >= I_L) return;
    ConvItem cur = conv_decode(p, l, wk, lane); f32x4 v[8]; conv_load(cur, v);
    for (int it = wk; it < I_L; it += nwk) {
        const int nx = it + nwk; ConvItem nxt = cur; f32x4 v2[8];
        if (nx < I_L) { nxt = conv_decode(p, l, nx, lane); conv_load(nxt, v2); }
        conv_store(cur, v, scr, lane);
        if (nx < I_L) { cur = nxt;
#pragma unroll
            for (int i = 0; i < 8; ++i) v[i] = v2[i]; }
    }
}
__device__ __forceinline__ void phase0(const Params& p, LAS unsigned char* lds) {
    int tid_ = threadIdx.x; asm volatile("" : "+v"(tid_)); const int tid = tid_, wave = tid >> 6;
    convert_layer(p, 0, lds, blockIdx.x * 8 + wave, gridDim.x * 8);
    const size_t gt = (size_t)blockIdx.x * 512 + tid, NT = (size_t)gridDim.x * 512;
    GAS bf16_t* xb = (GAS bf16_t*)(p.ws + WS_XB); const GAS f32x4* xs = (const GAS f32x4*)p.x;
    for (size_t i = gt; i < (size_t)SEQ * DM / 8; i += NT) { const f32x4 a = xs[2 * i], b = xs[2 * i + 1];
        u32x4 o; o.x = pk2(a.x, a.y); o.y = pk2(a.z, a.w); o.z = pk2(b.x, b.y); o.w = pk2(b.z, b.w); ((GAS u32x4*)xb)[i] = o; }
    GAS bf16_t* mb = (GAS bf16_t*)(p.ws + WS_MEMB); const GAS f32x4* ms = (const GAS f32x4*)p.mem;
    for (size_t i = gt; i < (size_t)NMEM * DM / 8; i += NT) { const f32x4 a = ms[2 * i], b = ms[2 * i + 1];
        u32x4 o; o.x = pk2(a.x, a.y); o.y = pk2(a.z, a.w); o.z = pk2(b.x, b.y); o.w = pk2(b.z, b.w); ((GAS u32x4*)mb)[i] = o; }
}

constexpr int A_KS = 0, A_KSZ = 64 * 272, A_VS = 2 * A_KSZ, A_VSZ = 128 * 144, A_BT = A_VS + 2 * A_VSZ;
template <bool BAND>
__device__ __forceinline__ void attn_step(LAS unsigned char* lds, int buf, int t, int cw, int w, int r16, int g, const bf16x8 (&qf)[4], f32x4 (&o)[8], float& m, float& l) {
    const LAS float* btab = (const LAS float*)(lds + A_BT);
    const LAS unsigned char* kb_ = lds + A_KS + buf * A_KSZ + r16 * 272 + g * 16;
    f32x4 s[4];
#pragma unroll
    for (int kb = 0; kb < 4; ++kb) { s[kb] = (f32x4){0.f, 0.f, 0.f, 0.f}; bf16x8 kfr[4];
#pragma unroll
        for (int ks = 0; ks < 4; ++ks) kfr[ks] = *(const LAS bf16x8*)(kb_ + kb * 16 * 272 + ks * 64);
#pragma unroll
        for (int ks = 0; ks < 4; ++ks) s[kb] = MFMA16(kfr[ks], qf[ks], s[kb]); }
    if (BAND) {
        const int delta = cw + 8 - t;
        if (delta >= 3) { const float bc = btab[256];
#pragma unroll
            for (int kb = 0; kb < 4; ++kb) s[kb] = s[kb] * ATT_SC + bc;
        } else { const int qi = 16 * (w & 3) + r16;
#pragma unroll
            for (int kb = 0; kb < 4; ++kb)
#pragma unroll
                for (int r = 0; r < 4; ++r) { int dist = 64 * delta + qi - (16 * kb + 4 * g + r); dist = dist > 128 ? 128 : (dist < -128 ? -128 : dist);
                    s[kb][r] = s[kb][r] * ATT_SC + btab[dist + 128]; }
        }
    } else {
#pragma unroll
        for (int kb = 0; kb < 4; ++kb) s[kb] = s[kb] * ATT_SC;
    }
    float mt = fmaxf(fmaxf(s[0][0], s[0][1]), fmaxf(s[0][2], s[0][3]));
#pragma unroll
    for (int kb = 1; kb < 4; ++kb) mt = fmaxf(mt, fmaxf(fmaxf(s[kb][0], s[kb][1]), fmaxf(s[kb][2], s[kb][3])));
    mt = fmaxf(mt, __shfl_xor(mt, 16)); mt = fmaxf(mt, __shfl_xor(mt, 32));
    const float mn = fmaxf(m, mt), alpha = __builtin_amdgcn_exp2f(m - mn); m = mn;
    float rs = 0.f;
#pragma unroll
    for (int kb = 0; kb < 4; ++kb)
#pragma unroll
        for (int r = 0; r < 4; ++r) { const float pv = __builtin_amdgcn_exp2f(s[kb][r] - mn); s[kb][r] = pv; rs += pv; }
    l = l * alpha + rs;
    if (__any(alpha != 1.0f)) {
#pragma unroll
        for (int i = 0; i < 8; ++i) o[i] = o[i] * alpha; }
    bf16x8 pb[2];
#pragma unroll
    for (int s2 = 0; s2 < 2; ++s2) { u32x4 pw; pw.x = pk2(s[2 * s2][0], s[2 * s2][1]); pw.y = pk2(s[2 * s2][2], s[2 * s2][3]);
        pw.z = pk2(s[2 * s2 + 1][0], s[2 * s2 + 1][1]); pw.w = pk2(s[2 * s2 + 1][2], s[2 * s2 + 1][3]); pb[s2] = __builtin_bit_cast(bf16x8, pw); }
    int voff_ = 0; asm volatile("" : "+v"(voff_), "+v"(pb[1]));
    const LAS unsigned char* vb_ = lds + A_VS + buf * A_VSZ + r16 * 144 + g * 8 + voff_;
    u32x2 vfr[2][4];
#pragma unroll
    for (int q = 0; q < 4; ++q) vfr[0][q] = *(const LAS u32x2*)(vb_ + (q >> 1) * 64 + (q & 1) * 32);
#pragma unroll
    for (int dvb = 0; dvb < 8; ++dvb) {
        if (dvb < 7) {
#pragma unroll
            for (int q = 0; q < 4; ++q) vfr[(dvb + 1) & 1][q] = *(const LAS u32x2*)(vb_ + (dvb + 1) * 16 * 144 + (q >> 1) * 64 + (q & 1) * 32); }
#pragma unroll
        for (int s2 = 0; s2 < 2; ++s2) { const u32x2 lo = vfr[dvb & 1][2 * s2], hi = vfr[dvb & 1][2 * s2 + 1];
            const u32x4 av = (u32x4){lo.x, lo.y, hi.x, hi.y}; o[dvb] = MFMA16(__builtin_bit_cast(bf16x8, av), pb[s2], o[dvb]); } }
}
template <bool BAND>
__device__ __forceinline__ void attn_unit(LAS unsigned char* lds, int q_row0, const bf16_t* Qh, int ldq, const bf16_t* Kh, int ldk, const bf16_t* Vth, int ldvt,
                                          const bf16_t* Zh, int ldz, bf16_t* Yh, int ldy, const float* bias_tab, int j2) {
    int tid_ = threadIdx.x; asm volatile("" : "+v"(tid_)); const int tid = tid_, lane = tid & 63, w = __builtin_amdgcn_readfirstlane(tid >> 6), r16 = lane & 15, g = lane >> 4;
    LAS float* btab = (LAS float*)(lds + A_BT);
    if (BAND) { for (int i = tid; i < 257; i += 512) btab[i] = ((const GAS float*)bias_tab)[i] * LOG2E; }
    const GAS bf16_t* qp = (const GAS bf16_t*)Qh + (size_t)(q_row0 + 16 * w + r16) * ldq + 8 * g;
    bf16x8 qf[4];
#pragma unroll
    for (int ks = 0; ks < 4; ++ks) qf[ks] = *(const GAS bf16x8*)(qp + 32 * ks);
    f32x4 o[8];
#pragma unroll
    for (int i = 0; i < 8; ++i) o[i] = (f32x4){0.f, 0.f, 0.f, 0.f};
    float m = -1e30f, l = 0.f;
    const int cw = BAND ? (w >> 2) : 0;
    const int nt = BAND ? 10 : 4;
    int t0 = 0; if (BAND) { t0 = 8 - 2 * j2; if (t0 < 0) t0 = 0; }
    u32x4 kA[2], vA[2], kB[2], vB[2];
#define A_GLOAD(kr, vr, t) do { const int key0_ = BAND ? 64 * (2 * j2 - 8 + (t)) : 64 * (t); \
        _Pragma("unroll") for (int i_ = 0; i_ < 2; ++i_) { const int id_ = tid + 512 * i_; \
            kr[i_] = *(const GAS u32x4*)((const GAS bf16_t*)Kh + (size_t)(key0_ + (id_ >> 4)) * ldk + (id_ & 15) * 8); \
            vr[i_] = *(const GAS u32x4*)((const GAS bf16_t*)Vth + (size_t)(id_ >> 3) * ldvt + key0_ + (id_ & 7) * 8); } } while (0)
#define A_LSTORE(kr, vr, buf) do { _Pragma("unroll") for (int i_ = 0; i_ < 2; ++i_) { const int id_ = tid + 512 * i_; \
            *(LAS u32x4*)(lds + A_KS + (buf) * A_KSZ + (id_ >> 4) * 272 + (id_ & 15) * 16) = kr[i_]; \
            *(LAS u32x4*)(lds + A_VS + (buf) * A_VSZ + (id_ >> 3) * 144 + (id_ & 7) * 16) = vr[i_]; } } while (0)
    A_GLOAD(kA, vA, t0); A_GLOAD(kB, vB, t0 + 1); A_LSTORE(kA, vA, 0); __syncthreads();
    for (int t = t0; t < nt; t += 2) {
        if (t + 2 < nt) A_GLOAD(kA, vA, t + 2);
        if (!BAND || (t >= cw && t <= cw + 8)) attn_step<BAND>(lds, 0, t, cw, w, r16, g, qf, o, m, l);
        A_LSTORE(kB, vB, 1);
        __syncthreads();
        if (t + 3 < nt) A_GLOAD(kB, vB, t + 3);
        if (!BAND || (t + 1 >= cw && t + 1 <= cw + 8)) attn_step<BAND>(lds, 1, t + 1, cw, w, r16, g, qf, o, m, l);
        if (t + 2 < nt) A_LSTORE(kA, vA, 0);
        __syncthreads();
    }
#undef A_GLOAD
#undef A_LSTORE
    l += __shfl_xor(l, 16); l += __shfl_xor(l, 32);
    const float inv = 1.0f / l;
    const size_t row = (size_t)(q_row0 + 16 * w + r16);
#pragma unroll
    for (int dvb = 0; dvb < 8; ++dvb) { const int col = 16 * dvb + 4 * g; const u32x2 z = *(const GAS u32x2*)((const GAS bf16_t*)Zh + row * ldz + col);
        const float y0 = o[dvb][0] * inv * silu_f(bflo(z.x)), y1 = o[dvb][1] * inv * silu_f(bfhi(z.x)), y2 = o[dvb][2] * inv * silu_f(bflo(z.y)), y3 = o[dvb][3] * inv * silu_f(bfhi(z.y));
        u32x2 yo; yo.x = pk2(y0, y1); yo.y = pk2(y2, y3); *(GAS u32x2*)((GAS bf16_t*)Yh + row * ldy + col) = yo; }
}


constexpr int P_HALF = 2 * A_KSZ + 2 * A_VSZ, P_BT = 2 * P_HALF;
static_assert(P_BT + 2 * 1028 <= LDS_BYTES - 64, "pair attention LDS map");
__device__ __forceinline__ void band_pair_step(LAS unsigned char* hl, const LAS float* btab, int buf, int t, int cw, int w4, int r16, int g,
                                               const bf16x8 (&qf)[2][4], f32x4 (&o)[2][8], float (&m)[2], f32x4 (&l)[2]) {
    const LAS unsigned char* kb_ = hl + buf * A_KSZ + r16 * 272 + g * 16;
    f32x4 s[2][4];
#pragma unroll
    for (int kb = 0; kb < 4; ++kb) { bf16x8 kfr[4];
#pragma unroll
        for (int ks = 0; ks < 4; ++ks) kfr[ks] = *(const LAS bf16x8*)(kb_ + kb * 16 * 272 + ks * 64);
#pragma unroll
        for (int rb = 0; rb < 2; ++rb) { s[rb][kb] = (f32x4){0.f, 0.f, 0.f, 0.f};
#pragma unroll
            for (int ks = 0; ks < 4; ++ks) s[rb][kb] = MFMA16(kfr[ks], qf[rb][ks], s[rb][kb]); } }
    const int delta = cw + 8 - t;
    bf16x8 pb[2][2];
    const bf16x8 ones = (bf16x8){16256, 16256, 16256, 16256, 16256, 16256, 16256, 16256};
#pragma unroll
    for (int rb = 0; rb < 2; ++rb) {
        float mn, alpha;
        if (delta >= 3) {
            const float bc = btab[256];
            float mt = fmaxf(fmaxf(s[rb][0][0], s[rb][0][1]), fmaxf(s[rb][0][2], s[rb][0][3]));
#pragma unroll
            for (int kb = 1; kb < 4; ++kb) mt = fmaxf(mt, fmaxf(fmaxf(s[rb][kb][0], s[rb][kb][1]), fmaxf(s[rb][kb][2], s[rb][kb][3])));
            mt = fmaxf(mt, __shfl_xor(mt, 16)); mt = fmaxf(mt, __shfl_xor(mt, 32));
            mn = fmaxf(m[rb], mt * ATT_SC + bc); alpha = __builtin_amdgcn_exp2f(m[rb] - mn); m[rb] = mn;
            const float off = bc - mn;
#pragma unroll
            for (int kb = 0; kb < 4; ++kb)
#pragma unroll
                for (int r = 0; r < 4; ++r) s[rb][kb][r] = __builtin_amdgcn_exp2f(s[rb][kb][r] * ATT_SC + off);
        } else { const int qi = 32 * (w4 & 1) + 16 * rb + r16;
#pragma unroll
            for (int kb = 0; kb < 4; ++kb)
#pragma unroll
                for (int r = 0; r < 4; ++r) { int dist = 64 * delta + qi - (16 * kb + 4 * g + r); dist = dist > 128 ? 128 : (dist < -128 ? -128 : dist);
                    s[rb][kb][r] = s[rb][kb][r] * ATT_SC + btab[dist + 128]; }
            float mt = fmaxf(fmaxf(s[rb][0][0], s[rb][0][1]), fmaxf(s[rb][0][2], s[rb][0][3]));
#pragma unroll
            for (int kb = 1; kb < 4; ++kb) mt = fmaxf(mt, fmaxf(fmaxf(s[rb][kb][0], s[rb][kb][1]), fmaxf(s[rb][kb][2], s[rb][kb][3])));
            mt = fmaxf(mt, __shfl_xor(mt, 16)); mt = fmaxf(mt, __shfl_xor(mt, 32));
            mn = fmaxf(m[rb], mt); alpha = __builtin_amdgcn_exp2f(m[rb] - mn); m[rb] = mn;
#pragma unroll
            for (int kb = 0; kb < 4; ++kb)
#pragma unroll
                for (int r = 0; r < 4; ++r) s[rb][kb][r] = __builtin_amdgcn_exp2f(s[rb][kb][r] - mn);
        }
        if (__any(alpha != 1.0f)) { l[rb] = l[rb] * alpha;
#pragma unroll
            for (int i = 0; i < 8; ++i) o[rb][i] = o[rb][i] * alpha; }
#pragma unroll
        for (int s2 = 0; s2 < 2; ++s2) { u32x4 pw; pw.x = pk2(s[rb][2 * s2][0], s[rb][2 * s2][1]); pw.y = pk2(s[rb][2 * s2][2], s[rb][2 * s2][3]);
            pw.z = pk2(s[rb][2 * s2 + 1][0], s[rb][2 * s2 + 1][1]); pw.w = pk2(s[rb][2 * s2 + 1][2], s[rb][2 * s2 + 1][3]); pb[rb][s2] = __builtin_bit_cast(bf16x8, pw);
            l[rb] = MFMA16(ones, pb[rb][s2], l[rb]); }
    }
    int voff_ = 0; asm volatile("" : "+v"(voff_), "+v"(pb[1][1]));
    const LAS unsigned char* vb_ = hl + 2 * A_KSZ + buf * A_VSZ + r16 * 144 + g * 8 + voff_;
#pragma unroll
    for (int dvb = 0; dvb < 8; ++dvb) { u32x2 vfr[4];
#pragma unroll
        for (int q = 0; q < 4; ++q) vfr[q] = *(const LAS u32x2*)(vb_ + dvb * 16 * 144 + (q >> 1) * 64 + (q & 1) * 32);
#pragma unroll
        for (int s2 = 0; s2 < 2; ++s2) { const u32x4 av = (u32x4){vfr[2 * s2].x, vfr[2 * s2].y, vfr[2 * s2 + 1].x, vfr[2 * s2 + 1].y};
#pragma unroll
            for (int rb = 0; rb < 2; ++rb) o[rb][dvb] = MFMA16(__builtin_bit_cast(bf16x8, av), pb[rb][s2], o[rb][dvb]); } }
}
__device__ __forceinline__ void band_pair_unit(LAS unsigned char* lds, const Params& p, int l, int j2, int hA) {
    int tid_ = threadIdx.x; asm volatile("" : "+v"(tid_)); const int tid = tid_, lane = tid & 63, w = __builtin_amdgcn_readfirstlane(tid >> 6), r16 = lane & 15, g = lane >> 4;
    const int half = w >> 2, w4 = w & 3, th = tid & 255, head = hA + half;
    LAS unsigned char* hl = lds + half * P_HALF;
    LAS float* btab = (LAS float*)(lds + P_BT + half * 1028);
    { const GAS float* bt = (const GAS float*)p.rel + (l * 8 + head) * 257; for (int i = th; i < 257; i += 256) btab[i] = bt[i] * LOG2E; }
    const GAS bf16_t* hm = (const GAS bf16_t*)(p.ws + WS_HM);
    const GAS bf16_t* Kh = hm + C_AK + head * 128; const GAS bf16_t* Vth = (const GAS bf16_t*)(p.ws + WS_VT) + (size_t)(head * 128) * LDV;
    const int row0 = 128 * j2 + 32 * w4 + r16;
    bf16x8 qf[2][4];
#pragma unroll
    for (int rb = 0; rb < 2; ++rb)
#pragma unroll
        for (int ks = 0; ks < 4; ++ks) qf[rb][ks] = *(const GAS bf16x8*)(hm + (size_t)(row0 + 16 * rb) * NMAIN + C_AQ + head * 128 + 32 * ks + 8 * g);
    f32x4 o[2][8];
#pragma unroll
    for (int rb = 0; rb < 2; ++rb)
#pragma unroll
        for (int i = 0; i < 8; ++i) o[rb][i] = (f32x4){0.f, 0.f, 0.f, 0.f};
    float m[2] = {-1e30f, -1e30f}; f32x4 l_[2] = {(f32x4){0.f, 0.f, 0.f, 0.f}, (f32x4){0.f, 0.f, 0.f, 0.f}};
    const int cw = w4 >> 1, nt = 10;
    int t0 = 8 - 2 * j2; if (t0 < 0) t0 = 0;
    u32x4 kr[4], vr[4];
#define P_GLOAD(t) do { const int key0_ = 64 * (2 * j2 - 8 + (t)); \
        _Pragma("unroll") for (int i_ = 0; i_ < 4; ++i_) { const int id_ = th + 256 * i_; \
            kr[i_] = *(const GAS u32x4*)(Kh + (size_t)(key0_ + (id_ >> 4)) * NMAIN + (id_ & 15) * 8); \
            vr[i_] = *(const GAS u32x4*)(Vth + (size_t)(id_ >> 3) * LDV + key0_ + (id_ & 7) * 8); } } while (0)
#define P_LSTORE(buf) do { _Pragma("unroll") for (int i_ = 0; i_ < 4; ++i_) { const int id_ = th + 256 * i_; \
            *(LAS u32x4*)(hl + (buf) * A_KSZ + (id_ >> 4) * 272 + (id_ & 15) * 16) = kr[i_]; \
            *(LAS u32x4*)(hl + 2 * A_KSZ + (buf) * A_VSZ + (id_ >> 3) * 144 + (id_ & 7) * 16) = vr[i_]; } } while (0)
    P_GLOAD(t0); P_LSTORE(0); __syncthreads();
    for (int t = t0; t < nt; ++t) {
        const int buf = (t - t0) & 1;
        if (t + 1 < nt) P_GLOAD(t + 1);
        if (t >= cw && t <= cw + 8) band_pair_step(hl, btab, buf, t, cw, w4, r16, g, qf, o, m, l_);
        if (t + 1 < nt) P_LSTORE(buf ^ 1);
        __syncthreads();
    }
#undef P_GLOAD
#undef P_LSTORE
    GAS bf16_t* Y = (GAS bf16_t*)(p.ws + WS_Y);
#pragma unroll
    for (int rb = 0; rb < 2; ++rb) { const float inv = 1.0f / l_[rb][0]; const size_t row = (size_t)(row0 + 16 * rb);
#pragma unroll
        for (int dvb = 0; dvb < 8; ++dvb) { const int col = 16 * dvb + 4 * g; const u32x2 z = *(const GAS u32x2*)(hm + row * NMAIN + C_AZ + head * 128 + col);
            const float y0 = o[rb][dvb][0] * inv * silu_f(bflo(z.x)), y1 = o[rb][dvb][1] * inv * silu_f(bfhi(z.x)), y2 = o[rb][dvb][2] * inv * silu_f(bflo(z.y)), y3 = o[rb][dvb][3] * inv * silu_f(bfhi(z.y));
            u32x2 yo; yo.x = pk2(y0, y1); yo.y = pk2(y2, y3); *(GAS u32x2*)(Y + row * DM + head * 128 + col) = yo; } }
}

constexpr int G_LR = 0, G_GW = 4096, G_GB = 8192, G_SEG = 8448, G_B = 10496, G_SSQ = 27136, G_QP = 27648, G_QM = 36864, G_KP = 46080, G_KM = 55296,
              G_KD = 64512, G_AT = 73728, G_VT = 82944, G_ST = 101376;
__device__ __forceinline__ void gla_compute_b(LAS unsigned char* lds, const bf16_t* hm_rows, const float* gw_l, const float* gb_l, int hb) {
    int tid_ = threadIdx.x; asm volatile("" : "+v"(tid_)); const int tid = tid_;
    LAS float* LR = (LAS float*)(lds + G_LR); LAS float* GW = (LAS float*)(lds + G_GW); LAS float* GB = (LAS float*)(lds + G_GB);
    LAS float* SEG = (LAS float*)(lds + G_SEG); LAS float* Bm = (LAS float*)(lds + G_B);
    if (tid < 128) { const int row = tid >> 1, half = tid & 1; const u32x4 v = *(const GAS u32x4*)((const GAS bf16_t*)hm_rows + (size_t)row * NMAIN + C_LR + 8 * half);
        LAS float* d = LR + row * 16 + 8 * half; d[0] = bflo(v.x); d[1] = bfhi(v.x); d[2] = bflo(v.y); d[3] = bfhi(v.y); d[4] = bflo(v.z); d[5] = bfhi(v.z); d[6] = bflo(v.w); d[7] = bfhi(v.w); }
    for (int i = tid; i < 1024; i += 512) GW[i] = ((const GAS float*)gw_l)[(i >> 6) * 256 + hb * 64 + (i & 63)];
    if (tid < 64) GB[tid] = ((const GAS float*)gb_l)[hb * 64 + tid];
    __syncthreads();
    const int d = tid & 63, tseg = tid >> 6;
    float gwr[16];
#pragma unroll
    for (int r = 0; r < 16; ++r) gwr[r] = GW[r * 64 + d];
    const float gbv = GB[d];
    float loc[8]; float run = 0.f;
#pragma unroll
    for (int tt = 0; tt < 8; ++tt) { const int t = 8 * tseg + tt; float x = gbv;
#pragma unroll
        for (int r = 0; r < 16; ++r) x += LR[t * 16 + r] * gwr[r];
        const float lg = (fminf(x, 0.f) - __logf(1.0f + __expf(-fabsf(x)))) * 0.0625f;
        run += lg; loc[tt] = run; }
    SEG[tseg * 64 + d] = run;
    __syncthreads();
    float off = 0.f;
#pragma unroll
    for (int s = 0; s < 8; ++s) { const float v = SEG[s * 64 + d]; off += (s < tseg) ? v : 0.f; }
#pragma unroll
    for (int tt = 0; tt < 8; ++tt) Bm[(8 * tseg + tt) * 65 + d] = off + loc[tt];
    __syncthreads();
}
__device__ __forceinline__ void gla_load_vt(LAS unsigned char* lds, const bf16_t* VTg, int hb, int c) {
    int tid_ = threadIdx.x; asm volatile("" : "+v"(tid_)); const int tid = tid_;
#pragma unroll
    for (int i = 0; i < 2; ++i) { const int id = tid + 512 * i, row = id >> 3, c8 = id & 7;
        *(LAS u32x4*)(lds + G_VT + row * 144 + c8 * 16) = *(const GAS u32x4*)((const GAS bf16_t*)VTg + (size_t)(1024 + hb * 128 + row) * LDV + 64 * c + 8 * c8); }
}
__device__ __forceinline__ void gla_part1(LAS unsigned char* lds, const Params& p, int l, int c, int hb) {
    int tid_ = threadIdx.x; asm volatile("" : "+v"(tid_)); const int tid = tid_, lane = tid & 63, w = __builtin_amdgcn_readfirstlane(tid >> 6), r16 = lane & 15, g = lane >> 4;
    const bf16_t* hm_rows = (const bf16_t*)(p.ws + WS_HM) + (size_t)(64 * c) * NMAIN;
    gla_compute_b(lds, hm_rows, p.gate_w + l * 16 * 256, p.gate_b + l * 256, hb);
    const LAS float* Bm = (const LAS float*)(lds + G_B);
    { GAS float* BG = (GAS float*)(p.ws + WS_BG) + (size_t)(64 * c) * 256 + hb * 64;
        const int t = tid >> 3, dc = tid & 7; f32x4 b0, b1;
        b0.x = Bm[t * 65 + 8 * dc + 0]; b0.y = Bm[t * 65 + 8 * dc + 1]; b0.z = Bm[t * 65 + 8 * dc + 2]; b0.w = Bm[t * 65 + 8 * dc + 3];
        b1.x = Bm[t * 65 + 8 * dc + 4]; b1.y = Bm[t * 65 + 8 * dc + 5]; b1.z = Bm[t * 65 + 8 * dc + 6]; b1.w = Bm[t * 65 + 8 * dc + 7];
        *(GAS f32x4*)(BG + (size_t)t * 256 + 8 * dc) = b0; *(GAS f32x4*)(BG + (size_t)t * 256 + 8 * dc + 4) = b1; }
    { const int t = tid >> 3, dc = tid & 7; const u32x4 kv = *(const GAS u32x4*)((const GAS bf16_t*)hm_rows + (size_t)t * NMAIN + C_BK + hb * 64 + 8 * dc);
        float kf[8] = {bflo(kv.x), bfhi(kv.x), bflo(kv.y), bfhi(kv.y), bflo(kv.z), bfhi(kv.z), bflo(kv.w), bfhi(kv.w)};
        LAS bf16_t* KD = (LAS bf16_t*)(lds + G_KD);
#pragma unroll
        for (int e = 0; e < 8; ++e) { const int d = 8 * dc + e; const float val = kf[e] * __expf(Bm[63 * 65 + d] - Bm[t * 65 + d]); KD[d * 72 + t] = (bf16_t)(pk2(val, 0.f) & 0xffffu); } }
    gla_load_vt(lds, (const bf16_t*)(p.ws + WS_VT), hb, c);
    if (tid < 64) ((GAS float*)(p.ws + WS_DCY))[(c * 4 + hb) * 64 + tid] = __expf(Bm[63 * 65 + tid]);
    __syncthreads();
    GAS bf16_t* U = (GAS bf16_t*)(p.ws + WS_U) + (size_t)(c * 4 + hb) * 8192;
    const LAS unsigned char* Ap = lds + G_VT + (16 * w + r16) * 144 + g * 16;
#pragma unroll
    for (int dkb = 0; dkb < 4; ++dkb) { const LAS unsigned char* Bp = lds + G_KD + (16 * dkb + r16) * 144 + g * 16; f32x4 acc = (f32x4){0.f, 0.f, 0.f, 0.f};
#pragma unroll
        for (int ks = 0; ks < 2; ++ks) acc = MFMA16(*(const LAS bf16x8*)(Bp + ks * 64), *(const LAS bf16x8*)(Ap + ks * 64), acc);
        u32x2 ub; ub.x = pk2(acc[0], acc[1]); ub.y = pk2(acc[2], acc[3]); *(GAS u32x2*)(U + (16 * w + r16) * 64 + 16 * dkb + 4 * g) = ub; }
    __syncthreads();
}
__device__ __forceinline__ void gla_scan(const Params& p, LAS unsigned char* lds) {
    int tid_ = threadIdx.x; asm volatile("" : "+v"(tid_)); const int tid = tid_, seg = tid >> 7, el = tid & 127;
    LAS float* CE = (LAS float*)lds;
    for (int eg = blockIdx.x; eg < 256; eg += gridDim.x) {
        const int e = eg * 128 + el, hb = e >> 13, rem = e & 8191, dk = rem & 63;
        const GAS bf16_t* U = (const GAS bf16_t*)(p.ws + WS_U) + (size_t)hb * 8192 + rem + (size_t)(seg * 32) * 32768;
        const GAS float* dcy = (const GAS float*)(p.ws + WS_DCY) + hb * 64 + dk + (seg * 32) * 256;
        GAS bf16_t* Sp = (GAS bf16_t*)(p.ws + WS_SP) + (size_t)hb * 8192 + rem + (size_t)(seg * 32) * 32768;
        float uv[32], dv[32];
#pragma unroll
        for (int j = 0; j < 32; ++j) { uv[j] = __uint_as_float(((unsigned)U[(size_t)j * 32768]) << 16); dv[j] = dcy[j * 256]; }
        float s = 0.f, pd = 1.f;
#pragma unroll
        for (int j = 0; j < 32; ++j) { const float u = uv[j], d = dv[j]; uv[j] = s; dv[j] = pd; s = d * s + u; pd *= d; }
        CE[seg * 128 + el] = s; CE[512 + seg * 128 + el] = pd;
        __syncthreads();
        float st = 0.f;
#pragma unroll
        for (int q = 0; q < 3; ++q) { const float se = CE[q * 128 + el], pe = CE[512 + q * 128 + el]; st = (q < seg) ? pe * st + se : st; }
#pragma unroll
        for (int j = 0; j < 32; ++j) Sp[(size_t)j * 32768] = (bf16_t)(pk2(uv[j] + dv[j] * st, 0.f) & 0xffffu);
        __syncthreads();
    }
}
struct Gla2Regs { u32x4 qv, kv; f32x4 b0, b1; u32x4 vt[2], st[2]; u32x2 zpre[4]; f32x4 gpre[4]; };
__device__ __forceinline__ void gla_part2_load(Gla2Regs& R, const Params& p, int l, int c, int hb, int tid, int w, int r16, int g) {
    const GAS bf16_t* hm_rows = (const GAS bf16_t*)(p.ws + WS_HM) + (size_t)(64 * c) * NMAIN;
    const int t = tid >> 3, dc = tid & 7;
    R.qv = *(const GAS u32x4*)(hm_rows + (size_t)t * NMAIN + C_BQ + hb * 64 + 8 * dc); R.kv = *(const GAS u32x4*)(hm_rows + (size_t)t * NMAIN + C_BK + hb * 64 + 8 * dc);
    const GAS float* BG = (const GAS float*)(p.ws + WS_BG) + (size_t)(64 * c + t) * 256 + hb * 64 + 8 * dc;
    R.b0 = *(const GAS f32x4*)BG; R.b1 = *(const GAS f32x4*)(BG + 4);
    const GAS bf16_t* VTg = (const GAS bf16_t*)(p.ws + WS_VT); const GAS bf16_t* Sp = (const GAS bf16_t*)(p.ws + WS_SP) + (size_t)(c * 4 + hb) * 8192;
#pragma unroll
    for (int i = 0; i < 2; ++i) { const int id = tid + 512 * i, row = id >> 3, c8 = id & 7;
        R.vt[i] = *(const GAS u32x4*)(VTg + (size_t)(1024 + hb * 128 + row) * LDV + 64 * c + 8 * c8); R.st[i] = *(const GAS u32x4*)(Sp + row * 64 + 8 * c8); }
    const int i_ = 16 * (w & 3) + r16;
#pragma unroll
    for (int q4 = 0; q4 < 4; ++q4) { const int dv0 = 16 * (4 * (w >> 2) + q4) + 4 * g;
        R.zpre[q4] = *(const GAS u32x2*)(hm_rows + (size_t)i_ * NMAIN + C_BZ + hb * 128 + dv0); R.gpre[q4] = *(const GAS f32x4*)((const GAS float*)p.norm_g + l * 128 + dv0); }
}
__device__ __forceinline__ void gla_part2(LAS unsigned char* lds, const Params& p, int l, int c, int hb, const Gla2Regs& R, int tid, int w, int r16, int g) {
    const bf16_t* hm_rows = (const bf16_t*)(p.ws + WS_HM) + (size_t)(64 * c) * NMAIN;
    u32x2 zpre[4]; f32x4 gpre[4];
#pragma unroll
    for (int q4 = 0; q4 < 4; ++q4) { zpre[q4] = R.zpre[q4]; gpre[q4] = R.gpre[q4]; }
    {
        const int t = tid >> 3, dc = tid & 7;
        const u32x4 qv = R.qv, kv = R.kv; const f32x4 b0 = R.b0, b1 = R.b1;
        u32x4 vt[2] = {R.vt[0], R.vt[1]}, st[2] = {R.st[0], R.st[1]};
        float qf[8] = {bflo(qv.x), bfhi(qv.x), bflo(qv.y), bfhi(qv.y), bflo(qv.z), bfhi(qv.z), bflo(qv.w), bfhi(qv.w)};
        float kf[8] = {bflo(kv.x), bfhi(kv.x), bflo(kv.y), bfhi(kv.y), bflo(kv.z), bfhi(kv.z), bflo(kv.w), bfhi(kv.w)};
        float bb[8] = {b0.x, b0.y, b0.z, b0.w, b1.x, b1.y, b1.z, b1.w};
        float qpv[8], qmv[8], kpv[8], kmv[8];
#pragma unroll
        for (int e = 0; e < 8; ++e) { const float ep = __expf(bb[e]), em = __expf(-bb[e]), q8 = qf[e] * 0.125f;
            qpv[e] = q8 * ep; qmv[e] = q8 * em; kpv[e] = kf[e] * ep; kmv[e] = kf[e] * em; }
        const int o = t * 144 + dc * 16;
        *(LAS u32x4*)(lds + G_QP + o) = (u32x4){pk2(qpv[0], qpv[1]), pk2(qpv[2], qpv[3]), pk2(qpv[4], qpv[5]), pk2(qpv[6], qpv[7])};
        *(LAS u32x4*)(lds + G_QM + o) = (u32x4){pk2(qmv[0], qmv[1]), pk2(qmv[2], qmv[3]), pk2(qmv[4], qmv[5]), pk2(qmv[6], qmv[7])};
        *(LAS u32x4*)(lds + G_KP + o) = (u32x4){pk2(kpv[0], kpv[1]), pk2(kpv[2], kpv[3]), pk2(kpv[4], kpv[5]), pk2(kpv[6], kpv[7])};
        *(LAS u32x4*)(lds + G_KM + o) = (u32x4){pk2(kmv[0], kmv[1]), pk2(kmv[2], kmv[3]), pk2(kmv[4], kmv[5]), pk2(kmv[6], kmv[7])};
#pragma unroll
        for (int i = 0; i < 2; ++i) { const int id = tid + 512 * i, row = id >> 3, c8 = id & 7;
            *(LAS u32x4*)(lds + G_VT + row * 144 + c8 * 16) = vt[i]; *(LAS u32x4*)(lds + G_ST + row * 144 + c8 * 16) = st[i]; }
    }
    __syncthreads();
    { const int ib = w >> 1; LAS bf16_t* AT = (LAS bf16_t*)(lds + G_AT);
        const LAS unsigned char* qpA = lds + G_QP + (16 * ib + r16) * 144 + g * 16; const LAS unsigned char* qmA = lds + G_QM + (16 * ib + r16) * 144 + g * 16;
#pragma unroll
        for (int jj = 0; jj < 2; ++jj) { const int jb = 2 * (w & 1) + jj;
            const LAS unsigned char* kmB = lds + G_KM + (16 * jb + r16) * 144 + g * 16; const LAS unsigned char* kpB = lds + G_KP + (16 * jb + r16) * 144 + g * 16;
            f32x4 lo = (f32x4){0.f, 0.f, 0.f, 0.f}, hi = lo;
#pragma unroll
            for (int ks = 0; ks < 2; ++ks) { lo = MFMA16(*(const LAS bf16x8*)(qpA + ks * 64), *(const LAS bf16x8*)(kmB + ks * 64), lo);
                hi = MFMA16(*(const LAS bf16x8*)(qmA + ks * 64), *(const LAS bf16x8*)(kpB + ks * 64), hi); }
#pragma unroll
            for (int r = 0; r < 4; ++r) { const int i = 16 * ib + 4 * g + r, j = 16 * jb + r16; const float v = (j <= i) ? lo[r] : hi[r]; AT[i * 72 + j] = (bf16_t)(pk2(v, 0.f) & 0xffffu); } } }
    __syncthreads();
    const int ib = w & 3, dvh = w >> 2;
    f32x4 oacc[4];
    { const LAS unsigned char* atA = lds + G_AT + (16 * ib + r16) * 144 + g * 16; const LAS unsigned char* qpA = lds + G_QP + (16 * ib + r16) * 144 + g * 16;
#pragma unroll
        for (int q4 = 0; q4 < 4; ++q4) { const int dvb = 4 * dvh + q4;
            const LAS unsigned char* vtB = lds + G_VT + (16 * dvb + r16) * 144 + g * 16; const LAS unsigned char* stB = lds + G_ST + (16 * dvb + r16) * 144 + g * 16;
            f32x4 acc = (f32x4){0.f, 0.f, 0.f, 0.f};
#pragma unroll
            for (int ks = 0; ks < 2; ++ks) { acc = MFMA16(*(const LAS bf16x8*)(vtB + ks * 64), *(const LAS bf16x8*)(atA + ks * 64), acc);
                acc = MFMA16(*(const LAS bf16x8*)(stB + ks * 64), *(const LAS bf16x8*)(qpA + ks * 64), acc); }
            oacc[q4] = acc; } }
    LAS float* SSQ = (LAS float*)(lds + G_SSQ);
    { float pr = 0.f;
#pragma unroll
        for (int q4 = 0; q4 < 4; ++q4) pr += (oacc[q4][0] * oacc[q4][0] + oacc[q4][1] * oacc[q4][1]) + (oacc[q4][2] * oacc[q4][2] + oacc[q4][3] * oacc[q4][3]);
        pr += __shfl_xor(pr, 16); pr += __shfl_xor(pr, 32);
        if (g == 0) SSQ[dvh * 64 + 16 * ib + r16] = pr; }
    __syncthreads();
    { const int i = 16 * ib + r16; const float rinv = rsqrtf((SSQ[i] + SSQ[64 + i]) * (1.0f / 128.0f) + RMS_EPS);
        GAS bf16_t* Yr = (GAS bf16_t*)(p.ws + WS_Y) + (size_t)(64 * c + i) * DM + 1024 + hb * 128;
#pragma unroll
        for (int q4 = 0; q4 < 4; ++q4) { const int dv0 = 16 * (4 * dvh + q4) + 4 * g; const u32x2 z = zpre[q4]; const f32x4 gg = gpre[q4];
            const float y0 = oacc[q4][0] * rinv * gg.x * silu_f(bflo(z.x)), y1 = oacc[q4][1] * rinv * gg.y * silu_f(bfhi(z.x)), y2 = oacc[q4][2] * rinv * gg.z * silu_f(bflo(z.y)), y3 = oacc[q4][3] * rinv * gg.w * silu_f(bfhi(z.y));
            u32x2 yo; yo.x = pk2(y0, y1); yo.y = pk2(y2, y3); *(GAS u32x2*)(Yr + dv0) = yo; } }
    __syncthreads();
}

__device__ __forceinline__ void ln_phase(const Params& p, int l, const float* tin, float* fout) {
    int tid_ = threadIdx.x; asm volatile("" : "+v"(tid_)); const int tid = tid_, lane = tid & 63, wave = tid >> 6;
    const int gw = blockIdx.x * 8 + wave, NGW = gridDim.x * 8;
    const float* lg = p.ln_g + l * DM; const float* lb = p.ln_b + l * DM; bf16_t* xb = (bf16_t*)(p.ws + WS_XB);
    for (int row = gw; row < SEQ; row += NGW) {
        const f32x4* xr = (const f32x4*)(tin + (size_t)row * DM) + lane;
        f32x4 v[8]; float s = 0.f;
#pragma unroll
        for (int j = 0; j < 8; ++j) { v[j] = xr[64 * j]; s += (v[j].x + v[j].y) + (v[j].z + v[j].w); }
#pragma unroll
        for (int o = 1; o < 64; o <<= 1) s += __shfl_xor(s, o);
        const float mean = s * (1.0f / DM); float s2 = 0.f;
#pragma unroll
        for (int j = 0; j < 8; ++j) { v[j] = v[j] - mean; s2 += (v[j].x * v[j].x + v[j].y * v[j].y) + (v[j].z * v[j].z + v[j].w * v[j].w); }
#pragma unroll
        for (int o = 1; o < 64; o <<= 1) s2 += __shfl_xor(s2, o);
        const float rstd = rsqrtf(s2 * (1.0f / DM) + LN_EPS);
        f32x4* orow = (f32x4*)(fout + (size_t)row * DM) + lane; u32x2* brow = (u32x2*)(xb + (size_t)row * DM) + lane;
#pragma unroll
        for (int j = 0; j < 8; ++j) { const f32x4 gg = ((const f32x4*)lg)[lane + 64 * j], bb = ((const f32x4*)lb)[lane + 64 * j];
            const f32x4 y = v[j] * rstd * gg + bb; orow[64 * j] = y; u32x2 o2; o2.x = pk2(y.x, y.y); o2.y = pk2(y.z, y.w); brow[64 * j] = o2; }
    }
}

#define XB_TMO      128
#define XB_XCNT(j)  (256  + 64 * (j))
#define XB_XSUB(j)  (1280 + 64 * (j))
#define XB_XGEN(j)  (2304 + 64 * (j))
#define XB_TOP      3328
#define XB_TOPGEN   3392
#define XCD_BAR_WORDS 3456
#define XB_SPIN_CAP (1u << 18)

__device__ __forceinline__ unsigned xb_ld(unsigned* p)              { return __hip_atomic_load(p, __ATOMIC_RELAXED, __HIP_MEMORY_SCOPE_AGENT); }
__device__ __forceinline__ unsigned xb_add(unsigned* p, unsigned v) { return __hip_atomic_fetch_add(p, v, __ATOMIC_RELAXED, __HIP_MEMORY_SCOPE_AGENT); }
__device__ __forceinline__ unsigned xb_xcc_id() { return (unsigned)__builtin_amdgcn_s_getreg((3 << 11) | 20) & 0xFu; }
#define XB_SPIN(cond, bar) do { unsigned _sp = 0; while (cond) { __builtin_amdgcn_s_sleep(1); \
    if ((++_sp & 255u) == 0u) { if (xb_ld(&(bar)[XB_TMO])) break; if (_sp > XB_SPIN_CAP) { atomicAdd(&(bar)[XB_TMO], 1u); break; } } } } while (0)

struct XcdBarrier {
    unsigned* bar; unsigned x;
    volatile LAS unsigned* st;
};

__device__ __forceinline__ XcdBarrier xcd_barrier_post(unsigned* bar, volatile LAS unsigned* st) {
    XcdBarrier b; b.bar = bar; b.x = xb_xcc_id(); b.st = st;
    if (threadIdx.x == 0) (void)xb_add(&bar[XB_XCNT(b.x)], 1u);
    return b;
}
__device__ __forceinline__ void xcd_barrier_complete(unsigned* bar, unsigned x, unsigned& nloc, unsigned& nx) {
    const unsigned G = gridDim.x * gridDim.y * gridDim.z;
    unsigned sum, cnt, mine, sp = 0u;
    for (;;) {
        sum = 0u; cnt = 0u; mine = 0u;
#pragma unroll
        for (unsigned j = 0; j < 16; ++j) { const unsigned c = xb_ld(&bar[XB_XCNT(j)]); sum += c; cnt += (c > 0u) ? 1u : 0u; mine = (j == x) ? c : mine; }
        if (sum == G) break;
        __builtin_amdgcn_s_sleep(1);
        if ((++sp & 255u) == 0u) { if (xb_ld(&bar[XB_TMO])) break; if (sp > XB_SPIN_CAP) { atomicAdd(&bar[XB_TMO], 1u); break; } }
    }
    nloc = mine > 0u ? mine : 1u; nx = cnt > 0u ? cnt : 1u;
}

__device__ __forceinline__ void xcd_barrier(const XcdBarrier& b) {
    asm volatile("s_waitcnt vmcnt(0)" ::: "memory");
    __syncthreads();
    if (threadIdx.x == 0) {
        unsigned* bar = b.bar;
        __builtin_amdgcn_s_waitcnt(0);
        unsigned nloc = b.st[0], nx = b.st[1];
        if (nloc == 0u) { xcd_barrier_complete(bar, b.x, nloc, nx); b.st[0] = nloc; b.st[1] = nx; }
        const unsigned old = xb_add(&bar[XB_XSUB(b.x)], 1u);
        const unsigned gen = old / nloc;
        if (old + 1u == (gen + 1u) * nloc) {
            __builtin_amdgcn_fence(__ATOMIC_RELEASE, "agent");
            asm volatile("s_waitcnt vmcnt(0)" ::: "memory");
            const unsigned og = xb_add(&bar[XB_TOP], 1u);
            const unsigned tg = og / nx;
            if (og + 1u == (tg + 1u) * nx) xb_add(&bar[XB_TOPGEN], 1u);
            else XB_SPIN(xb_ld(&bar[XB_TOPGEN]) == tg, bar);
            __builtin_amdgcn_fence(__ATOMIC_ACQUIRE, "agent");
            xb_add(&bar[XB_XGEN(b.x)], 1u);
            asm volatile("s_waitcnt vmcnt(0)" ::: "memory");
        } else {
            XB_SPIN(xb_ld(&bar[XB_XGEN(b.x)]) == gen, bar);
            __builtin_amdgcn_fence(__ATOMIC_ACQUIRE, "agent");
            asm volatile("s_waitcnt vmcnt(0)" ::: "memory");
        }
    }
    __syncthreads();
}

constexpr int NPH = 1 + 6 * DEPTH;
__global__ void __launch_bounds__(512, 2) mega(Params p_in) {
    extern __shared__ __attribute__((aligned(16))) unsigned char lds_raw[];
    LAS unsigned char* lds = (LAS unsigned char*)lds_raw;
    cg::grid_group grid = cg::this_grid();
    const int bid = blockIdx.x, G = gridDim.x;
    volatile LAS unsigned* misc = (volatile LAS unsigned*)(lds + LDS_BYTES - 64);
    if (threadIdx.x < 16) misc[threadIdx.x] = 0u;
    __syncthreads();
    const XcdBarrier bar = xcd_barrier_post((unsigned*)(p_in.ws + WS_CTL), misc);
    if (p_in.ph_hi < 0) grid.sync();
    const Params& p0 = p_in;
    for (int ph = p0.ph_lo; ph < p0.ph_hi; ++ph) {
        Params p = p0; asm volatile("" : "+s"(p.ws));
        bf16_t* xb = (bf16_t*)(p.ws + WS_XB); float* xf = (float*)(p.ws + WS_XF);
        bf16_t* hm = (bf16_t*)(p.ws + WS_HM); bf16_t* VT = (bf16_t*)(p.ws + WS_VT); bf16_t* Y = (bf16_t*)(p.ws + WS_Y);
        if (ph == 0) phase0(p, lds);
        else {
            const int l = (ph - 1) / 6, k = (ph - 1) % 6;
            const bf16_t* win = (const bf16_t*)(p.ws + WS_WIN + l * WIN_L);
            if (k == 0) {
                for (int gi = 0; gi < 4; ++gi) {
                    pg8::Gemm g; bf16_t* O; int ldc, c;
                    if (gi == 0) { g.A = xb; g.Bt = win; g.M = SEQ; g.N = NMAIN; O = hm; ldc = NMAIN; c = bid; }
                    else if (gi == 1) { g.A = win + (size_t)NMAIN * DM; g.Bt = xb; g.M = NVT; g.N = SEQ; O = VT; ldc = LDV; c = G - 1 - bid; }
                    else if (gi == 2) { g.A = (const bf16_t*)(p.ws + WS_MEMB); g.Bt = (const bf16_t*)(p.ws + WS_WMK) + (size_t)l * 512 * DM; g.M = NMEM; g.N = 512; O = (bf16_t*)(p.ws + WS_MK) + l * 512; ldc = 2048;
                        c = (bid >= G - 16 && bid < G - 14) ? bid - (G - 16) : (1 << 24); }
                    else { g.A = (const bf16_t*)(p.ws + WS_WMV) + (size_t)l * 512 * DM; g.Bt = (const bf16_t*)(p.ws + WS_MEMB); g.M = 512; g.N = NMEM; O = (bf16_t*)(p.ws + WS_MVT) + (size_t)l * 512 * NMEM; ldc = NMEM;
                        c = (bid >= G - 14 && bid < G - 12) ? bid - (G - 14) : (1 << 24); }
                    g.K = DM;
                    pg8::StaticOrder S; S.init(g.M, g.N, G, c);
                    pg8::EpiBf16<0> E{O, ldc, nullptr, 0, 0, 1.f};
                    pg8::gemm_phase<pg8::EpiBf16<0>, pg8::StaticOrder, true, true>(lds, g, S, E);
                }
                if (l + 1 < DEPTH) {
                    int wkb = bid, nwb = G;
                    if (G == 256) { nwb = 144; wkb = bid < 64 ? bid : (bid >= 160 && bid < 240 ? bid - 96 : -1); }
                    if (wkb >= 0) { int t2_ = threadIdx.x; asm volatile("" : "+v"(t2_)); convert_layer(p, l + 1, lds, wkb * 8 + (t2_ >> 6), nwb * 8); }
                }
            } else if (k == 1) {
                for (int u = bid; u < 256; u += G) band_pair_unit(lds, p, l, u >> 2, 2 * (u & 3));
                for (int u = bid; u < 256; u += G) { const int head = u & 3, qb = u >> 2;
                    attn_unit<false>(lds, 128 * qb, hm + C_MQ + head * 128, NMAIN, (const bf16_t*)(p.ws + WS_MK) + l * 512 + head * 128, 2048,
                                     (const bf16_t*)(p.ws + WS_MVT) + (size_t)(l * 512 + head * 128) * NMEM, NMEM, hm + C_MZ + head * 128, NMAIN, Y + 1536 + head * 128, DM, nullptr, 0); }
                for (int u = bid; u < 512; u += G) gla_part1(lds, p, l, u >> 2, u & 3);
            } else if (k == 2) gla_scan(p, lds);
            else if (k == 3) {
                int t3_ = threadIdx.x; asm volatile("" : "+v"(t3_)); const int tid3 = t3_, w3 = __builtin_amdgcn_readfirstlane(tid3 >> 6), r3 = tid3 & 15, g3 = (tid3 & 63) >> 4;
                if (G == 256) {
                    Gla2Regs RA, RB; const int u = bid, u2 = bid + 256;
                    gla_part2_load(RA, p, l, u >> 2, u & 3, tid3, w3, r3, g3);
                    gla_part2_load(RB, p, l, u2 >> 2, u2 & 3, tid3, w3, r3, g3);
                    gla_part2(lds, p, l, u >> 2, u & 3, RA, tid3, w3, r3, g3);
                    gla_part2(lds, p, l, u2 >> 2, u2 & 3, RB, tid3, w3, r3, g3);
                } else {
                    for (int u = bid; u < 512; u += G) { Gla2Regs RA; gla_part2_load(RA, p, l, u >> 2, u & 3, tid3, w3, r3, g3); gla_part2(lds, p, l, u >> 2, u & 3, RA, tid3, w3, r3, g3); }
                }
            }
            else if (k == 4) {
                pg8::Gemm g; g.A = Y; g.Bt = (const bf16_t*)(p.ws + WS_WOUT + l * WOUT_L); g.M = SEQ; g.N = DM; g.K = DM;
                pg8::StaticOrder S; S.init(SEQ, DM, G, bid);
                if (G == 256) {
                    pg8::EpiResLn E{l == 0 ? p.x : (const float*)nullptr, l == DEPTH - 1 ? p.out : (float*)nullptr, xb, (bf16_t*)(p.ws + WS_XL), p.ln_g + l * DM, p.ln_b + l * DM, (unsigned long long*)(p.ws + WS_XCH),
                                    (unsigned*)(p.ws + WS_CTL) + CW_CNT + l * 2048, 1.6817928305074292f, LN_EPS};
                    pg8::gemm_phase<pg8::EpiResLn, pg8::StaticOrder, false, true>(lds, g, S, E);
                } else {
                    pg8::EpiResid E{l == 0 ? p.x : xf, xf, DM, 1.6817928305074292f};
                    pg8::gemm_phase<pg8::EpiResid, pg8::StaticOrder, true, true>(lds, g, S, E);
                }
            } else if (G != 256) ln_phase(p, l, xf, l == DEPTH - 1 ? p.out : xf);
        }
        if (ph + 1 < p0.ph_hi && !(G == 256 && ph > 0 && (ph - 1) % 6 == 4)) xcd_barrier(bar);
    }
}

extern "C" void kernel_launch(void* const* d_in, const int* in_sizes, int n_in, void* d_out, int out_size, void* d_ws, size_t ws_size, hipStream_t stream) {
    static int grid = 0;
    if (grid == 0) {
        if (n_in != 11 || ws_size < WS_END) { fprintf(stderr, "kernel_launch: unexpected inputs (n_in %d, ws %zu)\n", n_in, ws_size); grid = -1; return; }
        int dev = 0, cus = 0, per_cu = 0;
        hipGetDevice(&dev); hipDeviceGetAttribute(&cus, hipDeviceAttributeMultiprocessorCount, dev);
        hipFuncSetAttribute((const void*)mega, hipFuncAttributeMaxDynamicSharedMemorySize, LDS_BYTES);
        hipOccupancyMaxActiveBlocksPerMultiprocessor(&per_cu, (const void*)mega, 512, LDS_BYTES);
        if (per_cu < 1) per_cu = 1;
        (void)hipGetLastError();
        grid = cus * per_cu;
    }
    if (grid < 0) return;
    Params p{};
    p.x = (const float*)d_in[0]; p.mem = (const float*)d_in[1]; p.w_in = (const float*)d_in[2]; p.rel = (const float*)d_in[3]; p.gate_w = (const float*)d_in[4];
    p.gate_b = (const float*)d_in[5]; p.norm_g = (const float*)d_in[6]; p.w_mkv = (const float*)d_in[7]; p.w_out = (const float*)d_in[8]; p.ln_g = (const float*)d_in[9]; p.ln_b = (const float*)d_in[10];
    p.out = (float*)d_out; p.ws = (unsigned char*)d_ws;
    if (hipMemsetAsync((char*)d_ws + WS_CTL, 0, CTL_BYTES, stream) != hipSuccess) { fprintf(stderr, "memset failed\n"); return; }
#if defined(MK_MULTI)
    for (int ph = 0; ph < NPH; ++ph) { p.ph_lo = ph; p.ph_hi = ph + 1; hipLaunchKernelGGL(mega, dim3(grid), dim3(512), LDS_BYTES, stream, p); }
#else
    p.ph_lo = 0; p.ph_hi = NPH;
    void* args[] = {&p};
    hipError_t e = hipLaunchCooperativeKernel((const void*)mega, dim3(grid), dim3(512), args, LDS_BYTES, stream);
    if (e != hipSuccess) fprintf(stderr, "cooperative launch failed: %s (grid %d)\n", hipGetErrorString(e), grid);
#endif
}
```

```cpp
#include <hip/hip_runtime.h>
#include <hip/hip_cooperative_groups.h>
#include <cstdio>
#include <cstdint>
namespace cg = cooperative_groups;
namespace pg8 {
#define PG8_LAS __attribute__((address_space(3)))
typedef unsigned short bf16_t;
typedef short bf16x8 __attribute__((ext_vector_type(8)));
typedef float f32x4 __attribute__((ext_vector_type(4)));
typedef unsigned u32x4 __attribute__((ext_vector_type(4)));
constexpr int BM = 256, BK = 64, HALF = 128, HTB = HALF * BK * 2  , STAGE_BYTES = 8 * HTB, NXCD = 8, WGM = 8;

__host__ __device__ __forceinline__ int lds_byte(int r, int c) { const int st = (r >> 4) * 2 + (c >> 5), rr = r & 15, cc = c & 31, ob = rr * 64 + cc * 2; return st * 1024 + (ob ^ (((ob >> 9) & 1) << 5)); }
__host__ __device__ __forceinline__ void stage_rc(int b, int& R, int& C) { const int st = b / 1024, sb = b % 1024, swz = sb ^ (((sb >> 9) & 1) << 5); R = (st >> 1) * 16 + swz / 64; C = (st & 1) * 32 + (swz % 64) / 2; }
__host__ __device__ __forceinline__ int perm32(int rho) { const int n = rho >> 4, i = rho & 15; return 8 * (i >> 2) + 4 * n + (i & 3); }

struct Unit { int pm, pn; };
struct Gemm { const bf16_t* A; const bf16_t* Bt; int M, N, K; };

struct StaticOrder {
    int nM, nN, nwg, G, c;
    __host__ __device__ void init(int M, int N, int G_, int c_) { nM = M / BM; nN = N / BM; nwg = nM * nN; G = G_; c = c_; }
    __host__ __device__ bool next(int i, Unit& u) const {
        const long L = (long)i * G + c; if (L >= nwg) return false;
        int wgid = (int)L; { const int q = nwg / NXCD, r = nwg % NXCD, xcd = wgid % NXCD, off = wgid / NXCD; wgid = (xcd < r ? xcd * (q + 1) : r * (q + 1) + (xcd - r) * q) + off; }
        const int nig = WGM * nN, gid = wgid / nig, fm = gid * WGM, gsz = (nM - fm) < WGM ? (nM - fm) : WGM;
        u.pm = fm + ((wgid % nig) % gsz); u.pn = (wgid % nig) / gsz; return true;
    }
    __device__ __forceinline__ void a_ready(const Unit&) const {}
    __device__ __forceinline__ void done(const Unit&) const {}
};

__device__ __forceinline__ unsigned cvt_pk_bf16(float lo, float hi) { unsigned r; asm volatile("v_cvt_pk_bf16_f32 %0, %1, %2" : "=v"(r) : "v"(lo), "v"(hi)); return r; }
typedef float f32x2 __attribute__((ext_vector_type(2)));
__device__ __forceinline__ f32x2 gelu_pk(f32x2 v) {
    const f32x2 av = __builtin_elementwise_abs(v), d = av * 0.2316418882f + 1.0f;
    f32x2 t; t.x = __builtin_amdgcn_rcpf(d.x); t.y = __builtin_amdgcn_rcpf(d.y);
    f32x2 q = t * 0.5307027145f + (-0.7265760135f); q = q * t + 0.7107068705f; q = q * t + (-0.142248368f); q = q * t + 0.127414796f; q = q * t;
    const f32x2 s = (v * v) * (-0.72134752044f);
    f32x2 e; e.x = __builtin_amdgcn_exp2f(s.x); e.y = __builtin_amdgcn_exp2f(s.y);
    const f32x2 m = v * (q * e), r = v - m;
    f32x2 o; o.x = v.x < 0.f ? m.x : r.x; o.y = v.y < 0.f ? m.y : r.y; return o;
}

template <int ACT  > struct EpiBf16 {
    static constexpr bool PERM = true, AFTER_DRAIN = false; static_assert(ACT == 0 || ACT == 1, "EpiBf16: ACT is 0 (none) or 1 (gelu_pk)");
    bf16_t* O; int ldc; const float* bias; int split_cols; size_t split_stride; float scale0;
    __device__ __forceinline__ void operator()(const f32x4 (&acc)[2][2][4][2], const Unit& u, int wr, int wc, int fr, int fq) const {
        const int row0 = u.pm * BM + wr * 64 + fr; int colt = u.pn * BM; bf16_t* base = O;
        float sc = 1.f; if (split_cols) { const int t = colt / split_cols; base += (size_t)t * split_stride; colt -= t * split_cols; if (t == 0) sc = scale0; }
        const int col0 = colt + wc * 32 + 8 * fq, bcol0 = u.pn * BM + wc * 32 + 8 * fq;
        f32x4 bv[2][2];
#pragma unroll
        for (int bj = 0; bj < 2; ++bj)
#pragma unroll
            for (int n = 0; n < 2; ++n) bv[bj][n] = bias ? *(const f32x4*)(bias + bcol0 + bj * HALF + 4 * n) : (f32x4){0.f, 0.f, 0.f, 0.f};
#pragma unroll
        for (int ai = 0; ai < 2; ++ai)
#pragma unroll
            for (int m = 0; m < 4; ++m) { bf16_t* rowp = base + (size_t)(row0 + ai * HALF + m * 16) * ldc + col0;
#pragma unroll
                for (int bj = 0; bj < 2; ++bj) { f32x4 v0 = acc[ai][bj][m][0] + bv[bj][0], v1 = acc[ai][bj][m][1] + bv[bj][1];
                    if (ACT == 1) { f32x2 a = gelu_pk((f32x2){v0[0], v0[1]}), b = gelu_pk((f32x2){v0[2], v0[3]}), c = gelu_pk((f32x2){v1[0], v1[1]}), d = gelu_pk((f32x2){v1[2], v1[3]});
                        v0 = (f32x4){a.x, a.y, b.x, b.y}; v1 = (f32x4){c.x, c.y, d.x, d.y}; }
                    v0 = v0 * sc; v1 = v1 * sc; u32x4 w; w.x = cvt_pk_bf16(v0[0], v0[1]); w.y = cvt_pk_bf16(v0[2], v0[3]); w.z = cvt_pk_bf16(v1[0], v1[1]); w.w = cvt_pk_bf16(v1[2], v1[3]);
                    *(u32x4*)(rowp + bj * HALF) = w; } }
    }
};
template <class Epi, class Sched, bool ALIGN_EPI = false, bool SP2 = false>
__device__ __forceinline__ void gemm_phase(PG8_LAS unsigned char* lds, const Gemm g, const Sched& S, const Epi& E) {
    int tid_ = threadIdx.x; asm volatile("" : "+v"(tid_)); const int tid = tid_, wid = __builtin_amdgcn_readfirstlane(tid >> 6), lane = tid & 63, wr = wid >> 2, wc = wid & 3, fr = lane & 15, fq = lane >> 4;
    const int K = g.K, nt = K / BK;
    unsigned voffA[2], voffB[2];
#pragma unroll
    for (int i = 0; i < 2; ++i) { int R, C; stage_rc(tid * 16 + i * 8192, R, C); const int Rb = Epi::PERM ? ((R & ~31) + perm32(R & 31)) : R;
        voffA[i] = (unsigned)(R * K + C) * 2u; voffB[i] = (unsigned)(Rb * K + C) * 2u; }
    const size_t kstep = (size_t)(BK * 2);
    const size_t hstep = (size_t)HALF * K * 2;
    const size_t tstep = 2 * hstep;
    const unsigned ldsw = (unsigned)wid * 1024u;
    const int aoff = lds_byte(wr * 64 + fr, fq * 8), boff = lds_byte(wc * 32 + fr, fq * 8);
#define PG8_SA(b, h) (((b) * 2 + (h)) * HTB)
#define PG8_SB(b, h) ((4 + (b) * 2 + (h)) * HTB)
#define PG8_STAGE(bufoff, gbase, voff) do { _Pragma("unroll") for (int _i = 0; _i < 2; ++_i) \
        __builtin_amdgcn_global_load_lds((const unsigned*)((const char*)(gbase) + (voff)[_i]), (PG8_LAS unsigned*)(lds + (bufoff) + ldsw + _i * 8192), 16, 0, 0); } while (0)
#define PG8_LDA(dst, b, h) do { _Pragma("unroll") for (int m = 0; m < 4; ++m) _Pragma("unroll") for (int k = 0; k < 2; ++k) dst[m][k] = *(const PG8_LAS bf16x8*)(lds + PG8_SA(b, h) + aoff + m * 2048 + k * 1024); } while (0)
#define PG8_LDB(dst, b, h) do { _Pragma("unroll") for (int n = 0; n < 2; ++n) _Pragma("unroll") for (int k = 0; k < 2; ++k) dst[n][k] = *(const PG8_LAS bf16x8*)(lds + PG8_SB(b, h) + boff + n * 2048 + k * 1024); } while (0)
#define PG8_MMA(ai, bj, At, Bt) do { __builtin_amdgcn_s_setprio(1); _Pragma("unroll") for (int m = 0; m < 4; ++m) _Pragma("unroll") for (int n = 0; n < 2; ++n) _Pragma("unroll") for (int k = 0; k < 2; ++k) \
        acc[ai][bj][m][n] = __builtin_amdgcn_mfma_f32_16x16x32_bf16(Bt[n][k], At[m][k], acc[ai][bj][m][n], 0, 0, 0); __builtin_amdgcn_s_setprio(0); } while (0)
#define PG8_WAIT_V(n) asm volatile("s_waitcnt vmcnt(" #n ")" ::: "memory")
#define PG8_WAIT_L(n) asm volatile("s_waitcnt lgkmcnt(" #n ")" ::: "memory")
#define PG8_BAR __builtin_amdgcn_s_barrier()
#define PG8_SCHED __builtin_amdgcn_sched_barrier(0)
    Unit cur, nxt; int ui = 0;
    if (!S.next(0, cur)) return;
    f32x4 acc[2][2][4][2];
#pragma unroll
    for (int a = 0; a < 2; ++a)
#pragma unroll
        for (int b = 0; b < 2; ++b)
#pragma unroll
            for (int m = 0; m < 4; ++m)
#pragma unroll
                for (int n = 0; n < 2; ++n) acc[a][b][m][n] = (f32x4){0.f, 0.f, 0.f, 0.f};
    bf16x8 At[4][2], B0[2][2], B1[2][2];
    const char* cA = (const char*)g.A + (size_t)cur.pm * tstep; const char* cB = (const char*)g.Bt + (size_t)cur.pn * tstep;
    S.a_ready(cur);
    if constexpr (SP2) {
        PG8_STAGE(PG8_SB(0, 0), cB, voffB); PG8_STAGE(PG8_SB(0, 1), cB + hstep, voffB); PG8_STAGE(PG8_SA(0, 0), cA, voffA); PG8_STAGE(PG8_SA(0, 1), cA + hstep, voffA);
        if (wr == 1) PG8_BAR;
        PG8_WAIT_V(2); PG8_BAR;
        PG8_STAGE(PG8_SB(1, 0), cB + kstep, voffB); PG8_STAGE(PG8_SA(1, 0), cA + kstep, voffA); PG8_STAGE(PG8_SB(1, 1), cB + hstep + kstep, voffB);
        PG8_WAIT_V(6); PG8_BAR;
    } else {
        PG8_STAGE(PG8_SB(0, 0), cB, voffB); PG8_STAGE(PG8_SA(0, 0), cA, voffA); PG8_STAGE(PG8_SB(0, 1), cB + hstep, voffB); PG8_STAGE(PG8_SA(0, 1), cA + hstep, voffA);
        if (wr == 1) PG8_BAR;
        PG8_WAIT_V(4); PG8_BAR;
        PG8_STAGE(PG8_SB(1, 0), cB + kstep, voffB); PG8_STAGE(PG8_SA(1, 0), cA + kstep, voffA); PG8_STAGE(PG8_SB(1, 1), cB + hstep + kstep, voffB);
        PG8_WAIT_V(6); PG8_BAR;
    }
    for (;;) {
        const bool has_next = S.next(ui + 1, nxt);
        const char* nA = has_next ? (const char*)g.A + (size_t)nxt.pm * tstep : cA; const char* nB = has_next ? (const char*)g.Bt + (size_t)nxt.pn * tstep : cB;
        for (int t = 0; t < nt; t += 2) {
            const bool last = (t == nt - 2);
            const char* a1 = cA + (size_t)(t + 1) * kstep;
            const char* a2 = last ? nA : cA + (size_t)(t + 2) * kstep; const char* b2 = last ? nB : cB + (size_t)(t + 2) * kstep;
            const char* a3 = a2 + kstep; const char* b3 = b2 + kstep;
            if (last && has_next) S.a_ready(nxt);
            if constexpr (SP2) {
            PG8_LDB(B0, 0, 0); PG8_LDB(B1, 0, 1); PG8_SCHED; PG8_LDA(At, 0, 0); PG8_STAGE(PG8_SA(1, 1), a1 + hstep, voffA);
            PG8_WAIT_V(8); PG8_WAIT_L(0); PG8_BAR; PG8_MMA(0, 0, At, B0); PG8_MMA(0, 1, At, B1); PG8_BAR; PG8_SCHED;
            PG8_LDA(At, 0, 1); PG8_STAGE(PG8_SB(0, 0), b2, voffB); PG8_STAGE(PG8_SB(0, 1), b2 + hstep, voffB); PG8_STAGE(PG8_SA(0, 0), a2, voffA);
            PG8_WAIT_V(8); PG8_WAIT_L(0); PG8_BAR; PG8_MMA(1, 0, At, B0); PG8_MMA(1, 1, At, B1); PG8_BAR; PG8_SCHED;
            PG8_LDB(B0, 1, 0); PG8_LDB(B1, 1, 1); PG8_SCHED; PG8_LDA(At, 1, 0); PG8_STAGE(PG8_SA(0, 1), a2 + hstep, voffA);
            PG8_WAIT_V(8); PG8_WAIT_L(0); PG8_BAR; PG8_MMA(0, 0, At, B0); PG8_MMA(0, 1, At, B1); PG8_BAR; PG8_SCHED;
            PG8_LDA(At, 1, 1); PG8_STAGE(PG8_SB(1, 0), b3, voffB); PG8_STAGE(PG8_SB(1, 1), b3 + hstep, voffB); PG8_STAGE(PG8_SA(1, 0), a3, voffA);
            PG8_WAIT_V(8); PG8_WAIT_L(0); PG8_BAR; PG8_MMA(1, 0, At, B0); PG8_MMA(1, 1, At, B1); PG8_BAR; PG8_SCHED;
            } else {
            PG8_LDB(B0, 0, 0); PG8_SCHED; PG8_LDA(At, 0, 0); PG8_STAGE(PG8_SA(1, 1), a1 + hstep, voffA);
            PG8_WAIT_L(8); PG8_BAR; PG8_WAIT_L(0); PG8_MMA(0, 0, At, B0); PG8_BAR; PG8_SCHED;
            PG8_LDB(B1, 0, 1); PG8_STAGE(PG8_SB(0, 0), b2, voffB);
            PG8_BAR; PG8_WAIT_L(0); PG8_MMA(0, 1, At, B1); PG8_BAR;
            PG8_LDA(At, 0, 1); PG8_STAGE(PG8_SA(0, 0), a2, voffA);
            PG8_BAR; PG8_WAIT_L(0); PG8_MMA(1, 0, At, B0); PG8_BAR; PG8_SCHED;
            PG8_STAGE(PG8_SB(0, 1), b2 + hstep, voffB);
            PG8_WAIT_V(6); PG8_BAR; PG8_MMA(1, 1, At, B1); PG8_BAR;
            PG8_LDB(B0, 1, 0); PG8_SCHED; PG8_LDA(At, 1, 0); PG8_STAGE(PG8_SA(0, 1), a2 + hstep, voffA);
            PG8_WAIT_L(8); PG8_BAR; PG8_WAIT_L(0); PG8_MMA(0, 0, At, B0); PG8_BAR; PG8_SCHED;
            PG8_LDB(B1, 1, 1); PG8_STAGE(PG8_SB(1, 0), b3, voffB);
            PG8_BAR; PG8_WAIT_L(0); PG8_MMA(0, 1, At, B1); PG8_BAR;
            PG8_LDA(At, 1, 1); PG8_STAGE(PG8_SA(1, 0), a3, voffA);
            PG8_BAR; PG8_WAIT_L(0); PG8_MMA(1, 0, At, B0); PG8_BAR; PG8_SCHED;
            PG8_STAGE(PG8_SB(1, 1), b3 + hstep, voffB);
            PG8_WAIT_V(6); PG8_BAR; PG8_MMA(1, 1, At, B1); PG8_BAR;
            }
        }
        if constexpr (ALIGN_EPI) { if (wr == 0) PG8_BAR; }
        if constexpr (!Epi::AFTER_DRAIN) { E(acc, cur, wr, wc, fr, fq); S.done(cur); }
        if (!has_next) break;
#pragma unroll
        for (int a = 0; a < 2; ++a)
#pragma unroll
            for (int b = 0; b < 2; ++b)
#pragma unroll
                for (int m = 0; m < 4; ++m)
#pragma unroll
                    for (int n = 0; n < 2; ++n) acc[a][b][m][n] = (f32x4){0.f, 0.f, 0.f, 0.f};
        cur = nxt; cA = nA; cB = nB; ++ui;
        if constexpr (ALIGN_EPI) { if (wr == 1) PG8_BAR; }
    }
    PG8_WAIT_V(0);
    if constexpr (!ALIGN_EPI) { if (wr == 0) PG8_BAR; }
    PG8_BAR;
    if constexpr (Epi::AFTER_DRAIN) { E.fused(acc, cur, wr, wc, fr, fq, lds, wid, lane); S.done(cur); }
#undef PG8_SA
#undef PG8_SB
#undef PG8_STAGE
#undef PG8_LDA
#undef PG8_LDB
#undef PG8_MMA
#undef PG8_WAIT_V
#undef PG8_WAIT_L
#undef PG8_BAR
#undef PG8_SCHED
}
}

namespace pg8 {
struct EpiResid {
    static constexpr bool PERM = false, AFTER_DRAIN = false;
    const float* base; float* out; int ldc; float alpha;
    __device__ __forceinline__ void operator()(const f32x4 (&acc)[2][2][4][2], const Unit& u, int wr, int wc, int fr, int fq) const {
        const int col0 = u.pn * BM + wc * 32 + 4 * fq;
#pragma unroll
        for (int ai = 0; ai < 2; ++ai)
#pragma unroll
            for (int m = 0; m < 4; ++m) { const int r = ai * HALF + wr * 64 + m * 16 + fr; const size_t off = (size_t)(u.pm * BM + r) * ldc + col0;
#pragma unroll
                for (int bj = 0; bj < 2; ++bj)
#pragma unroll
                    for (int n = 0; n < 2; ++n) { const f32x4 bs = *(const f32x4*)(base + off + bj * HALF + n * 16);
                        const f32x4 o = bs * alpha + acc[ai][bj][m][n]; *(f32x4*)(out + off + bj * HALF + n * 16) = o; }
                if (m & 1) asm volatile("" ::: "memory"); }
    }
};

struct EpiResLn {
    static constexpr bool PERM = false, AFTER_DRAIN = true;
    const float* base; float* out; bf16_t* xn; bf16_t* xl; const float* lg; const float* lb; unsigned long long* xbuf; unsigned* cnt; float alpha, eps;
    __device__ __forceinline__ void fused(f32x4 (&acc)[2][2][4][2], const Unit& u, int wr, int wc, int fr, int fq, PG8_LAS unsigned char* lds, int wid, int lane) const {
        typedef float f32x2v __attribute__((ext_vector_type(2))); typedef unsigned u32x2v __attribute__((ext_vector_type(2)));
        PG8_LAS f32x2v* P = (PG8_LAS f32x2v*)lds;
        PG8_LAS f32x2v* S = (PG8_LAS f32x2v*)(lds + 8192);
        const int col0 = u.pn * BM + wc * 32 + 4 * fq;
        const int tid_ = wid * 64 + lane; bf16_t* xl_t = xl + (size_t)(u.pm * 8 + u.pn) * 65536;
#pragma unroll
        for (int ai = 0; ai < 2; ++ai)
#pragma unroll
            for (int m = 0; m < 4; ++m) { const size_t off = (size_t)(u.pm * BM + ai * HALF + wr * 64 + m * 16 + fr) * 2048 + col0;
#pragma unroll
                for (int bj = 0; bj < 2; ++bj) { u32x4 lo16 = (u32x4){0u, 0u, 0u, 0u};
                    if (!base) lo16 = *(const u32x4*)(xl_t + ((size_t)(((ai * 4 + m) * 2 + bj) * 512 + tid_) * 8));
#pragma unroll
                    for (int n = 0; n < 2; ++n) { f32x4 bs;
                        if (base) bs = *(const f32x4*)(base + off + bj * HALF + n * 16);
                        else { const u32x2v h = *(const u32x2v*)(xn + off + bj * HALF + n * 16); const unsigned qx = n ? lo16.z : lo16.x, qy = n ? lo16.w : lo16.y;
                            bs[0] = __uint_as_float(h.x << 16) + __uint_as_float(qx << 16); bs[1] = __uint_as_float(h.x & 0xffff0000u) + __uint_as_float(qx & 0xffff0000u);
                            bs[2] = __uint_as_float(h.y << 16) + __uint_as_float(qy << 16); bs[3] = __uint_as_float(h.y & 0xffff0000u) + __uint_as_float(qy & 0xffff0000u); }
                        acc[ai][bj][m][n] = bs * alpha + acc[ai][bj][m][n]; } }
                asm volatile("" : "+v"(acc[ai][0][m][0]), "+v"(acc[ai][0][m][1]), "+v"(acc[ai][1][m][0]), "+v"(acc[ai][1][m][1]));
                if (m == 3) asm volatile("" ::: "memory"); }
#pragma unroll
        for (int ai = 0; ai < 2; ++ai)
#pragma unroll
            for (int m = 0; m < 4; ++m) {
                float s = 0.f;
#pragma unroll
                for (int bj = 0; bj < 2; ++bj)
#pragma unroll
                    for (int n = 0; n < 2; ++n) { const f32x4 x = acc[ai][bj][m][n]; s += (x[0] + x[1]) + (x[2] + x[3]); }
                s += __shfl_xor(s, 16); s += __shfl_xor(s, 32);
                const float mw = s * (1.0f / 64.0f); float q = 0.f;
#pragma unroll
                for (int bj = 0; bj < 2; ++bj)
#pragma unroll
                    for (int n = 0; n < 2; ++n) { const f32x4 d = acc[ai][bj][m][n] - mw; q += (d[0] * d[0] + d[1] * d[1]) + (d[2] * d[2] + d[3] * d[3]); }
                q += __shfl_xor(q, 16); q += __shfl_xor(q, 32);
                if (fq == 0) P[(ai * HALF + wr * 64 + m * 16 + fr) * 4 + wc] = (f32x2v){mw, q};
            }
        asm volatile("s_waitcnt lgkmcnt(0)" ::: "memory"); __builtin_amdgcn_s_barrier(); asm volatile("" ::: "memory");
        const int row = wid * 32 + (lane & 31);
        if (lane < 32) {
            const f32x2v a = P[row * 4 + 0], b = P[row * 4 + 1], c = P[row * 4 + 2], d = P[row * 4 + 3];
            const float mt = (a.x + b.x + c.x + d.x) * 0.25f;
            const float da = a.x - mt, db = b.x - mt, dc = c.x - mt, dd = d.x - mt;
            const float m2 = (a.y + b.y) + (c.y + d.y) + 64.0f * ((da * da + db * db) + (dc * dc + dd * dd));
            unsigned long long* slot = xbuf + ((size_t)(u.pm * BM + row) * 8 + u.pn);
            __hip_atomic_store(slot, ((unsigned long long)__float_as_uint(m2) << 32) | __float_as_uint(mt), __ATOMIC_RELAXED, __HIP_MEMORY_SCOPE_AGENT);
        }
        asm volatile("s_waitcnt vmcnt(0)" ::: "memory");
        if (lane == 0) __hip_atomic_fetch_add(cnt + 64 * u.pm, 1u, __ATOMIC_RELAXED, __HIP_MEMORY_SCOPE_AGENT);
        if (wid == 0) {
            unsigned sp = 0;
            while ((unsigned)__builtin_amdgcn_readfirstlane(__hip_atomic_load(cnt + 64 * u.pm, __ATOMIC_RELAXED, __HIP_MEMORY_SCOPE_AGENT)) < 64u) { __builtin_amdgcn_s_sleep(2); if (++sp > (1u << 22)) break; }
        }
        asm volatile("s_waitcnt vmcnt(0) lgkmcnt(0)" ::: "memory"); __builtin_amdgcn_s_barrier(); asm volatile("" ::: "memory");
        if (lane < 32) {
            const unsigned long long* slot = xbuf + (size_t)(u.pm * BM + row) * 8; float mt[8], m2[8]; float ms = 0.f;
#pragma unroll
            for (int t = 0; t < 8; ++t) { const unsigned long long w = __hip_atomic_load(slot + t, __ATOMIC_RELAXED, __HIP_MEMORY_SCOPE_AGENT); mt[t] = __uint_as_float((unsigned)w); m2[t] = __uint_as_float((unsigned)(w >> 32)); ms += mt[t]; }
            const float mean = ms * 0.125f; float q = 0.f;
#pragma unroll
            for (int t = 0; t < 8; ++t) { const float dm = mt[t] - mean; q += m2[t] + 256.0f * dm * dm; }
            S[row] = (f32x2v){mean, 1.0f / sqrtf(q * (1.0f / 2048.0f) + eps)};
        }
        asm volatile("s_waitcnt lgkmcnt(0)" ::: "memory"); __builtin_amdgcn_s_barrier(); asm volatile("" ::: "memory");
#pragma unroll
        for (int bj = 0; bj < 2; ++bj) { f32x4 gg[2], bb[2];
#pragma unroll
            for (int n = 0; n < 2; ++n) { gg[n] = *(const f32x4*)(lg + col0 + bj * HALF + n * 16); bb[n] = *(const f32x4*)(lb + col0 + bj * HALF + n * 16); }
#pragma unroll
            for (int ai = 0; ai < 2; ++ai)
#pragma unroll
                for (int m = 0; m < 4; ++m) { const int r = ai * HALF + wr * 64 + m * 16 + fr; const f32x2v sr = S[r]; u32x4 lo16;
#pragma unroll
                    for (int n = 0; n < 2; ++n) { const size_t off = (size_t)(u.pm * BM + r) * 2048 + col0 + bj * HALF + n * 16;
                        const f32x4 y = (acc[ai][bj][m][n] - sr.x) * sr.y * gg[n] + bb[n];
                        if (out) *(f32x4*)(out + off) = y;
                        else { u32x2v w; w.x = cvt_pk_bf16(y[0], y[1]); w.y = cvt_pk_bf16(y[2], y[3]); *(u32x2v*)(xn + off) = w;
                            const unsigned q0 = cvt_pk_bf16(y[0] - __uint_as_float(w.x << 16), y[1] - __uint_as_float(w.x & 0xffff0000u)), q1 = cvt_pk_bf16(y[2] - __uint_as_float(w.y << 16), y[3] - __uint_as_float(w.y & 0xffff0000u));
                            if (n == 0) { lo16.x = q0; lo16.y = q1; } else { lo16.z = q0; lo16.w = q1; } } }
                    if (!out) *(u32x4*)(xl_t + ((size_t)(((ai * 4 + m) * 2 + bj) * 512 + tid_) * 8)) = lo16; } }
    }
};
}

#define LAS __attribute__((address_space(3)))
#define GAS __attribute__((address_space(1)))
typedef unsigned short bf16_t;
typedef short bf16x8 __attribute__((ext_vector_type(8)));
typedef short bf16x4 __attribute__((ext_vector_type(4)));
typedef float f32x4 __attribute__((ext_vector_type(4)));
typedef unsigned u32x4 __attribute__((ext_vector_type(4)));
typedef unsigned u32x2 __attribute__((ext_vector_type(2)));

constexpr int SEQ = 8192, DM = 2048, DEPTH = 4, INW = 6672, NMEM = 256;
constexpr int NMAIN = 5376, NVT = 1536, NWT = NMAIN + NVT;
constexpr int C_AQ = 0, C_AK = 1024, C_AZ = 2048, C_BQ = 3072, C_BK = 3328, C_BZ = 3584, C_MQ = 4096, C_MZ = 4608, C_LR = 5120;
constexpr int NCH = SEQ / 64;
constexpr float LN_EPS = 1e-5f, RMS_EPS = 1e-6f;
constexpr float LOG2E = 1.4426950408889634f;
constexpr float ATT_SC = 0.08838834764831845f * LOG2E;
constexpr int LDS_BYTES = 147456;

constexpr size_t MiB = 1u << 20;
constexpr size_t WS_WIN = 0, WIN_L = (size_t)NWT * DM * 2;
constexpr size_t WS_WOUT = 112 * MiB, WOUT_L = (size_t)DM * DM * 2;
constexpr size_t WS_WMK = 144 * MiB, WS_WMV = 152 * MiB;
constexpr size_t WS_MEMB = 160 * MiB, WS_MK = 161 * MiB, WS_MVT = 162 * MiB;
constexpr size_t WS_XB = 164 * MiB, WS_XF = 196 * MiB, WS_HM = 260 * MiB, WS_Y = 368 * MiB;
constexpr int LDV = SEQ + 64;
constexpr size_t WS_U = 400 * MiB, WS_SP = 416 * MiB, WS_DCY = 424 * MiB, WS_CTL = 426 * MiB, CTL_BYTES = 65536, WS_XCH = 427 * MiB, WS_VT = 428 * MiB, WS_BG = 454 * MiB, WS_XL = 462 * MiB, WS_END = 494 * MiB;
constexpr int CW_CNT = 4096;
static_assert(WS_WIN + 4 * WIN_L <= WS_WOUT, "ws map");
static_assert(WS_HM + (size_t)SEQ * NMAIN * 2 <= WS_Y, "ws map");

struct Params {
    const float *x, *mem, *w_in, *rel, *gate_w, *gate_b, *norm_g, *w_mkv, *w_out, *ln_g, *ln_b;
    float* out; unsigned char* ws; int ph_lo, ph_hi;
};

typedef float f32x2_t __attribute__((ext_vector_type(2))); typedef __bf16 bf16x2_t __attribute__((ext_vector_type(2)));
__device__ __forceinline__ unsigned pk2(float lo, float hi) { const f32x2_t v = {lo, hi}; const bf16x2_t b = __builtin_convertvector(v, bf16x2_t); return __builtin_bit_cast(unsigned, b); }
__device__ __forceinline__ float bflo(unsigned w) { return __uint_as_float(w << 16); }
__device__ __forceinline__ float bfhi(unsigned w) { return __uint_as_float(w & 0xffff0000u); }
__device__ __forceinline__ float silu_f(float z) { return z / (1.0f + __expf(-z)); }
#define MFMA16(a, b, c) __builtin_amdgcn_mfma_f32_16x16x32_bf16((a), (b), (c), 0, 0, 0)

struct ConvItem { const GAS float* src; GAS bf16_t* dst; int ldw; bool ok; };
__device__ __forceinline__ void conv_load(const ConvItem& d, f32x4 (&v)[8]) {
#pragma unroll
    for (int i = 0; i < 8; ++i) v[i] = d.ok ? __builtin_nontemporal_load((const GAS f32x4*)(d.src + (size_t)(8 * i) * d.ldw)) : (f32x4){0.f, 0.f, 0.f, 0.f};
}
__device__ __forceinline__ void conv_store(const ConvItem& d, const f32x4 (&v)[8], LAS float* scr, int lane) {
    const int n4 = 4 * (lane & 7), kr = lane >> 3;
#pragma unroll
    for (int i = 0; i < 8; ++i) { LAS float* q = scr + (8 * i + kr) * 33 + n4; q[0] = v[i].x; q[1] = v[i].y; q[2] = v[i].z; q[3] = v[i].w; }
    asm volatile("s_waitcnt lgkmcnt(0)" ::: "memory");
    const int c = lane & 7;
#pragma unroll
    for (int j = 0; j < 4; ++j) { const int n = (lane >> 3) + 8 * j; const LAS float* s = scr + (8 * c) * 33 + n;
        u32x4 o; o.x = pk2(s[0 * 33], s[1 * 33]); o.y = pk2(s[2 * 33], s[3 * 33]); o.z = pk2(s[4 * 33], s[5 * 33]); o.w = pk2(s[6 * 33], s[7 * 33]);
        *(GAS u32x4*)(d.dst + (size_t)n * DM + 8 * c) = o; }
    asm volatile("s_waitcnt lgkmcnt(0)" ::: "memory");
}
__device__ __forceinline__ void in_seg(int drow, int& src_col, int& nvalid) {
    nvalid = 32;
    if (drow < 2048) src_col = drow;
    else if (drow < 3072) src_col = 3072 + (drow - 2048);
    else if (drow < 3328) src_col = 4096 + (drow - 3072);
    else if (drow < 3584) src_col = 4352 + (drow - 3328);
    else if (drow < 4096) src_col = 5120 + (drow - 3584);
    else if (drow < 4608) src_col = 5648 + (drow - 4096);
    else if (drow < 5120) src_col = 6160 + (drow - 4608);
    else if (drow < 5376) { src_col = 5632; nvalid = (drow == 5120) ? 16 : 0; }
    else if (drow < 6400) src_col = 2048 + (drow - 5376);
    else src_col = 4608 + (drow - 6400);
}
__device__ __forceinline__ ConvItem conv_decode(const Params& p, int l, int it, int lane) {
    constexpr int I_IN = 32 * (NWT / 32), I_OUT = 32 * (DM / 32);
    const int n4 = 4 * (lane & 7), kr = lane >> 3;
    ConvItem d; int r = it;
    if (r < I_IN) { const int g_ = r >> 5, nb = 8 * (g_ % 27) + (r & 7), k0 = 64 * (4 * (g_ / 27) + ((r >> 3) & 3)); int sc, nv; in_seg(32 * nb, sc, nv);
        d.ldw = INW; d.ok = n4 < nv; d.src = (const GAS float*)p.w_in + (size_t)l * DM * INW + (size_t)(k0 + kr) * INW + sc + n4;
        d.dst = (GAS bf16_t*)(p.ws + WS_WIN + l * WIN_L) + (size_t)(32 * nb) * DM + k0; return d; }
    r -= I_IN;
    if (r < I_OUT) { const int g_ = r >> 5, nb = 8 * (g_ % 8) + (r & 7), k0 = 64 * (4 * (g_ / 8) + ((r >> 3) & 3));
        d.ldw = DM; d.ok = true; d.src = (const GAS float*)p.w_out + (size_t)l * DM * DM + (size_t)(k0 + kr) * DM + 32 * nb + n4;
        d.dst = (GAS bf16_t*)(p.ws + WS_WOUT + l * WOUT_L) + (size_t)(32 * nb) * DM + k0; return d; }
    r -= I_OUT;
    { const int g_ = r >> 5, nb = 8 * (g_ % 4) + (r & 7), k0 = 64 * (4 * (g_ / 4) + ((r >> 3) & 3));
        d.ldw = 1024; d.ok = true; d.src = (const GAS float*)p.w_mkv + (size_t)l * DM * 1024 + (size_t)(k0 + kr) * 1024 + 32 * nb + n4;
        d.dst = (GAS bf16_t*)(p.ws + (nb < 16 ? WS_WMK : WS_WMV)) + (size_t)(l * 512 + 32 * (nb & 15)) * DM + k0; return d; }
}
__device__ __forceinline__ void convert_layer(const Params& p, int l, LAS unsigned char* lds, int wk, int nwk) {
    int tid_ = threadIdx.x; asm volatile("" : "+v"(tid_)); const int tid = tid_, lane = tid & 63, wave = tid >> 6;
    LAS float* scr = (LAS float*)(lds + wave * 8704);
    constexpr int I_L = 32 * (NWT / 32) + 32 * (DM / 32) + 32 * 32;
    if (wk >= I_L) return;
    ConvItem cur = conv_decode(p, l, wk, lane); f32x4 v[8]; conv_load(cur, v);
    for (int it = wk; it < I_L; it += nwk) {
        const int nx = it + nwk; ConvItem nxt = cur; f32x4 v2[8];
        if (nx < I_L) { nxt = conv_decode(p, l, nx, lane); conv_load(nxt, v2); }
        conv_store(cur, v, scr, lane);
        if (nx < I_L) { cur = nxt;
#pragma unroll
            for (int i = 0; i < 8; ++i) v[i] = v2[i]; }
    }
}
__device__ __forceinline__ void phase0(const Params& p, LAS unsigned char* lds) {
    int tid_ = threadIdx.x; asm volatile("" : "+v"(tid_)); const int tid = tid_, wave = tid >> 6;
    convert_layer(p, 0, lds, blockIdx.x * 8 + wave, gridDim.x * 8);
    const size_t gt = (size_t)blockIdx.x * 512 + tid, NT = (size_t)gridDim.x * 512;
    GAS bf16_t* xb = (GAS bf16_t*)(p.ws + WS_XB); const GAS f32x4* xs = (const GAS f32x4*)p.x;
    for (size_t i = gt; i < (size_t)SEQ * DM / 8; i += NT) { const f32x4 a = xs[2 * i], b = xs[2 * i + 1];
        u32x4 o; o.x = pk2(a.x, a.y); o.y = pk2(a.z, a.w); o.z = pk2(b.x, b.y); o.w = pk2(b.z, b.w); ((GAS u32x4*)xb)[i] = o; }
    GAS bf16_t* mb = (GAS bf16_t*)(p.ws + WS_MEMB); const GAS f32x4* ms = (const GAS f32x4*)p.mem;
    for (size_t i = gt; i < (size_t)NMEM * DM / 8; i += NT) { const f32x4 a = ms[2 * i], b = ms[2 * i + 1];
        u32x4 o; o.x = pk2(a.x, a.y); o.y = pk2(a.z, a.w); o.z = pk2(b.x, b.y); o.w = pk2(b.z, b.w); ((GAS u32x4*)mb)[i] = o; }
}

constexpr int A_KS = 0, A_KSZ = 64 * 272, A_VS = 2 * A_KSZ, A_VSZ = 128 * 144, A_BT = A_VS + 2 * A_VSZ;
template <bool BAND>
__device__ __forceinline__ void attn_step(LAS unsigned char* lds, int buf, int t, int cw, int w, int r16, int g, const bf16x8 (&qf)[4], f32x4 (&o)[8], float& m, float& l) {
    const LAS float* btab = (const LAS float*)(lds + A_BT);
    const LAS unsigned char* kb_ = lds + A_KS + buf * A_KSZ + r16 * 272 + g * 16;
    f32x4 s[4];
#pragma unroll
    for (int kb = 0; kb < 4; ++kb) { s[kb] = (f32x4){0.f, 0.f, 0.f, 0.f}; bf16x8 kfr[4];
#pragma unroll
        for (int ks = 0; ks < 4; ++ks) kfr[ks] = *(const LAS bf16x8*)(kb_ + kb * 16 * 272 + ks * 64);
#pragma unroll
        for (int ks = 0; ks < 4; ++ks) s[kb] = MFMA16(kfr[ks], qf[ks], s[kb]); }
    if (BAND) {
        const int delta = cw + 8 - t;
        if (delta >= 3) { const float bc = btab[256];
#pragma unroll
            for (int kb = 0; kb < 4; ++kb) s[kb] = s[kb] * ATT_SC + bc;
        } else { const int qi = 16 * (w & 3) + r16;
#pragma unroll
            for (int kb = 0; kb < 4; ++kb)
#pragma unroll
                for (int r = 0; r < 4; ++r) { int dist = 64 * delta + qi - (16 * kb + 4 * g + r); dist = dist > 128 ? 128 : (dist < -128 ? -128 : dist);
                    s[kb][r] = s[kb][r] * ATT_SC + btab[dist + 128]; }
        }
    } else {
#pragma unroll
        for (int kb = 0; kb < 4; ++kb) s[kb] = s[kb] * ATT_SC;
    }
    float mt = fmaxf(fmaxf(s[0][0], s[0][1]), fmaxf(s[0][2], s[0][3]));
#pragma unroll
    for (int kb = 1; kb < 4; ++kb) mt = fmaxf(mt, fmaxf(fmaxf(s[kb][0], s[kb][1]), fmaxf(s[kb][2], s[kb][3])));
    mt = fmaxf(mt, __shfl_xor(mt, 16)); mt = fmaxf(mt, __shfl_xor(mt, 32));
    const float mn = fmaxf(m, mt), alpha = __builtin_amdgcn_exp2f(m - mn); m = mn;
    float rs = 0.f;
#pragma unroll
    for (int kb = 0; kb < 4; ++kb)
#pragma unroll
        for (int r = 0; r < 4; ++r) { const float pv = __builtin_amdgcn_exp2f(s[kb][r] - mn); s[kb][r] = pv; rs += pv; }
    l = l * alpha + rs;
    if (__any(alpha != 1.0f)) {
#pragma unroll
        for (int i = 0; i < 8; ++i) o[i] = o[i] * alpha; }
    bf16x8 pb[2];
#pragma unroll
    for (int s2 = 0; s2 < 2; ++s2) { u32x4 pw; pw.x = pk2(s[2 * s2][0], s[2 * s2][1]); pw.y = pk2(s[2 * s2][2], s[2 * s2][3]);
        pw.z = pk2(s[2 * s2 + 1][0], s[2 * s2 + 1][1]); pw.w = pk2(s[2 * s2 + 1][2], s[2 * s2 + 1][3]); pb[s2] = __builtin_bit_cast(bf16x8, pw); }
    int voff_ = 0; asm volatile("" : "+v"(voff_), "+v"(pb[1]));
    const LAS unsigned char* vb_ = lds + A_VS + buf * A_VSZ + r16 * 144 + g * 8 + voff_;
    u32x2 vfr[2][4];
#pragma unroll
    for (int q = 0; q < 4; ++q) vfr[0][q] = *(const LAS u32x2*)(vb_ + (q >> 1) * 64 + (q & 1) * 32);
#pragma unroll
    for (int dvb = 0; dvb < 8; ++dvb) {
        if (dvb < 7) {
#pragma unroll
            for (int q = 0; q < 4; ++q) vfr[(dvb + 1) & 1][q] = *(const LAS u32x2*)(vb_ + (dvb + 1) * 16 * 144 + (q >> 1) * 64 + (q & 1) * 32); }
#pragma unroll
        for (int s2 = 0; s2 < 2; ++s2) { const u32x2 lo = vfr[dvb & 1][2 * s2], hi = vfr[dvb & 1][2 * s2 + 1];
            const u32x4 av = (u32x4){lo.x, lo.y, hi.x, hi.y}; o[dvb] = MFMA16(__builtin_bit_cast(bf16x8, av), pb[s2], o[dvb]); } }
}
template <bool BAND>
__device__ __forceinline__ void attn_unit(LAS unsigned char* lds, int q_row0, const bf16_t* Qh, int ldq, const bf16_t* Kh, int ldk, const bf16_t* Vth, int ldvt,
                                          const bf16_t* Zh, int ldz, bf16_t* Yh, int ldy, const float* bias_tab, int j2) {
    int tid_ = threadIdx.x; asm volatile("" : "+v"(tid_)); const int tid = tid_, lane = tid & 63, w = __builtin_amdgcn_readfirstlane(tid >> 6), r16 = lane & 15, g = lane >> 4;
    LAS float* btab = (LAS float*)(lds + A_BT);
    if (BAND) { for (int i = tid; i < 257; i += 512) btab[i] = ((const GAS float*)bias_tab)[i] * LOG2E; }
    const GAS bf16_t* qp = (const GAS bf16_t*)Qh + (size_t)(q_row0 + 16 * w + r16) * ldq + 8 * g;
    bf16x8 qf[4];
#pragma unroll
    for (int ks = 0; ks < 4; ++ks) qf[ks] = *(const GAS bf16x8*)(qp + 32 * ks);
    f32x4 o[8];
#pragma unroll
    for (int i = 0; i < 8; ++i) o[i] = (f32x4){0.f, 0.f, 0.f, 0.f};
    float m = -1e30f, l = 0.f;
    const int cw = BAND ? (w >> 2) : 0;
    const int nt = BAND ? 10 : 4;
    int t0 = 0; if (BAND) { t0 = 8 - 2 * j2; if (t0 < 0) t0 = 0; }
    u32x4 kA[2], vA[2], kB[2], vB[2];
#define A_GLOAD(kr, vr, t) do { const int key0_ = BAND ? 64 * (2 * j2 - 8 + (t)) : 64 * (t); \
        _Pragma("unroll") for (int i_ = 0; i_ < 2; ++i_) { const int id_ = tid + 512 * i_; \
            kr[i_] = *(const GAS u32x4*)((const GAS bf16_t*)Kh + (size_t)(key0_ + (id_ >> 4)) * ldk + (id_ & 15) * 8); \
            vr[i_] = *(const GAS u32x4*)((const GAS bf16_t*)Vth + (size_t)(id_ >> 3) * ldvt + key0_ + (id_ & 7) * 8); } } while (0)
#define A_LSTORE(kr, vr, buf) do { _Pragma("unroll") for (int i_ = 0; i_ < 2; ++i_) { const int id_ = tid + 512 * i_; \
            *(LAS u32x4*)(lds + A_KS + (buf) * A_KSZ + (id_ >> 4) * 272 + (id_ & 15) * 16) = kr[i_]; \
            *(LAS u32x4*)(lds + A_VS + (buf) * A_VSZ + (id_ >> 3) * 144 + (id_ & 7) * 16) = vr[i_]; } } while (0)
    A_GLOAD(kA, vA, t0); A_GLOAD(kB, vB, t0 + 1); A_LSTORE(kA, vA, 0); __syncthreads();
    for (int t = t0; t < nt; t += 2) {
        if (t + 2 < nt) A_GLOAD(kA, vA, t + 2);
        if (!BAND || (t >= cw && t <= cw + 8)) attn_step<BAND>(lds, 0, t, cw, w, r16, g, qf, o, m, l);
        A_LSTORE(kB, vB, 1);
        __syncthreads();
        if (t + 3 < nt) A_GLOAD(kB, vB, t + 3);
        if (!BAND || (t + 1 >= cw && t + 1 <= cw + 8)) attn_step<BAND>(lds, 1, t + 1, cw, w, r16, g, qf, o, m, l);
        if (t + 2 < nt) A_LSTORE(kA, vA, 0);
        __syncthreads();
    }
#undef A_GLOAD
#undef A_LSTORE
    l += __shfl_xor(l, 16); l += __shfl_xor(l, 32);
    const float inv = 1.0f / l;
    const size_t row = (size_t)(q_row0 + 16 * w + r16);
#pragma unroll
    for (int dvb = 0; dvb < 8; ++dvb) { const int col = 16 * dvb + 4 * g; const u32x2 z = *(const GAS u32x2*)((const GAS bf16_t*)Zh + row * ldz + col);
        const float y0 = o[dvb][0] * inv * silu_f(bflo(z.x)), y1 = o[dvb][1] * inv * silu_f(bfhi(z.x)), y2 = o[dvb][2] * inv * silu_f(bflo(z.y)), y3 = o[dvb][3] * inv * silu_f(bfhi(z.y));
        u32x2 yo; yo.x = pk2(y0, y1); yo.y = pk2(y2, y3); *(GAS u32x2*)((GAS bf16_t*)Yh + row * ldy + col) = yo; }
}


constexpr int P_HALF = 2 * A_KSZ + 2 * A_VSZ, P_BT = 2 * P_HALF;
static_assert(P_BT + 2 * 1028 <= LDS_BYTES - 64, "pair attention LDS map");
__device__ __forceinline__ void band_pair_step(LAS unsigned char* hl, const LAS float* btab, int buf, int t, int cw, int w4, int r16, int g,
                                               const bf16x8 (&qf)[2][4], f32x4 (&o)[2][8], float (&m)[2], f32x4 (&l)[2]) {
    const LAS unsigned char* kb_ = hl + buf * A_KSZ + r16 * 272 + g * 16;
    f32x4 s[2][4];
#pragma unroll
    for (int kb = 0; kb < 4; ++kb) { bf16x8 kfr[4];
#pragma unroll
        for (int ks = 0; ks < 4; ++ks) kfr[ks] = *(const LAS bf16x8*)(kb_ + kb * 16 * 272 + ks * 64);
#pragma unroll
        for (int rb = 0; rb < 2; ++rb) { s[rb][kb] = (f32x4){0.f, 0.f, 0.f, 0.f};
#pragma unroll
            for (int ks = 0; ks < 4; ++ks) s[rb][kb] = MFMA16(kfr[ks], qf[rb][ks], s[rb][kb]); } }
    const int delta = cw + 8 - t;
    bf16x8 pb[2][2];
    const bf16x8 ones = (bf16x8){16256, 16256, 16256, 16256, 16256, 16256, 16256, 16256};
#pragma unroll
    for (int rb = 0; rb < 2; ++rb) {
        float mn, alpha;
        if (delta >= 3) {
            const float bc = btab[256];
            float mt = fmaxf(fmaxf(s[rb][0][0], s[rb][0][1]), fmaxf(s[rb][0][2], s[rb][0][3]));
#pragma unroll
            for (int kb = 1; kb < 4; ++kb) mt = fmaxf(mt, fmaxf(fmaxf(s[rb][kb][0], s[rb][kb][1]), fmaxf(s[rb][kb][2], s[rb][kb][3])));
            mt = fmaxf(mt, __shfl_xor(mt, 16)); mt = fmaxf(mt, __shfl_xor(mt, 32));
            mn = fmaxf(m[rb], mt * ATT_SC + bc); alpha = __builtin_amdgcn_exp2f(m[rb] - mn); m[rb] = mn;
            const float off = bc - mn;
#pragma unroll
            for (int kb = 0; kb < 4; ++kb)
#pragma unroll
                for (int r = 0; r < 4; ++r) s[rb][kb][r] = __builtin_amdgcn_exp2f(s[rb][kb][r] * ATT_SC + off);
        } else { const int qi = 32 * (w4 & 1) + 16 * rb + r16;
#pragma unroll
            for (int kb = 0; kb < 4; ++kb)
#pragma unroll
                for (int r = 0; r < 4; ++r) { int dist = 64 * delta + qi - (16 * kb + 4 * g + r); dist = dist > 128 ? 128 : (dist < -128 ? -128 : dist);
                    s[rb][kb][r] = s[rb][kb][r] * ATT_SC + btab[dist + 128]; }
            float mt = fmaxf(fmaxf(s[rb][0][0], s[rb][0][1]), fmaxf(s[rb][0][2], s[rb][0][3]));
#pragma unroll
            for (int kb = 1; kb < 4; ++kb) mt = fmaxf(mt, fmaxf(fmaxf(s[rb][kb][0], s[rb][kb][1]), fmaxf(s[rb][kb][2], s[rb][kb][3])));
            mt = fmaxf(mt, __shfl_xor(mt, 16)); mt = fmaxf(mt, __shfl_xor(mt, 32));
            mn = fmaxf(m[rb], mt); alpha = __builtin_amdgcn_exp2f(m[rb] - mn); m[rb] = mn;
#pragma unroll
            for (int kb = 0; kb < 4; ++kb)
#pragma unroll
                for (int r = 0; r < 4; ++r) s[rb][kb][r] = __builtin_amdgcn_exp2f(s[rb][kb][r] - mn);
        }
        if (__any(alpha != 1.0f)) { l[rb] = l[rb] * alpha;
#pragma unroll
            for (int i = 0; i < 8; ++i) o[rb][i] = o[rb][i] * alpha; }
#pragma unroll
        for (int s2 = 0; s2 < 2; ++s2) { u32x4 pw; pw.x = pk2(s[rb][2 * s2][0], s[rb][2 * s2][1]); pw.y = pk2(s[rb][2 * s2][2], s[rb][2 * s2][3]);
            pw.z = pk2(s[rb][2 * s2 + 1][0], s[rb][2 * s2 + 1][1]); pw.w = pk2(s[rb][2 * s2 + 1][2], s[rb][2 * s2 + 1][3]); pb[rb][s2] = __builtin_bit_cast(bf16x8, pw);
            l[rb] = MFMA16(ones, pb[rb][s2], l[rb]); }
    }
    int voff_ = 0; asm volatile("" : "+v"(voff_), "+v"(pb[1][1]));
    const LAS unsigned char* vb_ = hl + 2 * A_KSZ + buf * A_VSZ + r16 * 144 + g * 8 + voff_;
#pragma unroll
    for (int dvb = 0; dvb < 8; ++dvb) { u32x2 vfr[4];
#pragma unroll
        for (int q = 0; q < 4; ++q) vfr[q] = *(const LAS u32x2*)(vb_ + dvb * 16 * 144 + (q >> 1) * 64 + (q & 1) * 32);
#pragma unroll
        for (int s2 = 0; s2 < 2; ++s2) { const u32x4 av = (u32x4){vfr[2 * s2].x, vfr[2 * s2].y, vfr[2 * s2 + 1].x, vfr[2 * s2 + 1].y};
#pragma unroll
            for (int rb = 0; rb < 2; ++rb) o[rb][dvb] = MFMA16(__builtin_bit_cast(bf16x8, av), pb[rb][s2], o[rb][dvb]); } }
}
__device__ __forceinline__ void band_pair_unit(LAS unsigned char* lds, const Params& p, int l, int j2, int hA) {
    int tid_ = threadIdx.x; asm volatile("" : "+v"(tid_)); const int tid = tid_, lane = tid & 63, w = __builtin_amdgcn_readfirstlane(tid >> 6), r16 = lane & 15, g = lane >> 4;
    const int half = w >> 2, w4 = w & 3, th = tid & 255, head = hA + half;
    LAS unsigned char* hl = lds + half * P_HALF;
    LAS float* btab = (LAS float*)(lds + P_BT + half * 1028);
    { const GAS float* bt = (const GAS float*)p.rel + (l * 8 + head) * 257; for (int i = th; i < 257; i += 256) btab[i] = bt[i] * LOG2E; }
    const GAS bf16_t* hm = (const GAS bf16_t*)(p.ws + WS_HM);
    const GAS bf16_t* Kh = hm + C_AK + head * 128; const GAS bf16_t* Vth = (const GAS bf16_t*)(p.ws + WS_VT) + (size_t)(head * 128) * LDV;
    const int row0 = 128 * j2 + 32 * w4 + r16;
    bf16x8 qf[2][4];
#pragma unroll
    for (int rb = 0; rb < 2; ++rb)
#pragma unroll
        for (int ks = 0; ks < 4; ++ks) qf[rb][ks] = *(const GAS bf16x8*)(hm + (size_t)(row0 + 16 * rb) * NMAIN + C_AQ + head * 128 + 32 * ks + 8 * g);
    f32x4 o[2][8];
#pragma unroll
    for (int rb = 0; rb < 2; ++rb)
#pragma unroll
        for (int i = 0; i < 8; ++i) o[rb][i] = (f32x4){0.f, 0.f, 0.f, 0.f};
    float m[2] = {-1e30f, -1e30f}; f32x4 l_[2] = {(f32x4){0.f, 0.f, 0.f, 0.f}, (f32x4){0.f, 0.f, 0.f, 0.f}};
    const int cw = w4 >> 1, nt = 10;
    int t0 = 8 - 2 * j2; if (t0 < 0) t0 = 0;
    u32x4 kr[4], vr[4];
#define P_GLOAD(t) do { const int key0_ = 64 * (2 * j2 - 8 + (t)); \
        _Pragma("unroll") for (int i_ = 0; i_ < 4; ++i_) { const int id_ = th + 256 * i_; \
            kr[i_] = *(const GAS u32x4*)(Kh + (size_t)(key0_ + (id_ >> 4)) * NMAIN + (id_ & 15) * 8); \
            vr[i_] = *(const GAS u32x4*)(Vth + (size_t)(id_ >> 3) * LDV + key0_ + (id_ & 7) * 8); } } while (0)
#define P_LSTORE(buf) do { _Pragma("unroll") for (int i_ = 0; i_ < 4; ++i_) { const int id_ = th + 256 * i_; \
            *(LAS u32x4*)(hl + (buf) * A_KSZ + (id_ >> 4) * 272 + (id_ & 15) * 16) = kr[i_]; \
            *(LAS u32x4*)(hl + 2 * A_KSZ + (buf) * A_VSZ + (id_ >> 3) * 144 + (id_ & 7) * 16) = vr[i_]; } } while (0)
    P_GLOAD(t0); P_LSTORE(0); __syncthreads();
    for (int t = t0; t < nt; ++t) {
        const int buf = (t - t0) & 1;
        if (t + 1 < nt) P_GLOAD(t + 1);
        if (t >= cw && t <= cw + 8) band_pair_step(hl, btab, buf, t, cw, w4, r16, g, qf, o, m, l_);
        if (t + 1 < nt) P_LSTORE(buf ^ 1);
        __syncthreads();
    }
#undef P_GLOAD
#undef P_LSTORE
    GAS bf16_t* Y = (GAS bf16_t*)(p.ws + WS_Y);
#pragma unroll
    for (int rb = 0; rb < 2; ++rb) { const float inv = 1.0f / l_[rb][0]; const size_t row = (size_t)(row0 + 16 * rb);
#pragma unroll
        for (int dvb = 0; dvb < 8; ++dvb) { const int col = 16 * dvb + 4 * g; const u32x2 z = *(const GAS u32x2*)(hm + row * NMAIN + C_AZ + head * 128 + col);
            const float y0 = o[rb][dvb][0] * inv * silu_f(bflo(z.x)), y1 = o[rb][dvb][1] * inv * silu_f(bfhi(z.x)), y2 = o[rb][dvb][2] * inv * silu_f(bflo(z.y)), y3 = o[rb][dvb][3] * inv * silu_f(bfhi(z.y));
            u32x2 yo; yo.x = pk2(y0, y1); yo.y = pk2(y2, y3); *(GAS u32x2*)(Y + row * DM + head * 128 + col) = yo; } }
}

constexpr int G_LR = 0, G_GW = 4096, G_GB = 8192, G_SEG = 8448, G_B = 10496, G_SSQ = 27136, G_QP = 27648, G_QM = 36864, G_KP = 46080, G_KM = 55296,
              G_KD = 64512, G_AT = 73728, G_VT = 82944, G_ST = 101376;
__device__ __forceinline__ void gla_compute_b(LAS unsigned char* lds, const bf16_t* hm_rows, const float* gw_l, const float* gb_l, int hb) {
    int tid_ = threadIdx.x; asm volatile("" : "+v"(tid_)); const int tid = tid_;
    LAS float* LR = (LAS float*)(lds + G_LR); LAS float* GW = (LAS float*)(lds + G_GW); LAS float* GB = (LAS float*)(lds + G_GB);
    LAS float* SEG = (LAS float*)(lds + G_SEG); LAS float* Bm = (LAS float*)(lds + G_B);
    if (tid < 128) { const int row = tid >> 1, half = tid & 1; const u32x4 v = *(const GAS u32x4*)((const GAS bf16_t*)hm_rows + (size_t)row * NMAIN + C_LR + 8 * half);
        LAS float* d = LR + row * 16 + 8 * half; d[0] = bflo(v.x); d[1] = bfhi(v.x); d[2] = bflo(v.y); d[3] = bfhi(v.y); d[4] = bflo(v.z); d[5] = bfhi(v.z); d[6] = bflo(v.w); d[7] = bfhi(v.w); }
    for (int i = tid; i < 1024; i += 512) GW[i] = ((const GAS float*)gw_l)[(i >> 6) * 256 + hb * 64 + (i & 63)];
    if (tid < 64) GB[tid] = ((const GAS float*)gb_l)[hb * 64 + tid];
    __syncthreads();
    const int d = tid & 63, tseg = tid >> 6;
    float gwr[16];
#pragma unroll
    for (int r = 0; r < 16; ++r) gwr[r] = GW[r * 64 + d];
    const float gbv = GB[d];
    float loc[8]; float run = 0.f;
#pragma unroll
    for (int tt = 0; tt < 8; ++tt) { const int t = 8 * tseg + tt; float x = gbv;
#pragma unroll
        for (int r = 0; r < 16; ++r) x += LR[t * 16 + r] * gwr[r];
        const float lg = (fminf(x, 0.f) - __logf(1.0f + __expf(-fabsf(x)))) * 0.0625f;
        run += lg; loc[tt] = run; }
    SEG[tseg * 64 + d] = run;
    __syncthreads();
    float off = 0.f;
#pragma unroll
    for (int s = 0; s < 8; ++s) { const float v = SEG[s * 64 + d]; off += (s < tseg) ? v : 0.f; }
#pragma unroll
    for (int tt = 0; tt < 8; ++tt) Bm[(8 * tseg + tt) * 65 + d] = off + loc[tt];
    __syncthreads();
}
__device__ __forceinline__ void gla_load_vt(LAS unsigned char* lds, const bf16_t* VTg, int hb, int c) {
    int tid_ = threadIdx.x; asm volatile("" : "+v"(tid_)); const int tid = tid_;
#pragma unroll
    for (int i = 0; i < 2; ++i) { const int id = tid + 512 * i, row = id >> 3, c8 = id & 7;
        *(LAS u32x4*)(lds + G_VT + row * 144 + c8 * 16) = *(const GAS u32x4*)((const GAS bf16_t*)VTg + (size_t)(1024 + hb * 128 + row) * LDV + 64 * c + 8 * c8); }
}
__device__ __forceinline__ void gla_part1(LAS unsigned char* lds, const Params& p, int l, int c, int hb) {
    int tid_ = threadIdx.x; asm volatile("" : "+v"(tid_)); const int tid = tid_, lane = tid & 63, w = __builtin_amdgcn_readfirstlane(tid >> 6), r16 = lane & 15, g = lane >> 4;
    const bf16_t* hm_rows = (const bf16_t*)(p.ws + WS_HM) + (size_t)(64 * c) * NMAIN;
    gla_compute_b(lds, hm_rows, p.gate_w + l * 16 * 256, p.gate_b + l * 256, hb);
    const LAS float* Bm = (const LAS float*)(lds + G_B);
    { GAS float* BG = (GAS float*)(p.ws + WS_BG) + (size_t)(64 * c) * 256 + hb * 64;
        const int t = tid >> 3, dc = tid & 7; f32x4 b0, b1;
        b0.x = Bm[t * 65 + 8 * dc + 0]; b0.y = Bm[t * 65 + 8 * dc + 1]; b0.z = Bm[t * 65 + 8 * dc + 2]; b0.w = Bm[t * 65 + 8 * dc + 3];
        b1.x = Bm[t * 65 + 8 * dc + 4]; b1.y = Bm[t * 65 + 8 * dc + 5]; b1.z = Bm[t * 65 + 8 * dc + 6]; b1.w = Bm[t * 65 + 8 * dc + 7];
        *(GAS f32x4*)(BG + (size_t)t * 256 + 8 * dc) = b0; *(GAS f32x4*)(BG + (size_t)t * 256 + 8 * dc + 4) = b1; }
    { const int t = tid >> 3, dc = tid & 7; const u32x4 kv = *(const GAS u32x4*)((const GAS bf16_t*)hm_rows + (size_t)t * NMAIN + C_BK + hb * 64 + 8 * dc);
        float kf[8] = {bflo(kv.x), bfhi(kv.x), bflo(kv.y), bfhi(kv.y), bflo(kv.z), bfhi(kv.z), bflo(kv.w), bfhi(kv.w)};
        LAS bf16_t* KD = (LAS bf16_t*)(lds + G_KD);
#pragma unroll
        for (int e = 0; e < 8; ++e) { const int d = 8 * dc + e; const float val = kf[e] * __expf(Bm[63 * 65 + d] - Bm[t * 65 + d]); KD[d * 72 + t] = (bf16_t)(pk2(val, 0.f) & 0xffffu); } }
    gla_load_vt(lds, (const bf16_t*)(p.ws + WS_VT), hb, c);
    if (tid < 64) ((GAS float*)(p.ws + WS_DCY))[(c * 4 + hb) * 64 + tid] = __expf(Bm[63 * 65 + tid]);
    __syncthreads();
    GAS bf16_t* U = (GAS bf16_t*)(p.ws + WS_U) + (size_t)(c * 4 + hb) * 8192;
    const LAS unsigned char* Ap = lds + G_VT + (16 * w + r16) * 144 + g * 16;
#pragma unroll
    for (int dkb = 0; dkb < 4; ++dkb) { const LAS unsigned char* Bp = lds + G_KD + (16 * dkb + r16) * 144 + g * 16; f32x4 acc = (f32x4){0.f, 0.f, 0.f, 0.f};
#pragma unroll
        for (int ks = 0; ks < 2; ++ks) acc = MFMA16(*(const LAS bf16x8*)(Bp + ks * 64), *(const LAS bf16x8*)(Ap + ks * 64), acc);
        u32x2 ub; ub.x = pk2(acc[0], acc[1]); ub.y = pk2(acc[2], acc[3]); *(GAS u32x2*)(U + (16 * w + r16) * 64 + 16 * dkb + 4 * g) = ub; }
    __syncthreads();
}
__device__ __forceinline__ void gla_scan(const Params& p, LAS unsigned char* lds) {
    int tid_ = threadIdx.x; asm volatile("" : "+v"(tid_)); const int tid = tid_, seg = tid >> 7, el = tid & 127;
    LAS float* CE = (LAS float*)lds;
    for (int eg = blockIdx.x; eg < 256; eg += gridDim.x) {
        const int e = eg * 128 + el, hb = e >> 13, rem = e & 8191, dk = rem & 63;
        const GAS bf16_t* U = (const GAS bf16_t*)(p.ws + WS_U) + (size_t)hb * 8192 + rem + (size_t)(seg * 32) * 32768;
        const GAS float* dcy = (const GAS float*)(p.ws + WS_DCY) + hb * 64 + dk + (seg * 32) * 256;
        GAS bf16_t* Sp = (GAS bf16_t*)(p.ws + WS_SP) + (size_t)hb * 8192 + rem + (size_t)(seg * 32) * 32768;
        float uv[32], dv[32];
#pragma unroll
        for (int j = 0; j < 32; ++j) { uv[j] = __uint_as_float(((unsigned)U[(size_t)j * 32768]) << 16); dv[j] = dcy[j * 256]; }
        float s = 0.f, pd = 1.f;
#pragma unroll
        for (int j = 0; j < 32; ++j) { const float u = uv[j], d = dv[j]; uv[j] = s; dv[j] = pd; s = d * s + u; pd *= d; }
        CE[seg * 128 + el] = s; CE[512 + seg * 128 + el] = pd;
        __syncthreads();
        float st = 0.f;
#pragma unroll
        for (int q = 0; q < 3; ++q) { const float se = CE[q * 128 + el], pe = CE[512 + q * 128 + el]; st = (q < seg) ? pe * st + se : st; }
#pragma unroll
        for (int j = 0; j < 32; ++j) Sp[(size_t)j * 32768] = (bf16_t)(pk2(uv[j] + dv[j] * st, 0.f) & 0xffffu);
        __syncthreads();
    }
}
struct Gla2Regs { u32x4 qv, kv; f32x4 b0, b1; u32x4 vt[2], st[2]; u32x2 zpre[4]; f32x4 gpre[4]; };
__device__ __forceinline__ void gla_part2_load(Gla2Regs& R, const Params& p, int l, int c, int hb, int tid, int w, int r16, int g) {
    const GAS bf16_t* hm_rows = (const GAS bf16_t*)(p.ws + WS_HM) + (size_t)(64 * c) * NMAIN;
    const int t = tid >> 3, dc = tid & 7;
    R.qv = *(const GAS u32x4*)(hm_rows + (size_t)t * NMAIN + C_BQ + hb * 64 + 8 * dc); R.kv = *(const GAS u32x4*)(hm_rows + (size_t)t * NMAIN + C_BK + hb * 64 + 8 * dc);
    const GAS float* BG = (const GAS float*)(p.ws + WS_BG) + (size_t)(64 * c + t) * 256 + hb * 64 + 8 * dc;
    R.b0 = *(const GAS f32x4*)BG; R.b1 = *(const GAS f32x4*)(BG + 4);
    const GAS bf16_t* VTg = (const GAS bf16_t*)(p.ws + WS_VT); const GAS bf16_t* Sp = (const GAS bf16_t*)(p.ws + WS_SP) + (size_t)(c * 4 + hb) * 8192;
#pragma unroll
    for (int i = 0; i < 2; ++i) { const int id = tid + 512 * i, row = id >> 3, c8 = id & 7;
        R.vt[i] = *(const GAS u32x4*)(VTg + (size_t)(1024 + hb * 128 + row) * LDV + 64 * c + 8 * c8); R.st[i] = *(const GAS u32x4*)(Sp + row * 64 + 8 * c8); }
    const int i_ = 16 * (w & 3) + r16;
#pragma unroll
    for (int q4 = 0; q4 < 4; ++q4) { const int dv0 = 16 * (4 * (w >> 2) + q4) + 4 * g;
        R.zpre[q4] = *(const GAS u32x2*)(hm_rows + (size_t)i_ * NMAIN + C_BZ + hb * 128 + dv0); R.gpre[q4] = *(const GAS f32x4*)((const GAS float*)p.norm_g + l * 128 + dv0); }
}
__device__ __forceinline__ void gla_part2(LAS unsigned char* lds, const Params& p, int l, int c, int hb, const Gla2Regs& R, int tid, int w, int r16, int g) {
    const bf16_t* hm_rows = (const bf16_t*)(p.ws + WS_HM) + (size_t)(64 * c) * NMAIN;
    u32x2 zpre[4]; f32x4 gpre[4];
#pragma unroll
    for (int q4 = 0; q4 < 4; ++q4) { zpre[q4] = R.zpre[q4]; gpre[q4] = R.gpre[q4]; }
    {
        const int t = tid >> 3, dc = tid & 7;
        const u32x4 qv = R.qv, kv = R.kv; const f32x4 b0 = R.b0, b1 = R.b1;
        u32x4 vt[2] = {R.vt[0], R.vt[1]}, st[2] = {R.st[0], R.st[1]};
        float qf[8] = {bflo(qv.x), bfhi(qv.x), bflo(qv.y), bfhi(qv.y), bflo(qv.z), bfhi(qv.z), bflo(qv.w), bfhi(qv.w)};
        float kf[8] = {bflo(kv.x), bfhi(kv.x), bflo(kv.y), bfhi(kv.y), bflo(kv.z), bfhi(kv.z), bflo(kv.w), bfhi(kv.w)};
        float bb[8] = {b0.x, b0.y, b0.z, b0.w, b1.x, b1.y, b1.z, b1.w};
        float qpv[8], qmv[8], kpv[8], kmv[8];
#pragma unroll
        for (int e = 0; e < 8; ++e) { const float ep = __expf(bb[e]), em = __expf(-bb[e]), q8 = qf[e] * 0.125f;
            qpv[e] = q8 * ep; qmv[e] = q8 * em; kpv[e] = kf[e] * ep; kmv[e] = kf[e] * em; }
        const int o = t * 144 + dc * 16;
        *(LAS u32x4*)(lds + G_QP + o) = (u32x4){pk2(qpv[0], qpv[1]), pk2(qpv[2], qpv[3]), pk2(qpv[4], qpv[5]), pk2(qpv[6], qpv[7])};
        *(LAS u32x4*)(lds + G_QM + o) = (u32x4){pk2(qmv[0], qmv[1]), pk2(qmv[2], qmv[3]), pk2(qmv[4], qmv[5]), pk2(qmv[6], qmv[7])};
        *(LAS u32x4*)(lds + G_KP + o) = (u32x4){pk2(kpv[0], kpv[1]), pk2(kpv[2], kpv[3]), pk2(kpv[4], kpv[5]), pk2(kpv[6], kpv[7])};
        *(LAS u32x4*)(lds + G_KM + o) = (u32x4){pk2(kmv[0], kmv[1]), pk2(kmv[2], kmv[3]), pk2(kmv[4], kmv[5]), pk2(kmv[6], kmv[7])};
#pragma unroll
        for (int i = 0; i < 2; ++i) { const int id = tid + 512 * i, row = id >> 3, c8 = id & 7;
            *(LAS u32x4*)(lds + G_VT + row * 144 + c8 * 16) = vt[i]; *(LAS u32x4*)(lds + G_ST + row * 144 + c8 * 16) = st[i]; }
    }
    __syncthreads();
    { const int ib = w >> 1; LAS bf16_t* AT = (LAS bf16_t*)(lds + G_AT);
        const LAS unsigned char* qpA = lds + G_QP + (16 * ib + r16) * 144 + g * 16; const LAS unsigned char* qmA = lds + G_QM + (16 * ib + r16) * 144 + g * 16;
#pragma unroll
        for (int jj = 0; jj < 2; ++jj) { const int jb = 2 * (w & 1) + jj;
            const LAS unsigned char* kmB = lds + G_KM + (16 * jb + r16) * 144 + g * 16; const LAS unsigned char* kpB = lds + G_KP + (16 * jb + r16) * 144 + g * 16;
            f32x4 lo = (f32x4){0.f, 0.f, 0.f, 0.f}, hi = lo;
#pragma unroll
            for (int ks = 0; ks < 2; ++ks) { lo = MFMA16(*(const LAS bf16x8*)(qpA + ks * 64), *(const LAS bf16x8*)(kmB + ks * 64), lo);
                hi = MFMA16(*(const LAS bf16x8*)(qmA + ks * 64), *(const LAS bf16x8*)(kpB + ks * 64), hi); }
#pragma unroll
            for (int r = 0; r < 4; ++r) { const int i = 16 * ib + 4 * g + r, j = 16 * jb + r16; const float v = (j <= i) ? lo[r] : hi[r]; AT[i * 72 + j] = (bf16_t)(pk2(v, 0.f) & 0xffffu); } } }
    __syncthreads();
    const int ib = w & 3, dvh = w >> 2;
    f32x4 oacc[4];
    { const LAS unsigned char* atA = lds + G_AT + (16 * ib + r16) * 144 + g * 16; const LAS unsigned char* qpA = lds + G_QP + (16 * ib + r16) * 144 + g * 16;
#pragma unroll
        for (int q4 = 0; q4 < 4; ++q4) { const int dvb = 4 * dvh + q4;
            const LAS unsigned char* vtB = lds + G_VT + (16 * dvb + r16) * 144 + g * 16; const LAS unsigned char* stB = lds + G_ST + (16 * dvb + r16) * 144 + g * 16;
            f32x4 acc = (f32x4){0.f, 0.f, 0.f, 0.f};
#pragma unroll
            for (int ks = 0; ks < 2; ++ks) { acc = MFMA16(*(const LAS bf16x8*)(vtB + ks * 64), *(const LAS bf16x8*)(atA + ks * 64), acc);
                acc = MFMA16(*(const LAS bf16x8*)(stB + ks * 64), *(const LAS bf16x8*)(qpA + ks * 64), acc); }
            oacc[q4] = acc; } }
    LAS float* SSQ = (LAS float*)(lds + G_SSQ);
    { float pr = 0.f;
#pragma unroll
        for (int q4 = 0; q4 < 4; ++q4) pr += (oacc[q4][0] * oacc[q4][0] + oacc[q4][1] * oacc[q4][1]) + (oacc[q4][2] * oacc[q4][2] + oacc[q4][3] * oacc[q4][3]);
        pr += __shfl_xor(pr, 16); pr += __shfl_xor(pr, 32);
        if (g == 0) SSQ[dvh * 64 + 16 * ib + r16] = pr; }
    __syncthreads();
    { const int i = 16 * ib + r16; const float rinv = rsqrtf((SSQ[i] + SSQ[64 + i]) * (1.0f / 128.0f) + RMS_EPS);
        GAS bf16_t* Yr = (GAS bf16_t*)(p.ws + WS_Y) + (size_t)(64 * c + i) * DM + 1024 + hb * 128;
#pragma unroll
        for (int q4 = 0; q4 < 4; ++q4) { const int dv0 = 16 * (4 * dvh + q4) + 4 * g; const u32x2 z = zpre[q4]; const f32x4 gg = gpre[q4];
            const float y0 = oacc[q4][0] * rinv * gg.x * silu_f(bflo(z.x)), y1 = oacc[q4][1] * rinv * gg.y * silu_f(bfhi(z.x)), y2 = oacc[q4][2] * rinv * gg.z * silu_f(bflo(z.y)), y3 = oacc[q4][3] * rinv * gg.w * silu_f(bfhi(z.y));
            u32x2 yo; yo.x = pk2(y0, y1); yo.y = pk2(y2, y3); *(GAS u32x2*)(Yr + dv0) = yo; } }
    __syncthreads();
}

__device__ __forceinline__ void ln_phase(const Params& p, int l, const float* tin, float* fout) {
    int tid_ = threadIdx.x; asm volatile("" : "+v"(tid_)); const int tid = tid_, lane = tid & 63, wave = tid >> 6;
    const int gw = blockIdx.x * 8 + wave, NGW = gridDim.x * 8;
    const float* lg = p.ln_g + l * DM; const float* lb = p.ln_b + l * DM; bf16_t* xb = (bf16_t*)(p.ws + WS_XB);
    for (int row = gw; row < SEQ; row += NGW) {
        const f32x4* xr = (const f32x4*)(tin + (size_t)row * DM) + lane;
        f32x4 v[8]; float s = 0.f;
#pragma unroll
        for (int j = 0; j < 8; ++j) { v[j] = xr[64 * j]; s += (v[j].x + v[j].y) + (v[j].z + v[j].w); }
#pragma unroll
        for (int o = 1; o < 64; o <<= 1) s += __shfl_xor(s, o);
        const float mean = s * (1.0f / DM); float s2 = 0.f;
#pragma unroll
        for (int j = 0; j < 8; ++j) { v[j] = v[j] - mean; s2 += (v[j].x * v[j].x + v[j].y * v[j].y) + (v[j].z * v[j].z + v[j].w * v[j].w); }
#pragma unroll
        for (int o = 1; o < 64; o <<= 1) s2 += __shfl_xor(s2, o);
        const float rstd = rsqrtf(s2 * (1.0f / DM) + LN_EPS);
        f32x4* orow = (f32x4*)(fout + (size_t)row * DM) + lane; u32x2* brow = (u32x2*)(xb + (size_t)row * DM) + lane;
#pragma unroll
        for (int j = 0; j < 8; ++j) { const f32x4 gg = ((const f32x4*)lg)[lane + 64 * j], bb = ((const f32x4*)lb)[lane + 64 * j];
            const f32x4 y = v[j] * rstd * gg + bb; orow[64 * j] = y; u32x2 o2; o2.x = pk2(y.x, y.y); o2.y = pk2(y.z, y.w); brow[64 * j] = o2; }
    }
}

#define XB_TMO      128
#define XB_XCNT(j)  (256  + 64 * (j))
#define XB_XSUB(j)  (1280 + 64 * (j))
#define XB_XGEN(j)  (2304 + 64 * (j))
#define XB_TOP      3328
#define XB_TOPGEN   3392
#define XCD_BAR_WORDS 3456
#define XB_SPIN_CAP (1u << 18)

__device__ __forceinline__ unsigned xb_ld(unsigned* p)              { return __hip_atomic_load(p, __ATOMIC_RELAXED, __HIP_MEMORY_SCOPE_AGENT); }
__device__ __forceinline__ unsigned xb_add(unsigned* p, unsigned v) { return __hip_atomic_fetch_add(p, v, __ATOMIC_RELAXED, __HIP_MEMORY_SCOPE_AGENT); }
__device__ __forceinline__ unsigned xb_xcc_id() { return (unsigned)__builtin_amdgcn_s_getreg((3 << 11) | 20) & 0xFu; }
#define XB_SPIN(cond, bar) do { unsigned _sp = 0; while (cond) { __builtin_amdgcn_s_sleep(1); \
    if ((++_sp & 255u) == 0u) { if (xb_ld(&(bar)[XB_TMO])) break; if (_sp > XB_SPIN_CAP) { atomicAdd(&(bar)[XB_TMO], 1u); break; } } } } while (0)

struct XcdBarrier {
    unsigned* bar; unsigned x;
    volatile LAS unsigned* st;
};

__device__ __forceinline__ XcdBarrier xcd_barrier_post(unsigned* bar, volatile LAS unsigned* st) {
    XcdBarrier b; b.bar = bar; b.x = xb_xcc_id(); b.st = st;
    if (threadIdx.x == 0) (void)xb_add(&bar[XB_XCNT(b.x)], 1u);
    return b;
}
__device__ __forceinline__ void xcd_barrier_complete(unsigned* bar, unsigned x, unsigned& nloc, unsigned& nx) {
    const unsigned G = gridDim.x * gridDim.y * gridDim.z;
    unsigned sum, cnt, mine, sp = 0u;
    for (;;) {
        sum = 0u; cnt = 0u; mine = 0u;
#pragma unroll
        for (unsigned j = 0; j < 16; ++j) { const unsigned c = xb_ld(&bar[XB_XCNT(j)]); sum += c; cnt += (c > 0u) ? 1u : 0u; mine = (j == x) ? c : mine; }
        if (sum == G) break;
        __builtin_amdgcn_s_sleep(1);
        if ((++sp & 255u) == 0u) { if (xb_ld(&bar[XB_TMO])) break; if (sp > XB_SPIN_CAP) { atomicAdd(&bar[XB_TMO], 1u); break; } }
    }
    nloc = mine > 0u ? mine : 1u; nx = cnt > 0u ? cnt : 1u;
}

__device__ __forceinline__ void xcd_barrier(const XcdBarrier& b) {
    asm volatile("s_waitcnt vmcnt(0)" ::: "memory");
    __syncthreads();
    if (threadIdx.x == 0) {
        unsigned* bar = b.bar;
        __builtin_amdgcn_s_waitcnt(0);
        unsigned nloc = b.st[0], nx = b.st[1];
        if (nloc == 0u) { xcd_barrier_complete(bar, b.x, nloc, nx); b.st[0] = nloc; b.st[1] = nx; }
        const unsigned old = xb_add(&bar[XB_XSUB(b.x)], 1u);
        const unsigned gen = old / nloc;
        if (old + 1u == (gen + 1u) * nloc) {
            __builtin_amdgcn_fence(__ATOMIC_RELEASE, "agent");
            asm volatile("s_waitcnt vmcnt(0)" ::: "memory");
            const unsigned og = xb_add(&bar[XB_TOP], 1u);
            const unsigned tg = og / nx;
            if (og + 1u == (tg + 1u) * nx) xb_add(&bar[XB_TOPGEN], 1u);
            else XB_SPIN(xb_ld(&bar[XB_TOPGEN]) == tg, bar);
            __builtin_amdgcn_fence(__ATOMIC_ACQUIRE, "agent");
            xb_add(&bar[XB_XGEN(b.x)], 1u);
            asm volatile("s_waitcnt vmcnt(0)" ::: "memory");
        } else {
            XB_SPIN(xb_ld(&bar[XB_XGEN(b.x)]) == gen, bar);
            __builtin_amdgcn_fence(__ATOMIC_ACQUIRE, "agent");
            asm volatile("s_waitcnt vmcnt(0)" ::: "memory");
        }
    }
    __syncthreads();
}

constexpr int NPH = 1 + 6 * DEPTH;
__global__ void __launch_bounds__(512, 2) mega(Params p_in) {
    extern __shared__ __attribute__((aligned(16))) unsigned char lds_raw[];
    LAS unsigned char* lds = (LAS unsigned char*)lds_raw;
    cg::grid_group grid = cg::this_grid();
    const int bid = blockIdx.x, G = gridDim.x;
    volatile LAS unsigned* misc = (volatile LAS unsigned*)(lds + LDS_BYTES - 64);
    if (threadIdx.x < 16) misc[threadIdx.x] = 0u;
    __syncthreads();
    const XcdBarrier bar = xcd_barrier_post((unsigned*)(p_in.ws + WS_CTL), misc);
    if (p_in.ph_hi < 0) grid.sync();
    const Params& p0 = p_in;
    for (int ph = p0.ph_lo; ph < p0.ph_hi; ++ph) {
        Params p = p0; asm volatile("" : "+s"(p.ws));
        bf16_t* xb = (bf16_t*)(p.ws + WS_XB); float* xf = (float*)(p.ws + WS_XF);
        bf16_t* hm = (bf16_t*)(p.ws + WS_HM); bf16_t* VT = (bf16_t*)(p.ws + WS_VT); bf16_t* Y = (bf16_t*)(p.ws + WS_Y);
        if (ph == 0) phase0(p, lds);
        else {
            const int l = (ph - 1) / 6, k = (ph - 1) % 6;
            const bf16_t* win = (const bf16_t*)(p.ws + WS_WIN + l * WIN_L);
            if (k == 0) {
                for (int gi = 0; gi < 4; ++gi) {
                    pg8::Gemm g; bf16_t* O; int ldc, c;
                    if (gi == 0) { g.A = xb; g.Bt = win; g.M = SEQ; g.N = NMAIN; O = hm; ldc = NMAIN; c = bid; }
                    else if (gi == 1) { g.A = win + (size_t)NMAIN * DM; g.Bt = xb; g.M = NVT; g.N = SEQ; O = VT; ldc = LDV; c = G - 1 - bid; }
                    else if (gi == 2) { g.A = (const bf16_t*)(p.ws + WS_MEMB); g.Bt = (const bf16_t*)(p.ws + WS_WMK) + (size_t)l * 512 * DM; g.M = NMEM; g.N = 512; O = (bf16_t*)(p.ws + WS_MK) + l * 512; ldc = 2048;
                        c = (bid >= G - 16 && bid < G - 14) ? bid - (G - 16) : (1 << 24); }
                    else { g.A = (const bf16_t*)(p.ws + WS_WMV) + (size_t)l * 512 * DM; g.Bt = (const bf16_t*)(p.ws + WS_MEMB); g.M = 512; g.N = NMEM; O = (bf16_t*)(p.ws + WS_MVT) + (size_t)l * 512 * NMEM; ldc = NMEM;
                        c = (bid >= G - 14 && bid < G - 12) ? bid - (G - 14) : (1 << 24); }
                    g.K = DM;
                    pg8::StaticOrder S; S.init(g.M, g.N, G, c);
                    pg8::EpiBf16<0> E{O, ldc, nullptr, 0, 0, 1.f};
                    pg8::gemm_phase<pg8::EpiBf16<0>, pg8::StaticOrder, true, true>(lds, g, S, E);
                }
                if (l + 1 < DEPTH) {
                    int wkb = bid, nwb = G;
                    if (G == 256) { nwb = 144; wkb = bid < 64 ? bid : (bid >= 160 && bid < 240 ? bid - 96 : -1); }
                    if (wkb >= 0) { int t2_ = threadIdx.x; asm volatile("" : "+v"(t2_)); convert_layer(p, l + 1, lds, wkb * 8 + (t2_ >> 6), nwb * 8); }
                }
            } else if (k == 1) {
                for (int u = bid; u < 256; u += G) band_pair_unit(lds, p, l, u >> 2, 2 * (u & 3));
                for (int u = bid; u < 256; u += G) { const int head = u & 3, qb = u >> 2;
                    attn_unit<false>(lds, 128 * qb, hm + C_MQ + head * 128, NMAIN, (const bf16_t*)(p.ws + WS_MK) + l * 512 + head * 128, 2048,
                                     (const bf16_t*)(p.ws + WS_MVT) + (size_t)(l * 512 + head * 128) * NMEM, NMEM, hm + C_MZ + head * 128, NMAIN, Y + 1536 + head * 128, DM, nullptr, 0); }
                for (int u = bid; u < 512; u += G) gla_part1(lds, p, l, u >> 2, u & 3);
            } else if (k == 2) gla_scan(p, lds);
            else if (k == 3) {
                int t3_ = threadIdx.x; asm volatile("" : "+v"(t3_)); const int tid3 = t3_, w3 = __builtin_amdgcn_readfirstlane(tid3 >> 6), r3 = tid3 & 15, g3 = (tid3 & 63) >> 4;
                if (G == 256) {
                    Gla2Regs RA, RB; const int u = bid, u2 = bid + 256;
                    gla_part2_load(RA, p, l, u >> 2, u & 3, tid3, w3, r3, g3);
                    gla_part2_load(RB, p, l, u2 >> 2, u2 & 3, tid3, w3, r3, g3);
                    gla_part2(lds, p, l, u >> 2, u & 3, RA, tid3, w3, r3, g3);
                    gla_part2(lds, p, l, u2 >> 2, u2 & 3, RB, tid3, w3, r3, g3);
                } else {
                    for (int u = bid; u < 512; u += G) { Gla2Regs RA; gla_part2_load(RA, p, l, u >> 2, u & 3, tid3, w3, r3, g3); gla_part2(lds, p, l, u >> 2, u & 3, RA, tid3, w3, r3, g3); }
                }
            }
            else if (k == 4) {
                pg8::Gemm g; g.A = Y; g.Bt = (const bf16_t*)(p.ws + WS_WOUT + l * WOUT_L); g.M = SEQ; g.N = DM; g.K = DM;
                pg8::StaticOrder S; S.init(SEQ, DM, G, bid);
                if (G == 256) {
                    pg8::EpiResLn E{l == 0 ? p.x : (const float*)nullptr, l == DEPTH - 1 ? p.out : (float*)nullptr, xb, (bf16_t*)(p.ws + WS_XL), p.ln_g + l * DM, p.ln_b + l * DM, (unsigned long long*)(p.ws + WS_XCH),
                                    (unsigned*)(p.ws + WS_CTL) + CW_CNT + l * 2048, 1.6817928305074292f, LN_EPS};
                    pg8::gemm_phase<pg8::EpiResLn, pg8::StaticOrder, false, true>(lds, g, S, E);
                } else {
                    pg8::EpiResid E{l == 0 ? p.x : xf, xf, DM, 1.6817928305074292f};
                    pg8::gemm_phase<pg8::EpiResid, pg8::StaticOrder, true, true>(lds, g, S, E);
                }
            } else if (G != 256) ln_phase(p, l, xf, l == DEPTH - 1 ? p.out : xf);
        }
        if (ph + 1 < p0.ph_hi && !(G == 256 && ph > 0 && (ph - 1) % 6 == 4)) xcd_barrier(bar);
    }
}

extern "C" void kernel_launch(void* const* d_in, const int* in_sizes, int n_in, void* d_out, int out_size, void* d_ws, size_t ws_size, hipStream_t stream) {
    static int grid = 0;
    if (grid == 0) {
        if (n_in != 11 || ws_size < WS_END) { fprintf(stderr, "kernel_launch: unexpected inputs (n_in %d, ws %zu)\n", n_in, ws_size); grid = -1; return; }
        int dev = 0, cus = 0, per_cu = 0;
        hipGetDevice(&dev); hipDeviceGetAttribute(&cus, hipDeviceAttributeMultiprocessorCount, dev);
        hipFuncSetAttribute((const void*)mega, hipFuncAttributeMaxDynamicSharedMemorySize, LDS_BYTES);
        hipOccupancyMaxActiveBlocksPerMultiprocessor(&per_cu, (const void*)mega, 512, LDS_BYTES);
        if (per_cu < 1) per_cu = 1;
        (void)hipGetLastError();
        grid = cus * per_cu;
    }
    if (grid < 0) return;
    Params p{};
    p.x = (const float*)d_in[0]; p.mem = (const float*)d_in[1]; p.w_in = (const float*)d_in[2]; p.rel = (const float*)d_in[3]; p.gate_w = (const float*)d_in[4];
    p.gate_b = (const float*)d_in[5]; p.norm_g = (const float*)d_in[6]; p.w_mkv = (const float*)d_in[7]; p.w_out = (const float*)d_in[8]; p.ln_g = (const float*)d_in[9]; p.ln_b = (const float*)d_in[10];
    p.out = (float*)d_out; p.ws = (unsigned char*)d_ws;
    if (hipMemsetAsync((char*)d_ws + WS_CTL, 0, CTL_BYTES, stream) != hipSuccess) { fprintf(stderr, "memset failed\n"); return; }
#if defined(MK_MULTI)
    for (int ph = 0; ph < NPH; ++ph) { p.ph_lo = ph; p.ph_hi = ph + 1; hipLaunchKernelGGL(mega, dim3(grid), dim3(512), LDS_BYTES, stream, p); }
#else
    p.ph_lo = 0; p.ph_hi = NPH;
    void* args[] = {&p};
    hipError_t e = hipLaunchCooperativeKernel((const void*)mega, dim3(grid), dim3(512), args, LDS_BYTES, stream);
    if (e != hipSuccess) fprintf(stderr, "cooperative launch failed: %s (grid %d)\n", hipGetErrorString(e), grid);
#endif
}
```

```cpp
#include <hip/hip_runtime.h>
#include <hip/hip_cooperative_groups.h>
#include <cstdio>
#include <cstdint>
namespace cg = cooperative_groups;
namespace pg8 {
#define PG8_LAS __attribute__((address_space(3)))
typedef unsigned short bf16_t;
typedef short bf16x8 __attribute__((ext_vector_type(8)));
typedef float f32x4 __attribute__((ext_vector_type(4)));
typedef unsigned u32x4 __attribute__((ext_vector_type(4)));
constexpr int BM = 256, BK = 64, HALF = 128, HTB = HALF * BK * 2  , STAGE_BYTES = 8 * HTB, NXCD = 8, WGM = 8;

__host__ __device__ __forceinline__ int lds_byte(int r, int c) { const int st = (r >> 4) * 2 + (c >> 5), rr = r & 15, cc = c & 31, ob = rr * 64 + cc * 2; return st * 1024 + (ob ^ (((ob >> 9) & 1) << 5)); }
__host__ __device__ __forceinline__ void stage_rc(int b, int& R, int& C) { const int st = b / 1024, sb = b % 1024, swz = sb ^ (((sb >> 9) & 1) << 5); R = (st >> 1) * 16 + swz / 64; C = (st & 1) * 32 + (swz % 64) / 2; }
__host__ __device__ __forceinline__ int perm32(int rho) { const int n = rho >> 4, i = rho & 15; return 8 * (i >> 2) + 4 * n + (i & 3); }

struct Unit { int pm, pn; };
struct Gemm { const bf16_t* A; const bf16_t* Bt; int M, N, K; };

struct StaticOrder {
    int nM, nN, nwg, G, c;
    __host__ __device__ void init(int M, int N, int G_, int c_) { nM = M / BM; nN = N / BM; nwg = nM * nN; G = G_; c = c_; }
    __host__ __device__ bool next(int i, Unit& u) const {
        const long L = (long)i * G + c; if (L >= nwg) return false;
        int wgid = (int)L; { const int q = nwg / NXCD, r = nwg % NXCD, xcd = wgid % NXCD, off = wgid / NXCD; wgid = (xcd < r ? xcd * (q + 1) : r * (q + 1) + (xcd - r) * q) + off; }
        const int nig = WGM * nN, gid = wgid / nig, fm = gid * WGM, gsz = (nM - fm) < WGM ? (nM - fm) : WGM;
        u.pm = fm + ((wgid % nig) % gsz); u.pn = (wgid % nig) / gsz; return true;
    }
    __device__ __forceinline__ void a_ready(const Unit&) const {}
    __device__ __forceinline__ void done(const Unit&) const {}
};

__device__ __forceinline__ unsigned cvt_pk_bf16(float lo, float hi) { unsigned r; asm volatile("v_cvt_pk_bf16_f32 %0, %1, %2" : "=v"(r) : "v"(lo), "v"(hi)); return r; }
typedef float f32x2 __attribute__((ext_vector_type(2)));
__device__ __forceinline__ f32x2 gelu_pk(f32x2 v) {
    const f32x2 av = __builtin_elementwise_abs(v), d = av * 0.2316418882f + 1.0f;
    f32x2 t; t.x = __builtin_amdgcn_rcpf(d.x); t.y = __builtin_amdgcn_rcpf(d.y);
    f32x2 q = t * 0.5307027145f + (-0.7265760135f); q = q * t + 0.7107068705f; q = q * t + (-0.142248368f); q = q * t + 0.127414796f; q = q * t;
    const f32x2 s = (v * v) * (-0.72134752044f);
    f32x2 e; e.x = __builtin_amdgcn_exp2f(s.x); e.y = __builtin_amdgcn_exp2f(s.y);
    const f32x2 m = v * (q * e), r = v - m;
    f32x2 o; o.x = v.x < 0.f ? m.x : r.x; o.y = v.y < 0.f ? m.y : r.y; return o;
}

template <int ACT  > struct EpiBf16 {
    static constexpr bool PERM = true, AFTER_DRAIN = false; static_assert(ACT == 0 || ACT == 1, "EpiBf16: ACT is 0 (none) or 1 (gelu_pk)");
    bf16_t* O; int ldc; const float* bias; int split_cols; size_t split_stride; float scale0;
    __device__ __forceinline__ void operator()(const f32x4 (&acc)[2][2][4][2], const Unit& u, int wr, int wc, int fr, int fq) const {
        const int row0 = u.pm * BM + wr * 64 + fr; int colt = u.pn * BM; bf16_t* base = O;
        float sc = 1.f; if (split_cols) { const int t = colt / split_cols; base += (size_t)t * split_stride; colt -= t * split_cols; if (t == 0) sc = scale0; }
        const int col0 = colt + wc * 32 + 8 * fq, bcol0 = u.pn * BM + wc * 32 + 8 * fq;
        f32x4 bv[2][2];
#pragma unroll
        for (int bj = 0; bj < 2; ++bj)
#pragma unroll
            for (int n = 0; n < 2; ++n) bv[bj][n] = bias ? *(const f32x4*)(bias + bcol0 + bj * HALF + 4 * n) : (f32x4){0.f, 0.f, 0.f, 0.f};
#pragma unroll
        for (int ai = 0; ai < 2; ++ai)
#pragma unroll
            for (int m = 0; m < 4; ++m) { bf16_t* rowp = base + (size_t)(row0 + ai * HALF + m * 16) * ldc + col0;
#pragma unroll
                for (int bj = 0; bj < 2; ++bj) { f32x4 v0 = acc[ai][bj][m][0] + bv[bj][0], v1 = acc[ai][bj][m][1] + bv[bj][1];
                    if (ACT == 1) { f32x2 a = gelu_pk((f32x2){v0[0], v0[1]}), b = gelu_pk((f32x2){v0[2], v0[3]}), c = gelu_pk((f32x2){v1[0], v1[1]}), d = gelu_pk((f32x2){v1[2], v1[3]});
                        v0 = (f32x4){a.x, a.y, b.x, b.y}; v1 = (f32x4){c.x, c.y, d.x, d.y}; }
                    v0 = v0 * sc; v1 = v1 * sc; u32x4 w; w.x = cvt_pk_bf16(v0[0], v0[1]); w.y = cvt_pk_bf16(v0[2], v0[3]); w.z = cvt_pk_bf16(v1[0], v1[1]); w.w = cvt_pk_bf16(v1[2], v1[3]);
                    *(u32x4*)(rowp + bj * HALF) = w; } }
    }
};
template <class Epi, class Sched, bool ALIGN_EPI = false, bool SP2 = false>
__device__ __forceinline__ void gemm_phase(PG8_LAS unsigned char* lds, const Gemm g, const Sched& S, const Epi& E) {
    int tid_ = threadIdx.x; asm volatile("" : "+v"(tid_)); const int tid = tid_, wid = __builtin_amdgcn_readfirstlane(tid >> 6), lane = tid & 63, wr = wid >> 2, wc = wid & 3, fr = lane & 15, fq = lane >> 4;
    const int K = g.K, nt = K / BK;
    unsigned voffA[2], voffB[2];
#pragma unroll
    for (int i = 0; i < 2; ++i) { int R, C; stage_rc(tid * 16 + i * 8192, R, C); const int Rb = Epi::PERM ? ((R & ~31) + perm32(R & 31)) : R;
        voffA[i] = (unsigned)(R * K + C) * 2u; voffB[i] = (unsigned)(Rb * K + C) * 2u; }
    const size_t kstep = (size_t)(BK * 2);
    const size_t hstep = (size_t)HALF * K * 2;
    const size_t tstep = 2 * hstep;
    const unsigned ldsw = (unsigned)wid * 1024u;
    const int aoff = lds_byte(wr * 64 + fr, fq * 8), boff = lds_byte(wc * 32 + fr, fq * 8);
#define PG8_SA(b, h) (((b) * 2 + (h)) * HTB)
#define PG8_SB(b, h) ((4 + (b) * 2 + (h)) * HTB)
#define PG8_STAGE(bufoff, gbase, voff) do { _Pragma("unroll") for (int _i = 0; _i < 2; ++_i) \
        __builtin_amdgcn_global_load_lds((const unsigned*)((const char*)(gbase) + (voff)[_i]), (PG8_LAS unsigned*)(lds + (bufoff) + ldsw + _i * 8192), 16, 0, 0); } while (0)
#define PG8_LDA(dst, b, h) do { _Pragma("unroll") for (int m = 0; m < 4; ++m) _Pragma("unroll") for (int k = 0; k < 2; ++k) dst[m][k] = *(const PG8_LAS bf16x8*)(lds + PG8_SA(b, h) + aoff + m * 2048 + k * 1024); } while (0)
#define PG8_LDB(dst, b, h) do { _Pragma("unroll") for (int n = 0; n < 2; ++n) _Pragma("unroll") for (int k = 0; k < 2; ++k) dst[n][k] = *(const PG8_LAS bf16x8*)(lds + PG8_SB(b, h) + boff + n * 2048 + k * 1024); } while (0)
#define PG8_MMA(ai, bj, At, Bt) do { __builtin_amdgcn_s_setprio(1); _Pragma("unroll") for (int m = 0; m < 4; ++m) _Pragma("unroll") for (int n = 0; n < 2; ++n) _Pragma("unroll") for (int k = 0; k < 2; ++k) \
        acc[ai][bj][m][n] = __builtin_amdgcn_mfma_f32_16x16x32_bf16(Bt[n][k], At[m][k], acc[ai][bj][m][n], 0, 0, 0); __builtin_amdgcn_s_setprio(0); } while (0)
#define PG8_WAIT_V(n) asm volatile("s_waitcnt vmcnt(" #n ")" ::: "memory")
#define PG8_WAIT_L(n) asm volatile("s_waitcnt lgkmcnt(" #n ")" ::: "memory")
#define PG8_BAR __builtin_amdgcn_s_barrier()
#define PG8_SCHED __builtin_amdgcn_sched_barrier(0)
    Unit cur, nxt; int ui = 0;
    if (!S.next(0, cur)) return;
    f32x4 acc[2][2][4][2];
#pragma unroll
    for (int a = 0; a < 2; ++a)
#pragma unroll
        for (int b = 0; b < 2; ++b)
#pragma unroll
            for (int m = 0; m < 4; ++m)
#pragma unroll
                for (int n = 0; n < 2; ++n) acc[a][b][m][n] = (f32x4){0.f, 0.f, 0.f, 0.f};
    bf16x8 At[4][2], B0[2][2], B1[2][2];
    const char* cA = (const char*)g.A + (size_t)cur.pm * tstep; const char* cB = (const char*)g.Bt + (size_t)cur.pn * tstep;
    S.a_ready(cur);
    if constexpr (SP2) {
        PG8_STAGE(PG8_SB(0, 0), cB, voffB); PG8_STAGE(PG8_SB(0, 1), cB + hstep, voffB); PG8_STAGE(PG8_SA(0, 0), cA, voffA); PG8_STAGE(PG8_SA(0, 1), cA + hstep, voffA);
        if (wr == 1) PG8_BAR;
        PG8_WAIT_V(2); PG8_BAR;
        PG8_STAGE(PG8_SB(1, 0), cB + kstep, voffB); PG8_STAGE(PG8_SA(1, 0), cA + kstep, voffA); PG8_STAGE(PG8_SB(1, 1), cB + hstep + kstep, voffB);
        PG8_WAIT_V(6); PG8_BAR;
    } else {
        PG8_STAGE(PG8_SB(0, 0), cB, voffB); PG8_STAGE(PG8_SA(0, 0), cA, voffA); PG8_STAGE(PG8_SB(0, 1), cB + hstep, voffB); PG8_STAGE(PG8_SA(0, 1), cA + hstep, voffA);
        if (wr == 1) PG8_BAR;
        PG8_WAIT_V(4); PG8_BAR;
        PG8_STAGE(PG8_SB(1, 0), cB + kstep, voffB); PG8_STAGE(PG8_SA(1, 0), cA + kstep, voffA); PG8_STAGE(PG8_SB(1, 1), cB + hstep + kstep, voffB);
        PG8_WAIT_V(6); PG8_BAR;
    }
    for (;;) {
        const bool has_next = S.next(ui + 1, nxt);
        const char* nA = has_next ? (const char*)g.A + (size_t)nxt.pm * tstep : cA; const char* nB = has_next ? (const char*)g.Bt + (size_t)nxt.pn * tstep : cB;
        for (int t = 0; t < nt; t += 2) {
            const bool last = (t == nt - 2);
            const char* a1 = cA + (size_t)(t + 1) * kstep;
            const char* a2 = last ? nA : cA + (size_t)(t + 2) * kstep; const char* b2 = last ? nB : cB + (size_t)(t + 2) * kstep;
            const char* a3 = a2 + kstep; const char* b3 = b2 + kstep;
            if (last && has_next) S.a_ready(nxt);
            if constexpr (SP2) {
            PG8_LDB(B0, 0, 0); PG8_LDB(B1, 0, 1); PG8_SCHED; PG8_LDA(At, 0, 0); PG8_STAGE(PG8_SA(1, 1), a1 + hstep, voffA);
            PG8_WAIT_V(8); PG8_WAIT_L(0); PG8_BAR; PG8_MMA(0, 0, At, B0); PG8_MMA(0, 1, At, B1); PG8_BAR; PG8_SCHED;
            PG8_LDA(At, 0, 1); PG8_STAGE(PG8_SB(0, 0), b2, voffB); PG8_STAGE(PG8_SB(0, 1), b2 + hstep, voffB); PG8_STAGE(PG8_SA(0, 0), a2, voffA);
            PG8_WAIT_V(8); PG8_WAIT_L(0); PG8_BAR; PG8_MMA(1, 0, At, B0); PG8_MMA(1, 1, At, B1); PG8_BAR; PG8_SCHED;
            PG8_LDB(B0, 1, 0); PG8_LDB(B1, 1, 1); PG8_SCHED; PG8_LDA(At, 1, 0); PG8_STAGE(PG8_SA(0, 1), a2 + hstep, voffA);
            PG8_WAIT_V(8); PG8_WAIT_L(0); PG8_BAR; PG8_MMA(0, 0, At, B0); PG8_MMA(0, 1, At, B1); PG8_BAR; PG8_SCHED;
            PG8_LDA(At, 1, 1); PG8_STAGE(PG8_SB(1, 0), b3, voffB); PG8_STAGE(PG8_SB(1, 1), b3 + hstep, voffB); PG8_STAGE(PG8_SA(1, 0), a3, voffA);
            PG8_WAIT_V(8); PG8_WAIT_L(0); PG8_BAR; PG8_MMA(1, 0, At, B0); PG8_MMA(1, 1, At, B1); PG8_BAR; PG8_SCHED;
            } else {
            PG8_LDB(B0, 0, 0); PG8_SCHED; PG8_LDA(At, 0, 0); PG8_STAGE(PG8_SA(1, 1), a1 + hstep, voffA);
            PG8_WAIT_L(8); PG8_BAR; PG8_WAIT_L(0); PG8_MMA(0, 0, At, B0); PG8_BAR; PG8_SCHED;
            PG8_LDB(B1, 0, 1); PG8_STAGE(PG8_SB(0, 0), b2, voffB);
            PG8_BAR; PG8_WAIT_L(0); PG8_MMA(0, 1, At, B1); PG8_BAR;
            PG8_LDA(At, 0, 1); PG8_STAGE(PG8_SA(0, 0), a2, voffA);
            PG8_BAR; PG8_WAIT_L(0); PG8_MMA(1, 0, At, B0); PG8_BAR; PG8_SCHED;
            PG8_STAGE(PG8_SB(0, 1), b2 + hstep, voffB);
            PG8_WAIT_V(6); PG8_BAR; PG8_MMA(1, 1, At, B1); PG8_BAR;
            PG8_LDB(B0, 1, 0); PG8_SCHED; PG8_LDA(At, 1, 0); PG8_STAGE(PG8_SA(0, 1), a2 + hstep, voffA);
            PG8_WAIT_L(8); PG8_BAR; PG8_WAIT_L(0); PG8_MMA(0, 0, At, B0); PG8_BAR; PG8_SCHED;
            PG8_LDB(B1, 1, 1); PG8_STAGE(PG8_SB(1, 0), b3, voffB);
            PG8_BAR; PG8_WAIT_L(0); PG8_MMA(0, 1, At, B1); PG8_BAR;
            PG8_LDA(At, 1, 1); PG8_STAGE(PG8_SA(1, 0), a3, voffA);
            PG8_BAR; PG8_WAIT_L(0); PG8_MMA(1, 0, At, B0); PG8_BAR; PG8_SCHED;
            PG8_STAGE(PG8_SB(1, 1), b3 + hstep, voffB);
            PG8_WAIT_V(6); PG8_BAR; PG8_MMA(1, 1, At, B1); PG8_BAR;
            }
        }
        if constexpr (ALIGN_EPI) { if (wr == 0) PG8_BAR; }
        if constexpr (!Epi::AFTER_DRAIN) { E(acc, cur, wr, wc, fr, fq); S.done(cur); }
        if (!has_next) break;
#pragma unroll
        for (int a = 0; a < 2; ++a)
#pragma unroll
            for (int b = 0; b < 2; ++b)
#pragma unroll
                for (int m = 0; m < 4; ++m)
#pragma unroll
                    for (int n = 0; n < 2; ++n) acc[a][b][m][n] = (f32x4){0.f, 0.f, 0.f, 0.f};
        cur = nxt; cA = nA; cB = nB; ++ui;
        if constexpr (ALIGN_EPI) { if (wr == 1) PG8_BAR; }
    }
    PG8_WAIT_V(0);
    if constexpr (!ALIGN_EPI) { if (wr == 0) PG8_BAR; }
    PG8_BAR;
    if constexpr (Epi::AFTER_DRAIN) { E.fused(acc, cur, wr, wc, fr, fq, lds, wid, lane); S.done(cur); }
#undef PG8_SA
#undef PG8_SB
#undef PG8_STAGE
#undef PG8_LDA
#undef PG8_LDB
#undef PG8_MMA
#undef PG8_WAIT_V
#undef PG8_WAIT_L
#undef PG8_BAR
#undef PG8_SCHED
}
}

namespace pg8 {
struct EpiResid {
    static constexpr bool PERM = false, AFTER_DRAIN = false;
    const float* base; float* out; int ldc; float alpha;
    __device__ __forceinline__ void operator()(const f32x4 (&acc)[2][2][4][2], const Unit& u, int wr, int wc, int fr, int fq) const {
        const int col0 = u.pn * BM + wc * 32 + 4 * fq;
#pragma unroll
        for (int ai = 0; ai < 2; ++ai)
#pragma unroll
            for (int m = 0; m < 4; ++m) { const int r = ai * HALF + wr * 64 + m * 16 + fr; const size_t off = (size_t)(u.pm * BM + r) * ldc + col0;
#pragma unroll
                for (int bj = 0; bj < 2; ++bj)
#pragma unroll
                    for (int n = 0; n < 2; ++n) { const f32x4 bs = *(const f32x4*)(base + off + bj * HALF + n * 16);
                        const f32x4 o = bs * alpha + acc[ai][bj][m][n]; *(f32x4*)(out + off + bj * HALF + n * 16) = o; }
                if (m & 1) asm volatile("" ::: "memory"); }
    }
};

struct EpiResLn {
    static constexpr bool PERM = false, AFTER_DRAIN = true;
    const float* base; float* out; bf16_t* xn; bf16_t* xl; const float* lg; const float* lb; unsigned long long* xbuf; unsigned* cnt; float alpha, eps;
    __device__ __forceinline__ void fused(f32x4 (&acc)[2][2][4][2], const Unit& u, int wr, int wc, int fr, int fq, PG8_LAS unsigned char* lds, int wid, int lane) const {
        typedef float f32x2v __attribute__((ext_vector_type(2))); typedef unsigned u32x2v __attribute__((ext_vector_type(2)));
        PG8_LAS f32x2v* P = (PG8_LAS f32x2v*)lds;
        PG8_LAS f32x2v* S = (PG8_LAS f32x2v*)(lds + 8192);
        const int col0 = u.pn * BM + wc * 32 + 4 * fq;
        const int tid_ = wid * 64 + lane; bf16_t* xl_t = xl + (size_t)(u.pm * 8 + u.pn) * 65536;
#pragma unroll
        for (int ai = 0; ai < 2; ++ai)
#pragma unroll
            for (int m = 0; m < 4; ++m) { const size_t off = (size_t)(u.pm * BM + ai * HALF + wr * 64 + m * 16 + fr) * 2048 + col0;
#pragma unroll
                for (int bj = 0; bj < 2; ++bj) { u32x4 lo16 = (u32x4){0u, 0u, 0u, 0u};
                    if (!base) lo16 = __builtin_nontemporal_load((const u32x4*)(xl_t + ((size_t)(((ai * 4 + m) * 2 + bj) * 512 + tid_) * 8)));
#pragma unroll
                    for (int n = 0; n < 2; ++n) { f32x4 bs;
                        if (base) bs = __builtin_nontemporal_load((const f32x4*)(base + off + bj * HALF + n * 16));
                        else { const u32x2v h = __builtin_nontemporal_load((const u32x2v*)(xn + off + bj * HALF + n * 16)); const unsigned qx = n ? lo16.z : lo16.x, qy = n ? lo16.w : lo16.y;
                            bs[0] = __uint_as_float(h.x << 16) + __uint_as_float(qx << 16); bs[1] = __uint_as_float(h.x & 0xffff0000u) + __uint_as_float(qx & 0xffff0000u);
                            bs[2] = __uint_as_float(h.y << 16) + __uint_as_float(qy << 16); bs[3] = __uint_as_float(h.y & 0xffff0000u) + __uint_as_float(qy & 0xffff0000u); }
                        acc[ai][bj][m][n] = bs * alpha + acc[ai][bj][m][n]; } }
                asm volatile("" : "+v"(acc[ai][0][m][0]), "+v"(acc[ai][0][m][1]), "+v"(acc[ai][1][m][0]), "+v"(acc[ai][1][m][1]));
                if (m == 3) asm volatile("" ::: "memory"); }
#pragma unroll
        for (int ai = 0; ai < 2; ++ai)
#pragma unroll
            for (int m = 0; m < 4; ++m) {
                float s = 0.f;
#pragma unroll
                for (int bj = 0; bj < 2; ++bj)
#pragma unroll
                    for (int n = 0; n < 2; ++n) { const f32x4 x = acc[ai][bj][m][n]; s += (x[0] + x[1]) + (x[2] + x[3]); }
                s += __shfl_xor(s, 16); s += __shfl_xor(s, 32);
                const float mw = s * (1.0f / 64.0f); float q = 0.f;
#pragma unroll
                for (int bj = 0; bj < 2; ++bj)
#pragma unroll
                    for (int n = 0; n < 2; ++n) { const f32x4 d = acc[ai][bj][m][n] - mw; q += (d[0] * d[0] + d[1] * d[1]) + (d[2] * d[2] + d[3] * d[3]); }
                q += __shfl_xor(q, 16); q += __shfl_xor(q, 32);
                if (fq == 0) P[(ai * HALF + wr * 64 + m * 16 + fr) * 4 + wc] = (f32x2v){mw, q};
            }
        asm volatile("s_waitcnt lgkmcnt(0)" ::: "memory"); __builtin_amdgcn_s_barrier(); asm volatile("" ::: "memory");
        const int row = wid * 32 + (lane & 31);
        if (lane < 32) {
            const f32x2v a = P[row * 4 + 0], b = P[row * 4 + 1], c = P[row * 4 + 2], d = P[row * 4 + 3];
            const float mt = (a.x + b.x + c.x + d.x) * 0.25f;
            const float da = a.x - mt, db = b.x - mt, dc = c.x - mt, dd = d.x - mt;
            const float m2 = (a.y + b.y) + (c.y + d.y) + 64.0f * ((da * da + db * db) + (dc * dc + dd * dd));
            unsigned long long* slot = xbuf + ((size_t)(u.pm * BM + row) * 8 + u.pn);
            __hip_atomic_store(slot, ((unsigned long long)__float_as_uint(m2) << 32) | __float_as_uint(mt), __ATOMIC_RELAXED, __HIP_MEMORY_SCOPE_AGENT);
        }
        asm volatile("s_waitcnt vmcnt(0)" ::: "memory");
        if (lane == 0) __hip_atomic_fetch_add(cnt + 64 * u.pm, 1u, __ATOMIC_RELAXED, __HIP_MEMORY_SCOPE_AGENT);
        if (wid == 0) {
            unsigned sp = 0;
            while ((unsigned)__builtin_amdgcn_readfirstlane(__hip_atomic_load(cnt + 64 * u.pm, __ATOMIC_RELAXED, __HIP_MEMORY_SCOPE_AGENT)) < 64u) { __builtin_amdgcn_s_sleep(2); if (++sp > (1u << 22)) break; }
        }
        asm volatile("s_waitcnt vmcnt(0) lgkmcnt(0)" ::: "memory"); __builtin_amdgcn_s_barrier(); asm volatile("" ::: "memory");
        if (lane < 32) {
            const unsigned long long* slot = xbuf + (size_t)(u.pm * BM + row) * 8; float mt[8], m2[8]; float ms = 0.f;
#pragma unroll
            for (int t = 0; t < 8; ++t) { const unsigned long long w = __hip_atomic_load(slot + t, __ATOMIC_RELAXED, __HIP_MEMORY_SCOPE_AGENT); mt[t] = __uint_as_float((unsigned)w); m2[t] = __uint_as_float((unsigned)(w >> 32)); ms += mt[t]; }
            const float mean = ms * 0.125f; float q = 0.f;
#pragma unroll
            for (int t = 0; t < 8; ++t) { const float dm = mt[t] - mean; q += m2[t] + 256.0f * dm * dm; }
            S[row] = (f32x2v){mean, 1.0f / sqrtf(q * (1.0f / 2048.0f) + eps)};
        }
        asm volatile("s_waitcnt lgkmcnt(0)" ::: "memory"); __builtin_amdgcn_s_barrier(); asm volatile("" ::: "memory");
#pragma unroll
        for (int bj = 0; bj < 2; ++bj) { f32x4 gg[2], bb[2];
#pragma unroll
            for (int n = 0; n < 2; ++n) { gg[n] = *(const f32x4*)(lg + col0 + bj * HALF + n * 16); bb[n] = *(const f32x4*)(lb + col0 + bj * HALF + n * 16); }
#pragma unroll
            for (int ai = 0; ai < 2; ++ai)
#pragma unroll
                for (int m = 0; m < 4; ++m) { const int r = ai * HALF + wr * 64 + m * 16 + fr; const f32x2v sr = S[r]; u32x4 lo16;
#pragma unroll
                    for (int n = 0; n < 2; ++n) { const size_t off = (size_t)(u.pm * BM + r) * 2048 + col0 + bj * HALF + n * 16;
                        const f32x4 y = (acc[ai][bj][m][n] - sr.x) * sr.y * gg[n] + bb[n];
                        if (out) *(f32x4*)(out + off) = y;
                        else { u32x2v w; w.x = cvt_pk_bf16(y[0], y[1]); w.y = cvt_pk_bf16(y[2], y[3]); *(u32x2v*)(xn + off) = w;
                            const unsigned q0 = cvt_pk_bf16(y[0] - __uint_as_float(w.x << 16), y[1] - __uint_as_float(w.x & 0xffff0000u)), q1 = cvt_pk_bf16(y[2] - __uint_as_float(w.y << 16), y[3] - __uint_as_float(w.y & 0xffff0000u));
                            if (n == 0) { lo16.x = q0; lo16.y = q1; } else { lo16.z = q0; lo16.w = q1; } } }
                    if (!out) *(u32x4*)(xl_t + ((size_t)(((ai * 4 + m) * 2 + bj) * 512 + tid_) * 8)) = lo16; } }
    }
};
}

#define LAS __attribute__((address_space(3)))
#define GAS __attribute__((address_space(1)))
typedef unsigned short bf16_t;
typedef short bf16x8 __attribute__((ext_vector_type(8)));
typedef short bf16x4 __attribute__((ext_vector_type(4)));
typedef float f32x4 __attribute__((ext_vector_type(4)));
typedef unsigned u32x4 __attribute__((ext_vector_type(4)));
typedef unsigned u32x2 __attribute__((ext_vector_type(2)));

constexpr int SEQ = 8192, DM = 2048, DEPTH = 4, INW = 6672, NMEM = 256;
constexpr int NMAIN = 5376, NVT = 1536, NWT = NMAIN + NVT;
constexpr int C_AQ = 0, C_AK = 1024, C_AZ = 2048, C_BQ = 3072, C_BK = 3328, C_BZ = 3584, C_MQ = 4096, C_MZ = 4608, C_LR = 5120;
constexpr int NCH = SEQ / 64;
constexpr float LN_EPS = 1e-5f, RMS_EPS = 1e-6f;
constexpr float LOG2E = 1.4426950408889634f;
constexpr float ATT_SC = 0.08838834764831845f * LOG2E;
constexpr int LDS_BYTES = 147456;

constexpr size_t MiB = 1u << 20;
constexpr size_t WS_WIN = 0, WIN_L = (size_t)NWT * DM * 2;
constexpr size_t WS_WOUT = 112 * MiB, WOUT_L = (size_t)DM * DM * 2;
constexpr size_t WS_WMK = 144 * MiB, WS_WMV = 152 * MiB;
constexpr size_t WS_MEMB = 160 * MiB, WS_MK = 161 * MiB, WS_MVT = 162 * MiB;
constexpr size_t WS_XB = 164 * MiB, WS_XF = 196 * MiB, WS_HM = 260 * MiB, WS_Y = 368 * MiB;
constexpr int LDV = SEQ + 64;
constexpr size_t WS_U = 400 * MiB, WS_SP = 416 * MiB, WS_DCY = 424 * MiB, WS_CTL = 426 * MiB, CTL_BYTES = 65536, WS_XCH = 427 * MiB, WS_VT = 428 * MiB, WS_BG = 454 * MiB, WS_XL = 462 * MiB, WS_END = 494 * MiB;
constexpr int CW_CNT = 4096;
static_assert(WS_WIN + 4 * WIN_L <= WS_WOUT, "ws map");
static_assert(WS_HM + (size_t)SEQ * NMAIN * 2 <= WS_Y, "ws map");

struct Params {
    const float *x, *mem, *w_in, *rel, *gate_w, *gate_b, *norm_g, *w_mkv, *w_out, *ln_g, *ln_b;
    float* out; unsigned char* ws; int ph_lo, ph_hi;
};

typedef float f32x2_t __attribute__((ext_vector_type(2))); typedef __bf16 bf16x2_t __attribute__((ext_vector_type(2)));
__device__ __forceinline__ unsigned pk2(float lo, float hi) { const f32x2_t v = {lo, hi}; const bf16x2_t b = __builtin_convertvector(v, bf16x2_t); return __builtin_bit_cast(unsigned, b); }
__device__ __forceinline__ float bflo(unsigned w) { return __uint_as_float(w << 16); }
__device__ __forceinline__ float bfhi(unsigned w) { return __uint_as_float(w & 0xffff0000u); }
__device__ __forceinline__ float silu_f(float z) { return z / (1.0f + __expf(-z)); }
#define MFMA16(a, b, c) __builtin_amdgcn_mfma_f32_16x16x32_bf16((a), (b), (c), 0, 0, 0)

struct ConvItem { const GAS float* src; GAS bf16_t* dst; int ldw; bool ok; };
__device__ __forceinline__ void conv_load(const ConvItem& d, f32x4 (&v)[8]) {
#pragma unroll
    for (int i = 0; i < 8; ++i) v[i] = d.ok ? __builtin_nontemporal_load((const GAS f32x4*)(d.src + (size_t)(8 * i) * d.ldw)) : (f32x4){0.f, 0.f, 0.f, 0.f};
}
__device__ __forceinline__ void conv_store(const ConvItem& d, const f32x4 (&v)[8], LAS float* scr, int lane) {
    const int n4 = 4 * (lane & 7), kr = lane >> 3;
#pragma unroll
    for (int i = 0; i < 8; ++i) { LAS float* q = scr + (8 * i + kr) * 33 + n4; q[0] = v[i].x; q[1] = v[i].y; q[2] = v[i].z; q[3] = v[i].w; }
    asm volatile("s_waitcnt lgkmcnt(0)" ::: "memory");
    const int c = lane & 7;
#pragma unroll
    for (int j = 0; j < 4; ++j) { const int n = (lane >> 3) + 8 * j; const LAS float* s = scr + (8 * c) * 33 + n;
        u32x4 o; o.x = pk2(s[0 * 33], s[1 * 33]); o.y = pk2(s[2 * 33], s[3 * 33]); o.z = pk2(s[4 * 33], s[5 * 33]); o.w = pk2(s[6 * 33], s[7 * 33]);
        *(GAS u32x4*)(d.dst + (size_t)n * DM + 8 * c) = o; }
    asm volatile("s_waitcnt lgkmcnt(0)" ::: "memory");
}
__device__ __forceinline__ void in_seg(int drow, int& src_col, int& nvalid) {
    nvalid = 32;
    if (drow < 2048) src_col = drow;
    else if (drow < 3072) src_col = 3072 + (drow - 2048);
    else if (drow < 3328) src_col = 4096 + (drow - 3072);
    else if (drow < 3584) src_col = 4352 + (drow - 3328);
    else if (drow < 4096) src_col = 5120 + (drow - 3584);
    else if (drow < 4608) src_col = 5648 + (drow - 4096);
    else if (drow < 5120) src_col = 6160 + (drow - 4608);
    else if (drow < 5376) { src_col = 5632; nvalid = (drow == 5120) ? 16 : 0; }
    else if (drow < 6400) src_col = 2048 + (drow - 5376);
    else src_col = 4608 + (drow - 6400);
}
__device__ __forceinline__ ConvItem conv_decode(const Params& p, int l, int it, int lane) {
    constexpr int I_IN = 32 * (NWT / 32), I_OUT = 32 * (DM / 32);
    const int n4 = 4 * (lane & 7), kr = lane >> 3;
    ConvItem d; int r = it;
    if (r < I_IN) { const int g_ = r >> 5, nb = 8 * (g_ % 27) + (r & 7), k0 = 64 * (4 * (g_ / 27) + ((r >> 3) & 3)); int sc, nv; in_seg(32 * nb, sc, nv);
        d.ldw = INW; d.ok = n4 < nv; d.src = (const GAS float*)p.w_in + (size_t)l * DM * INW + (size_t)(k0 + kr) * INW + sc + n4;
        d.dst = (GAS bf16_t*)(p.ws + WS_WIN + l * WIN_L) + (size_t)(32 * nb) * DM + k0; return d; }
    r -= I_IN;
    if (r < I_OUT) { const int g_ = r >> 5, nb = 8 * (g_ % 8) + (r & 7), k0 = 64 * (4 * (g_ / 8) + ((r >> 3) & 3));
        d.ldw = DM; d.ok = true; d.src = (const GAS float*)p.w_out + (size_t)l * DM * DM + (size_t)(k0 + kr) * DM + 32 * nb + n4;
        d.dst = (GAS bf16_t*)(p.ws + WS_WOUT + l * WOUT_L) + (size_t)(32 * nb) * DM + k0; return d; }
    r -= I_OUT;
    { const int g_ = r >> 5, nb = 8 * (g_ % 4) + (r & 7), k0 = 64 * (4 * (g_ / 4) + ((r >> 3) & 3));
        d.ldw = 1024; d.ok = true; d.src = (const GAS float*)p.w_mkv + (size_t)l * DM * 1024 + (size_t)(k0 + kr) * 1024 + 32 * nb + n4;
        d.dst = (GAS bf16_t*)(p.ws + (nb < 16 ? WS_WMK : WS_WMV)) + (size_t)(l * 512 + 32 * (nb & 15)) * DM + k0; return d; }
}
__device__ __forceinline__ void convert_layer(const Params& p, int l, LAS unsigned char* lds, int wk, int nwk) {
    int tid_ = threadIdx.x; asm volatile("" : "+v"(tid_)); const int tid = tid_, lane = tid & 63, wave = tid >> 6;
    LAS float* scr = (LAS float*)(lds + wave * 8704);
    constexpr int I_L = 32 * (NWT / 32) + 32 * (DM / 32) + 32 * 32;
    if (wk >= I_L) return;
    ConvItem cur = conv_decode(p, l, wk, lane); f32x4 v[8]; conv_load(cur, v);
    for (int it = wk; it < I_L; it += nwk) {
        const int nx = it + nwk; ConvItem nxt = cur; f32x4 v2[8];
        if (nx < I_L) { nxt = conv_decode(p, l, nx, lane); conv_load(nxt, v2); }
        conv_store(cur, v, scr, lane);
        if (nx < I_L) { cur = nxt;
#pragma unroll
            for (int i = 0; i < 8; ++i) v[i] = v2[i]; }
    }
}
__device__ __forceinline__ void phase0(const Params& p, LAS unsigned char* lds) {
    int tid_ = threadIdx.x; asm volatile("" : "+v"(tid_)); const int tid = tid_, wave = tid >> 6;
    convert_layer(p, 0, lds, blockIdx.x * 8 + wave, gridDim.x * 8);
    const size_t gt = (size_t)blockIdx.x * 512 + tid, NT = (size_t)gridDim.x * 512;
    GAS bf16_t* xb = (GAS bf16_t*)(p.ws + WS_XB); const GAS f32x4* xs = (const GAS f32x4*)p.x;
    for (size_t i = gt; i < (size_t)SEQ * DM / 8; i += NT) { const f32x4 a = __builtin_nontemporal_load(xs + 2 * i), b = __builtin_nontemporal_load(xs + 2 * i + 1);
        u32x4 o; o.x = pk2(a.x, a.y); o.y = pk2(a.z, a.w); o.z = pk2(b.x, b.y); o.w = pk2(b.z, b.w); ((GAS u32x4*)xb)[i] = o; }
    GAS bf16_t* mb = (GAS bf16_t*)(p.ws + WS_MEMB); const GAS f32x4* ms = (const GAS f32x4*)p.mem;
    for (size_t i = gt; i < (size_t)NMEM * DM / 8; i += NT) { const f32x4 a = __builtin_nontemporal_load(ms + 2 * i), b = __builtin_nontemporal_load(ms + 2 * i + 1);
        u32x4 o; o.x = pk2(a.x, a.y); o.y = pk2(a.z, a.w); o.z = pk2(b.x, b.y); o.w = pk2(b.z, b.w); ((GAS u32x4*)mb)[i] = o; }
}

constexpr int A_KS = 0, A_KSZ = 64 * 272, A_VS = 2 * A_KSZ, A_VSZ = 128 * 144, A_BT = A_VS + 2 * A_VSZ;
template <bool BAND>
__device__ __forceinline__ void attn_step(LAS unsigned char* lds, int buf, int t, int cw, int w, int r16, int g, const bf16x8 (&qf)[4], f32x4 (&o)[8], float& m, float& l) {
    const LAS float* btab = (const LAS float*)(lds + A_BT);
    const LAS unsigned char* kb_ = lds + A_KS + buf * A_KSZ + r16 * 272 + g * 16;
    f32x4 s[4];
#pragma unroll
    for (int kb = 0; kb < 4; ++kb) { s[kb] = (f32x4){0.f, 0.f, 0.f, 0.f}; bf16x8 kfr[4];
#pragma unroll
        for (int ks = 0; ks < 4; ++ks) kfr[ks] = *(const LAS bf16x8*)(kb_ + kb * 16 * 272 + ks * 64);
#pragma unroll
        for (int ks = 0; ks < 4; ++ks) s[kb] = MFMA16(kfr[ks], qf[ks], s[kb]); }
    if (BAND) {
        const int delta = cw + 8 - t;
        if (delta >= 3) { const float bc = btab[256];
#pragma unroll
            for (int kb = 0; kb < 4; ++kb) s[kb] = s[kb] * ATT_SC + bc;
        } else { const int qi = 16 * (w & 3) + r16;
#pragma unroll
            for (int kb = 0; kb < 4; ++kb)
#pragma unroll
                for (int r = 0; r < 4; ++r) { int dist = 64 * delta + qi - (16 * kb + 4 * g + r); dist = dist > 128 ? 128 : (dist < -128 ? -128 : dist);
                    s[kb][r] = s[kb][r] * ATT_SC + btab[dist + 128]; }
        }
    } else {
#pragma unroll
        for (int kb = 0; kb < 4; ++kb) s[kb] = s[kb] * ATT_SC;
    }
    float mt = fmaxf(fmaxf(s[0][0], s[0][1]), fmaxf(s[0][2], s[0][3]));
#pragma unroll
    for (int kb = 1; kb < 4; ++kb) mt = fmaxf(mt, fmaxf(fmaxf(s[kb][0], s[kb][1]), fmaxf(s[kb][2], s[kb][3])));
    mt = fmaxf(mt, __shfl_xor(mt, 16)); mt = fmaxf(mt, __shfl_xor(mt, 32));
    const float mn = fmaxf(m, mt), alpha = __builtin_amdgcn_exp2f(m - mn); m = mn;
    float rs = 0.f;
#pragma unroll
    for (int kb = 0; kb < 4; ++kb)
#pragma unroll
        for (int r = 0; r < 4; ++r) { const float pv = __builtin_amdgcn_exp2f(s[kb][r] - mn); s[kb][r] = pv; rs += pv; }
    l = l * alpha + rs;
    if (__any(alpha != 1.0f)) {
#pragma unroll
        for (int i = 0; i < 8; ++i) o[i] = o[i] * alpha; }
    bf16x8 pb[2];
#pragma unroll
    for (int s2 = 0; s2 < 2; ++s2) { u32x4 pw; pw.x = pk2(s[2 * s2][0], s[2 * s2][1]); pw.y = pk2(s[2 * s2][2], s[2 * s2][3]);
        pw.z = pk2(s[2 * s2 + 1][0], s[2 * s2 + 1][1]); pw.w = pk2(s[2 * s2 + 1][2], s[2 * s2 + 1][3]); pb[s2] = __builtin_bit_cast(bf16x8, pw); }
    int voff_ = 0; asm volatile("" : "+v"(voff_), "+v"(pb[1]));
    const LAS unsigned char* vb_ = lds + A_VS + buf * A_VSZ + r16 * 144 + g * 8 + voff_;
    u32x2 vfr[2][4];
#pragma unroll
    for (int q = 0; q < 4; ++q) vfr[0][q] = *(const LAS u32x2*)(vb_ + (q >> 1) * 64 + (q & 1) * 32);
#pragma unroll
    for (int dvb = 0; dvb < 8; ++dvb) {
        if (dvb < 7) {
#pragma unroll
            for (int q = 0; q < 4; ++q) vfr[(dvb + 1) & 1][q] = *(const LAS u32x2*)(vb_ + (dvb + 1) * 16 * 144 + (q >> 1) * 64 + (q & 1) * 32); }
#pragma unroll
        for (int s2 = 0; s2 < 2; ++s2) { const u32x2 lo = vfr[dvb & 1][2 * s2], hi = vfr[dvb & 1][2 * s2 + 1];
            const u32x4 av = (u32x4){lo.x, lo.y, hi.x, hi.y}; o[dvb] = MFMA16(__builtin_bit_cast(bf16x8, av), pb[s2], o[dvb]); } }
}
template <bool BAND>
__device__ __forceinline__ void attn_unit(LAS unsigned char* lds, int q_row0, const bf16_t* Qh, int ldq, const bf16_t* Kh, int ldk, const bf16_t* Vth, int ldvt,
                                          const bf16_t* Zh, int ldz, bf16_t* Yh, int ldy, const float* bias_tab, int j2) {
    int tid_ = threadIdx.x; asm volatile("" : "+v"(tid_)); const int tid = tid_, lane = tid & 63, w = __builtin_amdgcn_readfirstlane(tid >> 6), r16 = lane & 15, g = lane >> 4;
    LAS float* btab = (LAS float*)(lds + A_BT);
    if (BAND) { for (int i = tid; i < 257; i += 512) btab[i] = ((const GAS float*)bias_tab)[i] * LOG2E; }
    const GAS bf16_t* qp = (const GAS bf16_t*)Qh + (size_t)(q_row0 + 16 * w + r16) * ldq + 8 * g;
    bf16x8 qf[4];
#pragma unroll
    for (int ks = 0; ks < 4; ++ks) qf[ks] = __builtin_nontemporal_load((const GAS bf16x8*)(qp + 32 * ks));
    f32x4 o[8];
#pragma unroll
    for (int i = 0; i < 8; ++i) o[i] = (f32x4){0.f, 0.f, 0.f, 0.f};
    float m = -1e30f, l = 0.f;
    const int cw = BAND ? (w >> 2) : 0;
    const int nt = BAND ? 10 : 4;
    int t0 = 0; if (BAND) { t0 = 8 - 2 * j2; if (t0 < 0) t0 = 0; }
    u32x4 kA[2], vA[2], kB[2], vB[2];
#define A_GLOAD(kr, vr, t) do { const int key0_ = BAND ? 64 * (2 * j2 - 8 + (t)) : 64 * (t); \
        _Pragma("unroll") for (int i_ = 0; i_ < 2; ++i_) { const int id_ = tid + 512 * i_; \
            kr[i_] = *(const GAS u32x4*)((const GAS bf16_t*)Kh + (size_t)(key0_ + (id_ >> 4)) * ldk + (id_ & 15) * 8); \
            vr[i_] = *(const GAS u32x4*)((const GAS bf16_t*)Vth + (size_t)(id_ >> 3) * ldvt + key0_ + (id_ & 7) * 8); } } while (0)
#define A_LSTORE(kr, vr, buf) do { _Pragma("unroll") for (int i_ = 0; i_ < 2; ++i_) { const int id_ = tid + 512 * i_; \
            *(LAS u32x4*)(lds + A_KS + (buf) * A_KSZ + (id_ >> 4) * 272 + (id_ & 15) * 16) = kr[i_]; \
            *(LAS u32x4*)(lds + A_VS + (buf) * A_VSZ + (id_ >> 3) * 144 + (id_ & 7) * 16) = vr[i_]; } } while (0)
    A_GLOAD(kA, vA, t0); A_GLOAD(kB, vB, t0 + 1); A_LSTORE(kA, vA, 0); __syncthreads();
    for (int t = t0; t < nt; t += 2) {
        if (t + 2 < nt) A_GLOAD(kA, vA, t + 2);
        if (!BAND || (t >= cw && t <= cw + 8)) attn_step<BAND>(lds, 0, t, cw, w, r16, g, qf, o, m, l);
        A_LSTORE(kB, vB, 1);
        __syncthreads();
        if (t + 3 < nt) A_GLOAD(kB, vB, t + 3);
        if (!BAND || (t + 1 >= cw && t + 1 <= cw + 8)) attn_step<BAND>(lds, 1, t + 1, cw, w, r16, g, qf, o, m, l);
        if (t + 2 < nt) A_LSTORE(kA, vA, 0);
        __syncthreads();
    }
#undef A_GLOAD
#undef A_LSTORE
    l += __shfl_xor(l, 16); l += __shfl_xor(l, 32);
    const float inv = 1.0f / l;
    const size_t row = (size_t)(q_row0 + 16 * w + r16);
#pragma unroll
    for (int dvb = 0; dvb < 8; ++dvb) { const int col = 16 * dvb + 4 * g; const u32x2 z = __builtin_nontemporal_load((const GAS u32x2*)((const GAS bf16_t*)Zh + row * ldz + col));
        const float y0 = o[dvb][0] * inv * silu_f(bflo(z.x)), y1 = o[dvb][1] * inv * silu_f(bfhi(z.x)), y2 = o[dvb][2] * inv * silu_f(bflo(z.y)), y3 = o[dvb][3] * inv * silu_f(bfhi(z.y));
        u32x2 yo; yo.x = pk2(y0, y1); yo.y = pk2(y2, y3); *(GAS u32x2*)((GAS bf16_t*)Yh + row * ldy + col) = yo; }
}


constexpr int P_HALF = 2 * A_KSZ + 2 * A_VSZ, P_BT = 2 * P_HALF;
static_assert(P_BT + 2 * 1028 <= LDS_BYTES - 64, "pair attention LDS map");
__device__ __forceinline__ void band_pair_step(LAS unsigned char* hl, const LAS float* btab, int buf, int t, int cw, int w4, int r16, int g,
                                               const bf16x8 (&qf)[2][4], f32x4 (&o)[2][8], float (&m)[2], f32x4 (&l)[2]) {
    const LAS unsigned char* kb_ = hl + buf * A_KSZ + r16 * 272 + g * 16;
    f32x4 s[2][4];
#pragma unroll
    for (int kb = 0; kb < 4; ++kb) { bf16x8 kfr[4];
#pragma unroll
        for (int ks = 0; ks < 4; ++ks) kfr[ks] = *(const LAS bf16x8*)(kb_ + kb * 16 * 272 + ks * 64);
#pragma unroll
        for (int rb = 0; rb < 2; ++rb) { s[rb][kb] = (f32x4){0.f, 0.f, 0.f, 0.f};
#pragma unroll
            for (int ks = 0; ks < 4; ++ks) s[rb][kb] = MFMA16(kfr[ks], qf[rb][ks], s[rb][kb]); } }
    const int delta = cw + 8 - t;
    bf16x8 pb[2][2];
    const bf16x8 ones = (bf16x8){16256, 16256, 16256, 16256, 16256, 16256, 16256, 16256};
#pragma unroll
    for (int rb = 0; rb < 2; ++rb) {
        float mn, alpha;
        if (delta >= 3) {
            const float bc = btab[256];
            float mt = fmaxf(fmaxf(s[rb][0][0], s[rb][0][1]), fmaxf(s[rb][0][2], s[rb][0][3]));
#pragma unroll
            for (int kb = 1; kb < 4; ++kb) mt = fmaxf(mt, fmaxf(fmaxf(s[rb][kb][0], s[rb][kb][1]), fmaxf(s[rb][kb][2], s[rb][kb][3])));
            mt = fmaxf(mt, __shfl_xor(mt, 16)); mt = fmaxf(mt, __shfl_xor(mt, 32));
            mn = fmaxf(m[rb], mt * ATT_SC + bc); alpha = __builtin_amdgcn_exp2f(m[rb] - mn); m[rb] = mn;
            const float off = bc - mn;
#pragma unroll
            for (int kb = 0; kb < 4; ++kb)
#pragma unroll
                for (int r = 0; r < 4; ++r) s[rb][kb][r] = __builtin_amdgcn_exp2f(s[rb][kb][r] * ATT_SC + off);
        } else { const int qi = 32 * (w4 & 1) + 16 * rb + r16;
#pragma unroll
            for (int kb = 0; kb < 4; ++kb)
#pragma unroll
                for (int r = 0; r < 4; ++r) { int dist = 64 * delta + qi - (16 * kb + 4 * g + r); dist = dist > 128 ? 128 : (dist < -128 ? -128 : dist);
                    s[rb][kb][r] = s[rb][kb][r] * ATT_SC + btab[dist + 128]; }
            float mt = fmaxf(fmaxf(s[rb][0][0], s[rb][0][1]), fmaxf(s[rb][0][2], s[rb][0][3]));
#pragma unroll
            for (int kb = 1; kb < 4; ++kb) mt = fmaxf(mt, fmaxf(fmaxf(s[rb][kb][0], s[rb][kb][1]), fmaxf(s[rb][kb][2], s[rb][kb][3])));
            mt = fmaxf(mt, __shfl_xor(mt, 16)); mt = fmaxf(mt, __shfl_xor(mt, 32));
            mn = fmaxf(m[rb], mt); alpha = __builtin_amdgcn_exp2f(m[rb] - mn); m[rb] = mn;
#pragma unroll
            for (int kb = 0; kb < 4; ++kb)
#pragma unroll
                for (int r = 0; r < 4; ++r) s[rb][kb][r] = __builtin_amdgcn_exp2f(s[rb][kb][r] - mn);
        }
        if (__any(alpha != 1.0f)) { l[rb] = l[rb] * alpha;
#pragma unroll
            for (int i = 0; i < 8; ++i) o[rb][i] = o[rb][i] * alpha; }
#pragma unroll
        for (int s2 = 0; s2 < 2; ++s2) { u32x4 pw; pw.x = pk2(s[rb][2 * s2][0], s[rb][2 * s2][1]); pw.y = pk2(s[rb][2 * s2][2], s[rb][2 * s2][3]);
            pw.z = pk2(s[rb][2 * s2 + 1][0], s[rb][2 * s2 + 1][1]); pw.w = pk2(s[rb][2 * s2 + 1][2], s[rb][2 * s2 + 1][3]); pb[rb][s2] = __builtin_bit_cast(bf16x8, pw);
            l[rb] = MFMA16(ones, pb[rb][s2], l[rb]); }
    }
    int voff_ = 0; asm volatile("" : "+v"(voff_), "+v"(pb[1][1]));
    const LAS unsigned char* vb_ = hl + 2 * A_KSZ + buf * A_VSZ + r16 * 144 + g * 8 + voff_;
#pragma unroll
    for (int dvb = 0; dvb < 8; ++dvb) { u32x2 vfr[4];
#pragma unroll
        for (int q = 0; q < 4; ++q) vfr[q] = *(const LAS u32x2*)(vb_ + dvb * 16 * 144 + (q >> 1) * 64 + (q & 1) * 32);
#pragma unroll
        for (int s2 = 0; s2 < 2; ++s2) { const u32x4 av = (u32x4){vfr[2 * s2].x, vfr[2 * s2].y, vfr[2 * s2 + 1].x, vfr[2 * s2 + 1].y};
#pragma unroll
            for (int rb = 0; rb < 2; ++rb) o[rb][dvb] = MFMA16(__builtin_bit_cast(bf16x8, av), pb[rb][s2], o[rb][dvb]); } }
}
__device__ __forceinline__ void band_pair_unit(LAS unsigned char* lds, const Params& p, int l, int j2, int hA) {
    int tid_ = threadIdx.x; asm volatile("" : "+v"(tid_)); const int tid = tid_, lane = tid & 63, w = __builtin_amdgcn_readfirstlane(tid >> 6), r16 = lane & 15, g = lane >> 4;
    const int half = w >> 2, w4 = w & 3, th = tid & 255, head = hA + half;
    LAS unsigned char* hl = lds + half * P_HALF;
    LAS float* btab = (LAS float*)(lds + P_BT + half * 1028);
    { const GAS float* bt = (const GAS float*)p.rel + (l * 8 + head) * 257; for (int i = th; i < 257; i += 256) btab[i] = bt[i] * LOG2E; }
    const GAS bf16_t* hm = (const GAS bf16_t*)(p.ws + WS_HM);
    const GAS bf16_t* Kh = hm + C_AK + head * 128; const GAS bf16_t* Vth = (const GAS bf16_t*)(p.ws + WS_VT) + (size_t)(head * 128) * LDV;
    const int row0 = 128 * j2 + 32 * w4 + r16;
    bf16x8 qf[2][4];
#pragma unroll
    for (int rb = 0; rb < 2; ++rb)
#pragma unroll
        for (int ks = 0; ks < 4; ++ks) qf[rb][ks] = __builtin_nontemporal_load((const GAS bf16x8*)(hm + (size_t)(row0 + 16 * rb) * NMAIN + C_AQ + head * 128 + 32 * ks + 8 * g));
    f32x4 o[2][8];
#pragma unroll
    for (int rb = 0; rb < 2; ++rb)
#pragma unroll
        for (int i = 0; i < 8; ++i) o[rb][i] = (f32x4){0.f, 0.f, 0.f, 0.f};
    float m[2] = {-1e30f, -1e30f}; f32x4 l_[2] = {(f32x4){0.f, 0.f, 0.f, 0.f}, (f32x4){0.f, 0.f, 0.f, 0.f}};
    const int cw = w4 >> 1, nt = 10;
    int t0 = 8 - 2 * j2; if (t0 < 0) t0 = 0;
    u32x4 kr[4], vr[4];
#define P_GLOAD(t) do { const int key0_ = 64 * (2 * j2 - 8 + (t)); \
        _Pragma("unroll") for (int i_ = 0; i_ < 4; ++i_) { const int id_ = th + 256 * i_; \
            kr[i_] = *(const GAS u32x4*)(Kh + (size_t)(key0_ + (id_ >> 4)) * NMAIN + (id_ & 15) * 8); \
            vr[i_] = *(const GAS u32x4*)(Vth + (size_t)(id_ >> 3) * LDV + key0_ + (id_ & 7) * 8); } } while (0)
#define P_LSTORE(buf) do { _Pragma("unroll") for (int i_ = 0; i_ < 4; ++i_) { const int id_ = th + 256 * i_; \
            *(LAS u32x4*)(hl + (buf) * A_KSZ + (id_ >> 4) * 272 + (id_ & 15) * 16) = kr[i_]; \
            *(LAS u32x4*)(hl + 2 * A_KSZ + (buf) * A_VSZ + (id_ >> 3) * 144 + (id_ & 7) * 16) = vr[i_]; } } while (0)
    P_GLOAD(t0); P_LSTORE(0); __syncthreads();
    for (int t = t0; t < nt; ++t) {
        const int buf = (t - t0) & 1;
        if (t + 1 < nt) P_GLOAD(t + 1);
        if (t >= cw && t <= cw + 8) band_pair_step(hl, btab, buf, t, cw, w4, r16, g, qf, o, m, l_);
        if (t + 1 < nt) P_LSTORE(buf ^ 1);
        __syncthreads();
    }
#undef P_GLOAD
#undef P_LSTORE
    GAS bf16_t* Y = (GAS bf16_t*)(p.ws + WS_Y);
#pragma unroll
    for (int rb = 0; rb < 2; ++rb) { const float inv = 1.0f / l_[rb][0]; const size_t row = (size_t)(row0 + 16 * rb);
#pragma unroll
        for (int dvb = 0; dvb < 8; ++dvb) { const int col = 16 * dvb + 4 * g; const u32x2 z = __builtin_nontemporal_load((const GAS u32x2*)(hm + row * NMAIN + C_AZ + head * 128 + col));
            const float y0 = o[rb][dvb][0] * inv * silu_f(bflo(z.x)), y1 = o[rb][dvb][1] * inv * silu_f(bfhi(z.x)), y2 = o[rb][dvb][2] * inv * silu_f(bflo(z.y)), y3 = o[rb][dvb][3] * inv * silu_f(bfhi(z.y));
            u32x2 yo; yo.x = pk2(y0, y1); yo.y = pk2(y2, y3); *(GAS u32x2*)(Y + row * DM + head * 128 + col) = yo; } }
}

constexpr int G_LR = 0, G_GW = 4096, G_GB = 8192, G_SEG = 8448, G_B = 10496, G_SSQ = 27136, G_QP = 27648, G_QM = 36864, G_KP = 46080, G_KM = 55296,
              G_KD = 64512, G_AT = 73728, G_VT = 82944, G_ST = 101376;
__device__ __forceinline__ void gla_compute_b(LAS unsigned char* lds, const bf16_t* hm_rows, const float* gw_l, const float* gb_l, int hb) {
    int tid_ = threadIdx.x; asm volatile("" : "+v"(tid_)); const int tid = tid_;
    LAS float* LR = (LAS float*)(lds + G_LR); LAS float* GW = (LAS float*)(lds + G_GW); LAS float* GB = (LAS float*)(lds + G_GB);
    LAS float* SEG = (LAS float*)(lds + G_SEG); LAS float* Bm = (LAS float*)(lds + G_B);
    if (tid < 128) { const int row = tid >> 1, half = tid & 1; const u32x4 v = *(const GAS u32x4*)((const GAS bf16_t*)hm_rows + (size_t)row * NMAIN + C_LR + 8 * half);
        LAS float* d = LR + row * 16 + 8 * half; d[0] = bflo(v.x); d[1] = bfhi(v.x); d[2] = bflo(v.y); d[3] = bfhi(v.y); d[4] = bflo(v.z); d[5] = bfhi(v.z); d[6] = bflo(v.w); d[7] = bfhi(v.w); }
    for (int i = tid; i < 1024; i += 512) GW[i] = ((const GAS float*)gw_l)[(i >> 6) * 256 + hb * 64 + (i & 63)];
    if (tid < 64) GB[tid] = ((const GAS float*)gb_l)[hb * 64 + tid];
    __syncthreads();
    const int d = tid & 63, tseg = tid >> 6;
    float gwr[16];
#pragma unroll
    for (int r = 0; r < 16; ++r) gwr[r] = GW[r * 64 + d];
    const float gbv = GB[d];
    float loc[8]; float run = 0.f;
#pragma unroll
    for (int tt = 0; tt < 8; ++tt) { const int t = 8 * tseg + tt; float x = gbv;
#pragma unroll
        for (int r = 0; r < 16; ++r) x += LR[t * 16 + r] * gwr[r];
        const float lg = (fminf(x, 0.f) - __logf(1.0f + __expf(-fabsf(x)))) * 0.0625f;
        run += lg; loc[tt] = run; }
    SEG[tseg * 64 + d] = run;
    __syncthreads();
    float off = 0.f;
#pragma unroll
    for (int s = 0; s < 8; ++s) { const float v = SEG[s * 64 + d]; off += (s < tseg) ? v : 0.f; }
#pragma unroll
    for (int tt = 0; tt < 8; ++tt) Bm[(8 * tseg + tt) * 65 + d] = off + loc[tt];
    __syncthreads();
}
__device__ __forceinline__ void gla_load_vt(LAS unsigned char* lds, const bf16_t* VTg, int hb, int c) {
    int tid_ = threadIdx.x; asm volatile("" : "+v"(tid_)); const int tid = tid_;
#pragma unroll
    for (int i = 0; i < 2; ++i) { const int id = tid + 512 * i, row = id >> 3, c8 = id & 7;
        *(LAS u32x4*)(lds + G_VT + row * 144 + c8 * 16) = *(const GAS u32x4*)((const GAS bf16_t*)VTg + (size_t)(1024 + hb * 128 + row) * LDV + 64 * c + 8 * c8); }
}
__device__ __forceinline__ void gla_part1(LAS unsigned char* lds, const Params& p, int l, int c, int hb) {
    int tid_ = threadIdx.x; asm volatile("" : "+v"(tid_)); const int tid = tid_, lane = tid & 63, w = __builtin_amdgcn_readfirstlane(tid >> 6), r16 = lane & 15, g = lane >> 4;
    const bf16_t* hm_rows = (const bf16_t*)(p.ws + WS_HM) + (size_t)(64 * c) * NMAIN;
    gla_compute_b(lds, hm_rows, p.gate_w + l * 16 * 256, p.gate_b + l * 256, hb);
    const LAS float* Bm = (const LAS float*)(lds + G_B);
    { GAS float* BG = (GAS float*)(p.ws + WS_BG) + (size_t)(64 * c) * 256 + hb * 64;
        const int t = tid >> 3, dc = tid & 7; f32x4 b0, b1;
        b0.x = Bm[t * 65 + 8 * dc + 0]; b0.y = Bm[t * 65 + 8 * dc + 1]; b0.z = Bm[t * 65 + 8 * dc + 2]; b0.w = Bm[t * 65 + 8 * dc + 3];
        b1.x = Bm[t * 65 + 8 * dc + 4]; b1.y = Bm[t * 65 + 8 * dc + 5]; b1.z = Bm[t * 65 + 8 * dc + 6]; b1.w = Bm[t * 65 + 8 * dc + 7];
        *(GAS f32x4*)(BG + (size_t)t * 256 + 8 * dc) = b0; *(GAS f32x4*)(BG + (size_t)t * 256 + 8 * dc + 4) = b1; }
    { const int t = tid >> 3, dc = tid & 7; const u32x4 kv = *(const GAS u32x4*)((const GAS bf16_t*)hm_rows + (size_t)t * NMAIN + C_BK + hb * 64 + 8 * dc);
        float kf[8] = {bflo(kv.x), bfhi(kv.x), bflo(kv.y), bfhi(kv.y), bflo(kv.z), bfhi(kv.z), bflo(kv.w), bfhi(kv.w)};
        LAS bf16_t* KD = (LAS bf16_t*)(lds + G_KD);
#pragma unroll
        for (int e = 0; e < 8; ++e) { const int d = 8 * dc + e; const float val = kf[e] * __expf(Bm[63 * 65 + d] - Bm[t * 65 + d]); KD[d * 72 + t] = (bf16_t)(pk2(val, 0.f) & 0xffffu); } }
    gla_load_vt(lds, (const bf16_t*)(p.ws + WS_VT), hb, c);
    if (tid < 64) ((GAS float*)(p.ws + WS_DCY))[(c * 4 + hb) * 64 + tid] = __expf(Bm[63 * 65 + tid]);
    __syncthreads();
    GAS bf16_t* U = (GAS bf16_t*)(p.ws + WS_U) + (size_t)(c * 4 + hb) * 8192;
    const LAS unsigned char* Ap = lds + G_VT + (16 * w + r16) * 144 + g * 16;
#pragma unroll
    for (int dkb = 0; dkb < 4; ++dkb) { const LAS unsigned char* Bp = lds + G_KD + (16 * dkb + r16) * 144 + g * 16; f32x4 acc = (f32x4){0.f, 0.f, 0.f, 0.f};
#pragma unroll
        for (int ks = 0; ks < 2; ++ks) acc = MFMA16(*(const LAS bf16x8*)(Bp + ks * 64), *(const LAS bf16x8*)(Ap + ks * 64), acc);
        u32x2 ub; ub.x = pk2(acc[0], acc[1]); ub.y = pk2(acc[2], acc[3]); *(GAS u32x2*)(U + (16 * w + r16) * 64 + 16 * dkb + 4 * g) = ub; }
    __syncthreads();
}
__device__ __forceinline__ void gla_scan(const Params& p, LAS unsigned char* lds) {
    int tid_ = threadIdx.x; asm volatile("" : "+v"(tid_)); const int tid = tid_, seg = tid >> 7, el = tid & 127;
    LAS float* CE = (LAS float*)lds;
    for (int eg = blockIdx.x; eg < 256; eg += gridDim.x) {
        const int e = eg * 128 + el, hb = e >> 13, rem = e & 8191, dk = rem & 63;
        const GAS bf16_t* U = (const GAS bf16_t*)(p.ws + WS_U) + (size_t)hb * 8192 + rem + (size_t)(seg * 32) * 32768;
        const GAS float* dcy = (const GAS float*)(p.ws + WS_DCY) + hb * 64 + dk + (seg * 32) * 256;
        GAS bf16_t* Sp = (GAS bf16_t*)(p.ws + WS_SP) + (size_t)hb * 8192 + rem + (size_t)(seg * 32) * 32768;
        float uv[32], dv[32];
#pragma unroll
        for (int j = 0; j < 32; ++j) { uv[j] = __uint_as_float(((unsigned)__builtin_nontemporal_load(U + (size_t)j * 32768)) << 16); dv[j] = dcy[j * 256]; }
        float s = 0.f, pd = 1.f;
#pragma unroll
        for (int j = 0; j < 32; ++j) { const float u = uv[j], d = dv[j]; uv[j] = s; dv[j] = pd; s = d * s + u; pd *= d; }
        CE[seg * 128 + el] = s; CE[512 + seg * 128 + el] = pd;
        __syncthreads();
        float st = 0.f;
#pragma unroll
        for (int q = 0; q < 3; ++q) { const float se = CE[q * 128 + el], pe = CE[512 + q * 128 + el]; st = (q < seg) ? pe * st + se : st; }
#pragma unroll
        for (int j = 0; j < 32; ++j) Sp[(size_t)j * 32768] = (bf16_t)(pk2(uv[j] + dv[j] * st, 0.f) & 0xffffu);
        __syncthreads();
    }
}
struct Gla2Regs { u32x4 qv, kv; f32x4 b0, b1; u32x4 vt[2], st[2]; u32x2 zpre[4]; f32x4 gpre[4]; };
__device__ __forceinline__ void gla_part2_load(Gla2Regs& R, const Params& p, int l, int c, int hb, int tid, int w, int r16, int g) {
    const GAS bf16_t* hm_rows = (const GAS bf16_t*)(p.ws + WS_HM) + (size_t)(64 * c) * NMAIN;
    const int t = tid >> 3, dc = tid & 7;
    R.qv = __builtin_nontemporal_load((const GAS u32x4*)(hm_rows + (size_t)t * NMAIN + C_BQ + hb * 64 + 8 * dc)); R.kv = __builtin_nontemporal_load((const GAS u32x4*)(hm_rows + (size_t)t * NMAIN + C_BK + hb * 64 + 8 * dc));
    const GAS float* BG = (const GAS float*)(p.ws + WS_BG) + (size_t)(64 * c + t) * 256 + hb * 64 + 8 * dc;
    R.b0 = __builtin_nontemporal_load((const GAS f32x4*)BG); R.b1 = __builtin_nontemporal_load((const GAS f32x4*)(BG + 4));
    const GAS bf16_t* VTg = (const GAS bf16_t*)(p.ws + WS_VT); const GAS bf16_t* Sp = (const GAS bf16_t*)(p.ws + WS_SP) + (size_t)(c * 4 + hb) * 8192;
#pragma unroll
    for (int i = 0; i < 2; ++i) { const int id = tid + 512 * i, row = id >> 3, c8 = id & 7;
        R.vt[i] = __builtin_nontemporal_load((const GAS u32x4*)(VTg + (size_t)(1024 + hb * 128 + row) * LDV + 64 * c + 8 * c8)); R.st[i] = __builtin_nontemporal_load((const GAS u32x4*)(Sp + row * 64 + 8 * c8)); }
    const int i_ = 16 * (w & 3) + r16;
#pragma unroll
    for (int q4 = 0; q4 < 4; ++q4) { const int dv0 = 16 * (4 * (w >> 2) + q4) + 4 * g;
        R.zpre[q4] = __builtin_nontemporal_load((const GAS u32x2*)(hm_rows + (size_t)i_ * NMAIN + C_BZ + hb * 128 + dv0)); R.gpre[q4] = *(const GAS f32x4*)((const GAS float*)p.norm_g + l * 128 + dv0); }
}
__device__ __forceinline__ void gla_part2(LAS unsigned char* lds, const Params& p, int l, int c, int hb, const Gla2Regs& R, int tid, int w, int r16, int g) {
    const bf16_t* hm_rows = (const bf16_t*)(p.ws + WS_HM) + (size_t)(64 * c) * NMAIN;
    u32x2 zpre[4]; f32x4 gpre[4];
#pragma unroll
    for (int q4 = 0; q4 < 4; ++q4) { zpre[q4] = R.zpre[q4]; gpre[q4] = R.gpre[q4]; }
    {
        const int t = tid >> 3, dc = tid & 7;
        const u32x4 qv = R.qv, kv = R.kv; const f32x4 b0 = R.b0, b1 = R.b1;
        u32x4 vt[2] = {R.vt[0], R.vt[1]}, st[2] = {R.st[0], R.st[1]};
        float qf[8] = {bflo(qv.x), bfhi(qv.x), bflo(qv.y), bfhi(qv.y), bflo(qv.z), bfhi(qv.z), bflo(qv.w), bfhi(qv.w)};
        float kf[8] = {bflo(kv.x), bfhi(kv.x), bflo(kv.y), bfhi(kv.y), bflo(kv.z), bfhi(kv.z), bflo(kv.w), bfhi(kv.w)};
        float bb[8] = {b0.x, b0.y, b0.z, b0.w, b1.x, b1.y, b1.z, b1.w};
        float qpv[8], qmv[8], kpv[8], kmv[8];
#pragma unroll
        for (int e = 0; e < 8; ++e) { const float ep = __expf(bb[e]), em = __expf(-bb[e]), q8 = qf[e] * 0.125f;
            qpv[e] = q8 * ep; qmv[e] = q8 * em; kpv[e] = kf[e] * ep; kmv[e] = kf[e] * em; }
        const int o = t * 144 + dc * 16;
        *(LAS u32x4*)(lds + G_QP + o) = (u32x4){pk2(qpv[0], qpv[1]), pk2(qpv[2], qpv[3]), pk2(qpv[4], qpv[5]), pk2(qpv[6], qpv[7])};
        *(LAS u32x4*)(lds + G_QM + o) = (u32x4){pk2(qmv[0], qmv[1]), pk2(qmv[2], qmv[3]), pk2(qmv[4], qmv[5]), pk2(qmv[6], qmv[7])};
        *(LAS u32x4*)(lds + G_KP + o) = (u32x4){pk2(kpv[0], kpv[1]), pk2(kpv[2], kpv[3]), pk2(kpv[4], kpv[5]), pk2(kpv[6], kpv[7])};
        *(LAS u32x4*)(lds + G_KM + o) = (u32x4){pk2(kmv[0], kmv[1]), pk2(kmv[2], kmv[3]), pk2(kmv[4], kmv[5]), pk2(kmv[6], kmv[7])};
#pragma unroll
        for (int i = 0; i < 2; ++i) { const int id = tid + 512 * i, row = id >> 3, c8 = id & 7;
            *(LAS u32x4*)(lds + G_VT + row * 144 + c8 * 16) = vt[i]; *(LAS u32x4*)(lds + G_ST + row * 144 + c8 * 16) = st[i]; }
    }
    __syncthreads();
    { const int ib = w >> 1; LAS bf16_t* AT = (LAS bf16_t*)(lds + G_AT);
        const LAS unsigned char* qpA = lds + G_QP + (16 * ib + r16) * 144 + g * 16; const LAS unsigned char* qmA = lds + G_QM + (16 * ib + r16) * 144 + g * 16;
#pragma unroll
        for (int jj = 0; jj < 2; ++jj) { const int jb = 2 * (w & 1) + jj;
            const LAS unsigned char* kmB = lds + G_KM + (16 * jb + r16) * 144 + g * 16; const LAS unsigned char* kpB = lds + G_KP + (16 * jb + r16) * 144 + g * 16;
            f32x4 lo = (f32x4){0.f, 0.f, 0.f, 0.f}, hi = lo;
#pragma unroll
            for (int ks = 0; ks < 2; ++ks) { lo = MFMA16(*(const LAS bf16x8*)(qpA + ks * 64), *(const LAS bf16x8*)(kmB + ks * 64), lo);
                hi = MFMA16(*(const LAS bf16x8*)(qmA + ks * 64), *(const LAS bf16x8*)(kpB + ks * 64), hi); }
#pragma unroll
            for (int r = 0; r < 4; ++r) { const int i = 16 * ib + 4 * g + r, j = 16 * jb + r16; const float v = (j <= i) ? lo[r] : hi[r]; AT[i * 72 + j] = (bf16_t)(pk2(v, 0.f) & 0xffffu); } } }
    __syncthreads();
    const int ib = w & 3, dvh = w >> 2;
    f32x4 oacc[4];
    { const LAS unsigned char* atA = lds + G_AT + (16 * ib + r16) * 144 + g * 16; const LAS unsigned char* qpA = lds + G_QP + (16 * ib + r16) * 144 + g * 16;
#pragma unroll
        for (int q4 = 0; q4 < 4; ++q4) { const int dvb = 4 * dvh + q4;
            const LAS unsigned char* vtB = lds + G_VT + (16 * dvb + r16) * 144 + g * 16; const LAS unsigned char* stB = lds + G_ST + (16 * dvb + r16) * 144 + g * 16;
            f32x4 acc = (f32x4){0.f, 0.f, 0.f, 0.f};
#pragma unroll
            for (int ks = 0; ks < 2; ++ks) { acc = MFMA16(*(const LAS bf16x8*)(vtB + ks * 64), *(const LAS bf16x8*)(atA + ks * 64), acc);
                acc = MFMA16(*(const LAS bf16x8*)(stB + ks * 64), *(const LAS bf16x8*)(qpA + ks * 64), acc); }
            oacc[q4] = acc; } }
    LAS float* SSQ = (LAS float*)(lds + G_SSQ);
    { float pr = 0.f;
#pragma unroll
        for (int q4 = 0; q4 < 4; ++q4) pr += (oacc[q4][0] * oacc[q4][0] + oacc[q4][1] * oacc[q4][1]) + (oacc[q4][2] * oacc[q4][2] + oacc[q4][3] * oacc[q4][3]);
        pr += __shfl_xor(pr, 16); pr += __shfl_xor(pr, 32);
        if (g == 0) SSQ[dvh * 64 + 16 * ib + r16] = pr; }
    __syncthreads();
    { const int i = 16 * ib + r16; const float rinv = rsqrtf((SSQ[i] + SSQ[64 + i]) * (1.0f / 128.0f) + RMS_EPS);
        GAS bf16_t* Yr = (GAS bf16_t*)(p.ws + WS_Y) + (size_t)(64 * c + i) * DM + 1024 + hb * 128;
#pragma unroll
        for (int q4 = 0; q4 < 4; ++q4) { const int dv0 = 16 * (4 * dvh + q4) + 4 * g; const u32x2 z = zpre[q4]; const f32x4 gg = gpre[q4];
            const float y0 = oacc[q4][0] * rinv * gg.x * silu_f(bflo(z.x)), y1 = oacc[q4][1] * rinv * gg.y * silu_f(bfhi(z.x)), y2 = oacc[q4][2] * rinv * gg.z * silu_f(bflo(z.y)), y3 = oacc[q4][3] * rinv * gg.w * silu_f(bfhi(z.y));
            u32x2 yo; yo.x = pk2(y0, y1); yo.y = pk2(y2, y3); *(GAS u32x2*)(Yr + dv0) = yo; } }
    __syncthreads();
}

__device__ __forceinline__ void ln_phase(const Params& p, int l, const float* tin, float* fout) {
    int tid_ = threadIdx.x; asm volatile("" : "+v"(tid_)); const int tid = tid_, lane = tid & 63, wave = tid >> 6;
    const int gw = blockIdx.x * 8 + wave, NGW = gridDim.x * 8;
    const float* lg = p.ln_g + l * DM; const float* lb = p.ln_b + l * DM; bf16_t* xb = (bf16_t*)(p.ws + WS_XB);
    for (int row = gw; row < SEQ; row += NGW) {
        const f32x4* xr = (const f32x4*)(tin + (size_t)row * DM) + lane;
        f32x4 v[8]; float s = 0.f;
#pragma unroll
        for (int j = 0; j < 8; ++j) { v[j] = xr[64 * j]; s += (v[j].x + v[j].y) + (v[j].z + v[j].w); }
#pragma unroll
        for (int o = 1; o < 64; o <<= 1) s += __shfl_xor(s, o);
        const float mean = s * (1.0f / DM); float s2 = 0.f;
#pragma unroll
        for (int j = 0; j < 8; ++j) { v[j] = v[j] - mean; s2 += (v[j].x * v[j].x + v[j].y * v[j].y) + (v[j].z * v[j].z + v[j].w * v[j].w); }
#pragma unroll
        for (int o = 1; o < 64; o <<= 1) s2 += __shfl_xor(s2, o);
        const float rstd = rsqrtf(s2 * (1.0f / DM) + LN_EPS);
        f32x4* orow = (f32x4*)(fout + (size_t)row * DM) + lane; u32x2* brow = (u32x2*)(xb + (size_t)row * DM) + lane;
#pragma unroll
        for (int j = 0; j < 8; ++j) { const f32x4 gg = ((const f32x4*)lg)[lane + 64 * j], bb = ((const f32x4*)lb)[lane + 64 * j];
            const f32x4 y = v[j] * rstd * gg + bb; orow[64 * j] = y; u32x2 o2; o2.x = pk2(y.x, y.y); o2.y = pk2(y.z, y.w); brow[64 * j] = o2; }
    }
}

#define XB_TMO      128
#define XB_XCNT(j)  (256  + 64 * (j))
#define XB_XSUB(j)  (1280 + 64 * (j))
#define XB_XGEN(j)  (2304 + 64 * (j))
#define XB_TOP      3328
#define XB_TOPGEN   3392
#define XCD_BAR_WORDS 3456
#define XB_SPIN_CAP (1u << 18)

__device__ __forceinline__ unsigned xb_ld(unsigned* p)              { return __hip_atomic_load(p, __ATOMIC_RELAXED, __HIP_MEMORY_SCOPE_AGENT); }
__device__ __forceinline__ unsigned xb_add(unsigned* p, unsigned v) { return __hip_atomic_fetch_add(p, v, __ATOMIC_RELAXED, __HIP_MEMORY_SCOPE_AGENT); }
__device__ __forceinline__ unsigned xb_xcc_id() { return (unsigned)__builtin_amdgcn_s_getreg((3 << 11) | 20) & 0xFu; }
#define XB_SPIN(cond, bar) do { unsigned _sp = 0; while (cond) { __builtin_amdgcn_s_sleep(1); \
    if ((++_sp & 255u) == 0u) { if (xb_ld(&(bar)[XB_TMO])) break; if (_sp > XB_SPIN_CAP) { atomicAdd(&(bar)[XB_TMO], 1u); break; } } } } while (0)

struct XcdBarrier {
    unsigned* bar; unsigned x;
    volatile LAS unsigned* st;
};

__device__ __forceinline__ XcdBarrier xcd_barrier_post(unsigned* bar, volatile LAS unsigned* st) {
    XcdBarrier b; b.bar = bar; b.x = xb_xcc_id(); b.st = st;
    if (threadIdx.x == 0) (void)xb_add(&bar[XB_XCNT(b.x)], 1u);
    return b;
}
__device__ __forceinline__ void xcd_barrier_complete(unsigned* bar, unsigned x, unsigned& nloc, unsigned& nx) {
    const unsigned G = gridDim.x * gridDim.y * gridDim.z;
    unsigned sum, cnt, mine, sp = 0u;
    for (;;) {
        sum = 0u; cnt = 0u; mine = 0u;
#pragma unroll
        for (unsigned j = 0; j < 16; ++j) { const unsigned c = xb_ld(&bar[XB_XCNT(j)]); sum += c; cnt += (c > 0u) ? 1u : 0u; mine = (j == x) ? c : mine; }
        if (sum == G) break;
        __builtin_amdgcn_s_sleep(1);
        if ((++sp & 255u) == 0u) { if (xb_ld(&bar[XB_TMO])) break; if (sp > XB_SPIN_CAP) { atomicAdd(&bar[XB_TMO], 1u); break; } }
    }
    nloc = mine > 0u ? mine : 1u; nx = cnt > 0u ? cnt : 1u;
}

__device__ __forceinline__ void xcd_barrier(const XcdBarrier& b) {
    asm volatile("s_waitcnt vmcnt(0)" ::: "memory");
    __syncthreads();
    if (threadIdx.x == 0) {
        unsigned* bar = b.bar;
        __builtin_amdgcn_s_waitcnt(0);
        unsigned nloc = b.st[0], nx = b.st[1];
        if (nloc == 0u) { xcd_barrier_complete(bar, b.x, nloc, nx); b.st[0] = nloc; b.st[1] = nx; }
        const unsigned old = xb_add(&bar[XB_XSUB(b.x)], 1u);
        const unsigned gen = old / nloc;
        if (old + 1u == (gen + 1u) * nloc) {
            __builtin_amdgcn_fence(__ATOMIC_RELEASE, "agent");
            asm volatile("s_waitcnt vmcnt(0)" ::: "memory");
            const unsigned og = xb_add(&bar[XB_TOP], 1u);
            const unsigned tg = og / nx;
            if (og + 1u == (tg + 1u) * nx) xb_add(&bar[XB_TOPGEN], 1u);
            else XB_SPIN(xb_ld(&bar[XB_TOPGEN]) == tg, bar);
            __builtin_amdgcn_fence(__ATOMIC_ACQUIRE, "agent");
            xb_add(&bar[XB_XGEN(b.x)], 1u);
            asm volatile("s_waitcnt vmcnt(0)" ::: "memory");
        } else {
            XB_SPIN(xb_ld(&bar[XB_XGEN(b.x)]) == gen, bar);
            __builtin_amdgcn_fence(__ATOMIC_ACQUIRE, "agent");
            asm volatile("s_waitcnt vmcnt(0)" ::: "memory");
        }
    }
    __syncthreads();
}

constexpr int NPH = 1 + 6 * DEPTH;
__global__ void __launch_bounds__(512, 2) mega(Params p_in) {
    extern __shared__ __attribute__((aligned(16))) unsigned char lds_raw[];
    LAS unsigned char* lds = (LAS unsigned char*)lds_raw;
    cg::grid_group grid = cg::this_grid();
    const int bid = blockIdx.x, G = gridDim.x;
    volatile LAS unsigned* misc = (volatile LAS unsigned*)(lds + LDS_BYTES - 64);
    if (threadIdx.x < 16) misc[threadIdx.x] = 0u;
    __syncthreads();
    const XcdBarrier bar = xcd_barrier_post((unsigned*)(p_in.ws + WS_CTL), misc);
    if (p_in.ph_hi < 0) grid.sync();
    const Params& p0 = p_in;
    for (int ph = p0.ph_lo; ph < p0.ph_hi; ++ph) {
        Params p = p0; asm volatile("" : "+s"(p.ws));
        bf16_t* xb = (bf16_t*)(p.ws + WS_XB); float* xf = (float*)(p.ws + WS_XF);
        bf16_t* hm = (bf16_t*)(p.ws + WS_HM); bf16_t* VT = (bf16_t*)(p.ws + WS_VT); bf16_t* Y = (bf16_t*)(p.ws + WS_Y);
        if (ph == 0) phase0(p, lds);
        else {
            const int l = (ph - 1) / 6, k = (ph - 1) % 6;
            const bf16_t* win = (const bf16_t*)(p.ws + WS_WIN + l * WIN_L);
            if (k == 0) {
                for (int gi = 0; gi < 4; ++gi) {
                    pg8::Gemm g; bf16_t* O; int ldc, c;
                    if (gi == 0) { g.A = xb; g.Bt = win; g.M = SEQ; g.N = NMAIN; O = hm; ldc = NMAIN; c = bid; }
                    else if (gi == 1) { g.A = win + (size_t)NMAIN * DM; g.Bt = xb; g.M = NVT; g.N = SEQ; O = VT; ldc = LDV; c = G - 1 - bid; }
                    else if (gi == 2) { g.A = (const bf16_t*)(p.ws + WS_MEMB); g.Bt = (const bf16_t*)(p.ws + WS_WMK) + (size_t)l * 512 * DM; g.M = NMEM; g.N = 512; O = (bf16_t*)(p.ws + WS_MK) + l * 512; ldc = 2048;
                        c = (bid >= G - 16 && bid < G - 14) ? bid - (G - 16) : (1 << 24); }
                    else { g.A = (const bf16_t*)(p.ws + WS_WMV) + (size_t)l * 512 * DM; g.Bt = (const bf16_t*)(p.ws + WS_MEMB); g.M = 512; g.N = NMEM; O = (bf16_t*)(p.ws + WS_MVT) + (size_t)l * 512 * NMEM; ldc = NMEM;
                        c = (bid >= G - 14 && bid < G - 12) ? bid - (G - 14) : (1 << 24); }
                    g.K = DM;
                    pg8::StaticOrder S; S.init(g.M, g.N, G, c);
                    pg8::EpiBf16<0> E{O, ldc, nullptr, 0, 0, 1.f};
                    pg8::gemm_phase<pg8::EpiBf16<0>, pg8::StaticOrder, true, true>(lds, g, S, E);
                }
                if (l + 1 < DEPTH) {
                    int wkb = bid, nwb = G;
                    if (G == 256) { nwb = 144; wkb = bid < 64 ? bid : (bid >= 160 && bid < 240 ? bid - 96 : -1); }
                    if (wkb >= 0) { int t2_ = threadIdx.x; asm volatile("" : "+v"(t2_)); convert_layer(p, l + 1, lds, wkb * 8 + (t2_ >> 6), nwb * 8); }
                }
            } else if (k == 1) {
                for (int u = bid; u < 256; u += G) band_pair_unit(lds, p, l, u >> 2, 2 * (u & 3));
                for (int u = bid; u < 256; u += G) { const int head = u & 3, qb = u >> 2;
                    attn_unit<false>(lds, 128 * qb, hm + C_MQ + head * 128, NMAIN, (const bf16_t*)(p.ws + WS_MK) + l * 512 + head * 128, 2048,
                                     (const bf16_t*)(p.ws + WS_MVT) + (size_t)(l * 512 + head * 128) * NMEM, NMEM, hm + C_MZ + head * 128, NMAIN, Y + 1536 + head * 128, DM, nullptr, 0); }
                for (int u = bid; u < 512; u += G) gla_part1(lds, p, l, u >> 2, u & 3);
            } else if (k == 2) gla_scan(p, lds);
            else if (k == 3) {
                int t3_ = threadIdx.x; asm volatile("" : "+v"(t3_)); const int tid3 = t3_, w3 = __builtin_amdgcn_readfirstlane(tid3 >> 6), r3 = tid3 & 15, g3 = (tid3 & 63) >> 4;
                if (G == 256) {
                    Gla2Regs RA, RB; const int u = bid, u2 = bid + 256;
                    gla_part2_load(RA, p, l, u >> 2, u & 3, tid3, w3, r3, g3);
                    gla_part2_load(RB, p, l, u2 >> 2, u2 & 3, tid3, w3, r3, g3);
                    gla_part2(lds, p, l, u >> 2, u & 3, RA, tid3, w3, r3, g3);
                    gla_part2(lds, p, l, u2 >> 2, u2 & 3, RB, tid3, w3, r3, g3);
                } else {
                    for (int u = bid; u < 512; u += G) { Gla2Regs RA; gla_part2_load(RA, p, l, u >> 2, u & 3, tid3, w3, r3, g3); gla_part2(lds, p, l, u >> 2, u & 3, RA, tid3, w3, r3, g3); }
                }
            }
            else if (k == 4) {
                pg8::Gemm g; g.A = Y; g.Bt = (const bf16_t*)(p.ws + WS_WOUT + l * WOUT_L); g.M = SEQ; g.N = DM; g.K = DM;
                pg8::StaticOrder S; S.init(SEQ, DM, G, bid);
                if (G == 256) {
                    pg8::EpiResLn E{l == 0 ? p.x : (const float*)nullptr, l == DEPTH - 1 ? p.out : (float*)nullptr, xb, (bf16_t*)(p.ws + WS_XL), p.ln_g + l * DM, p.ln_b + l * DM, (unsigned long long*)(p.ws + WS_XCH),
                                    (unsigned*)(p.ws + WS_CTL) + CW_CNT + l * 2048, 1.6817928305074292f, LN_EPS};
                    pg8::gemm_phase<pg8::EpiResLn, pg8::StaticOrder, false, true>(lds, g, S, E);
                } else {
                    pg8::EpiResid E{l == 0 ? p.x : xf, xf, DM, 1.6817928305074292f};
                    pg8::gemm_phase<pg8::EpiResid, pg8::StaticOrder, true, true>(lds, g, S, E);
                }
            } else if (G != 256) ln_phase(p, l, xf, l == DEPTH - 1 ? p.out : xf);
        }
        if (ph + 1 < p0.ph_hi && !(G == 256 && ph > 0 && (ph - 1) % 6 == 4)) xcd_barrier(bar);
    }
}

extern "C" void kernel_launch(void* const* d_in, const int* in_sizes, int n_in, void* d_out, int out_size, void* d_ws, size_t ws_size, hipStream_t stream) {
    static int grid = 0;
    if (grid == 0) {
        if (n_in != 11 || ws_size < WS_END) { fprintf(stderr, "kernel_launch: unexpected inputs (n_in %d, ws %zu)\n", n_in, ws_size); grid = -1; return; }
        int dev = 0, cus = 0, per_cu = 0;
        hipGetDevice(&dev); hipDeviceGetAttribute(&cus, hipDeviceAttributeMultiprocessorCount, dev);
        hipFuncSetAttribute((const void*)mega, hipFuncAttributeMaxDynamicSharedMemorySize, LDS_BYTES);
        hipOccupancyMaxActiveBlocksPerMultiprocessor(&per_cu, (const void*)mega, 512, LDS_BYTES);
        if (per_cu < 1) per_cu = 1;
        (void)hipGetLastError();
        grid = cus * per_cu;
    }
    if (grid < 0) return;
    Params p{};
    p.x = (const float*)d_in[0]; p.mem = (const float*)d_in[1]; p.w_in = (const float*)d_in[2]; p.rel = (const float*)d_in[3]; p.gate_w = (const float*)d_in[4];
    p.gate_b = (const float*)d_in[5]; p.norm_g = (const float*)d_in[6]; p.w_mkv = (const float*)d_in[7]; p.w_out = (const float*)d_in[8]; p.ln_g = (const float*)d_in[9]; p.ln_b = (const float*)d_in[10];
    p.out = (float*)d_out; p.ws = (unsigned char*)d_ws;
    if (hipMemsetAsync((char*)d_ws + WS_CTL, 0, CTL_BYTES, stream) != hipSuccess) { fprintf(stderr, "memset failed\n"); return; }
#if defined(MK_MULTI)
    for (int ph = 0; ph < NPH; ++ph) { p.ph_lo = ph; p.ph_hi = ph + 1; hipLaunchKernelGGL(mega, dim3(grid), dim3(512), LDS_BYTES, stream, p); }
#else
    p.ph_lo = 0; p.ph_hi = NPH;
    void* args[] = {&p};
    hipError_t e = hipLaunchCooperativeKernel((const void*)mega, dim3(grid), dim3(512), args, LDS_BYTES, stream);
    if (e != hipSuccess) fprintf(stderr, "cooperative launch failed: %s (grid %d)\n", hipGetErrorString(e), grid);
#endif
}
```
